# Optimizing an MI355X kernel written in HIP

```python
import jax, jax.numpy as jnp
from jax import lax
import numpy as np

D_MODEL = 2048
BATCH = 1
SEQ = 8192
DEPTH = 1

PLE_DIM = 256
MLA_HEADS = 8
QK_NOPE = 128
QK_ROPE = 64
QK_HEAD = QK_NOPE + QK_ROPE
V_HEAD = 128
Q_LORA = 512
KV_LORA = 256
ROPE_THETA = 10000.0
ATTN_BLOCK = 128
HG_HEADS = 8
HG_DK = 128
HG_DV = 128
HG_CHUNK = 64
D_MLA = MLA_HEADS * V_HEAD
D_HG = HG_HEADS * HG_DV
D_MIX = D_MLA + D_HG
IN_SPLITS = (Q_LORA, KV_LORA, QK_ROPE, HG_HEADS * HG_DK, HG_HEADS * HG_DK, D_HG, D_HG)
D_IN = Q_LORA + KV_LORA + QK_ROPE + 2 * HG_HEADS * HG_DK + 2 * D_HG
N_GROUPS = 8
EXPERTS_PER_GROUP = 8
N_EXPERTS = N_GROUPS * EXPERTS_PER_GROUP
TOP_K = 2
D_EXPERT = 512
MOE_BLOCK = 128
EPS = 1e-6

kernel_name = 'hymba_mla_hgrn2_hmoe_ple'


def rms_norm(x, gain):
    xf = x.astype(jnp.float32)
    y = xf * lax.rsqrt(jnp.mean(xf * xf, axis=-1, keepdims=True) + EPS)
    return (y * gain.astype(jnp.float32)).astype(x.dtype)


def rotary_tables(positions):
    inv_freq = 1.0 / (ROPE_THETA ** (jnp.arange(0, QK_ROPE, 2, dtype=jnp.float32) / QK_ROPE))
    ang = positions.astype(jnp.float32)[..., None] * inv_freq
    return jnp.cos(ang), jnp.sin(ang)


def apply_rope(x, cos, sin):
    xf = x.astype(jnp.float32)
    x1, x2 = jnp.split(xf, 2, axis=-1)
    return jnp.concatenate([x1 * cos - x2 * sin, x2 * cos + x1 * sin], axis=-1).astype(x.dtype)


def mla_group(c_q, c_kv, k_pe, cos, sin, q_norm, w_uq, kv_norm, w_ukv, mla_norm):
    B, S, _ = c_q.shape
    q = (rms_norm(c_q, q_norm) @ w_uq).reshape(B, S, MLA_HEADS, QK_HEAD)
    q = jnp.concatenate([q[..., :QK_NOPE], apply_rope(q[..., QK_NOPE:], cos[:, :, None], sin[:, :, None])], axis=-1)
    kv = (rms_norm(c_kv, kv_norm) @ w_ukv).reshape(B, S, MLA_HEADS, QK_NOPE + V_HEAD)
    k_pe = apply_rope(k_pe, cos, sin)
    k = jnp.concatenate([kv[..., :QK_NOPE], jnp.broadcast_to(k_pe[:, :, None], (B, S, MLA_HEADS, QK_ROPE))], axis=-1)
    v = kv[..., QK_NOPE:]
    scale = QK_HEAD ** -0.5
    kpos = jnp.arange(S)
    neg = jnp.finfo(jnp.float32).min

    def block(start):
        qb = lax.dynamic_slice_in_dim(q, start, ATTN_BLOCK, axis=1)
        s = jnp.einsum('bqhd,bkhd->bhqk', qb, k).astype(jnp.float32) * scale
        qpos = start + jnp.arange(ATTN_BLOCK)
        s = jnp.where(kpos[None, :] <= qpos[:, None], s, neg)
        pr = jax.nn.softmax(s, axis=-1).astype(v.dtype)
        return jnp.einsum('bhqk,bkhv->bqhv', pr, v)

    starts = jnp.arange(S // ATTN_BLOCK) * ATTN_BLOCK
    o = lax.map(block, starts)
    o = jnp.moveaxis(o, 0, 1).reshape(B, S, D_MLA)
    return rms_norm(o, mla_norm)


def hgrn2_group(q_in, f_in, i_in, g_in, lb, hg_norm):
    B, S, _ = q_in.shape
    NC = S // HG_CHUNK
    lb = lb.astype(jnp.float32).reshape(HG_HEADS, 1, HG_DK)

    def heads(t, d):
        return t.astype(jnp.float32).reshape(B, NC, HG_CHUNK, HG_HEADS, d).transpose(1, 0, 3, 2, 4)

    q = jax.nn.silu(heads(q_in, HG_DK))
    f = lb + (1.0 - lb) * jax.nn.sigmoid(heads(f_in, HG_DK))
    k = 1.0 - f
    b = jnp.cumsum(jnp.log(f), axis=3)
    i = heads(i_in, HG_DV)
    causal = jnp.tril(jnp.ones((HG_CHUNK, HG_CHUNK), dtype=bool))

    def step(state, xs):
        qc, kc, ic, bc = xs
        diff = bc[:, :, :, None, :] - bc[:, :, None, :, :]
        decay = jnp.where(causal[:, :, None], jnp.exp(jnp.minimum(diff, 0.0)), 0.0)
        attn = jnp.einsum('bhtk,bhtsk,bhsk->bhts', qc, decay, kc)
        o = attn @ ic + jnp.einsum('bhtk,bhkv->bhtv', qc * jnp.exp(bc), state)
        b_last = bc[:, :, -1:, :]
        state = jnp.exp(b_last[:, :, 0, :])[..., None] * state + jnp.einsum('bhsk,bhsv->bhkv', kc * jnp.exp(b_last - bc), ic)
        return state, o

    s0 = jnp.zeros((B, HG_HEADS, HG_DK, HG_DV), jnp.float32)
    _, o = lax.scan(step, s0, (q, k, i, b))
    o = o.transpose(1, 0, 3, 2, 4).reshape(B, S, HG_HEADS, HG_DV)
    o = rms_norm(o, hg_norm)
    gate = jax.nn.silu(g_in.astype(jnp.float32)).reshape(B, S, HG_HEADS, HG_DV)
    return (o * gate).reshape(B, S, D_HG).astype(q_in.dtype)


def hier_route(xt, w_rg, b_rg, w_re, b_re):
    T = xt.shape[0]
    pg = jax.nn.softmax((xt @ w_rg).astype(jnp.float32) + b_rg.astype(jnp.float32), axis=-1)
    g_w, g_idx = lax.top_k(pg, 1)
    el = ((xt @ w_re).astype(jnp.float32) + b_re.astype(jnp.float32)).reshape(T, N_GROUPS, EXPERTS_PER_GROUP)
    el = jnp.take_along_axis(el, g_idx[:, :, None], axis=1)[:, 0]
    top_p, top_i = lax.top_k(jax.nn.softmax(el, axis=-1), TOP_K)
    w = g_w * top_p / jnp.sum(top_p, axis=-1, keepdims=True)
    eid = g_idx * EXPERTS_PER_GROUP + top_i
    return eid, w


def moe_dispatch(xt, eid, ew, w_gate, w_up, w_down):
    T, D = xt.shape
    A = T * TOP_K
    e_flat = eid.reshape(-1).astype(jnp.int32)
    w_flat = ew.reshape(-1)
    t_flat = jnp.repeat(jnp.arange(T, dtype=jnp.int32), TOP_K)
    order = jnp.argsort(e_flat, stable=True)
    e_s, t_s, w_s = e_flat[order], t_flat[order], w_flat[order]
    counts = jnp.bincount(e_flat, length=N_EXPERTS).astype(jnp.int32)
    starts = jnp.cumsum(counts) - counts
    padded = ((counts + MOE_BLOCK - 1) // MOE_BLOCK) * MOE_BLOCK
    pends = jnp.cumsum(padded)
    pstarts = pends - padded
    slot = pstarts[e_s] + (jnp.arange(A, dtype=jnp.int32) - starts[e_s])
    n_blocks = -(-A // MOE_BLOCK) + N_EXPERTS
    slot_tok = jnp.full((n_blocks * MOE_BLOCK,), T, jnp.int32).at[slot].set(t_s)
    slot_w = jnp.zeros((n_blocks * MOE_BLOCK,), w_flat.dtype).at[slot].set(w_s)
    block_e = jnp.clip(jnp.searchsorted(pends, jnp.arange(n_blocks, dtype=jnp.int32) * MOE_BLOCK, side='right'), 0, N_EXPERTS - 1)
    x_pad = jnp.concatenate([xt, jnp.zeros((1, D), xt.dtype)], axis=0)

    def run(args):
        tok, wgt, e = args
        xb = x_pad[tok]
        hmid = jax.nn.silu(xb @ w_gate[e]) * (xb @ w_up[e])
        return (hmid @ w_down[e]) * wgt[:, None].astype(xt.dtype)

    yb = lax.map(run, (slot_tok.reshape(n_blocks, MOE_BLOCK), slot_w.reshape(n_blocks, MOE_BLOCK), block_e))
    y = jnp.zeros((T + 1, D), xt.dtype).at[slot_tok].add(yb.reshape(-1, D))
    return y[:T]


def setup_inputs(seed: int = 0) -> dict:
    key = jax.random.key(seed)
    ks = jax.random.split(key, 32)
    f32 = jnp.float32

    def normal(k, shape, scale):
        return jax.random.normal(k, shape, f32) * scale

    def gain(k, shape):
        return 1.0 + 0.05 * jax.random.normal(k, shape, f32)

    x = normal(ks[0], (BATCH, SEQ, D_MODEL), 1.0)
    p = normal(ks[1], (DEPTH, BATCH, SEQ, PLE_DIM), 1.0)
    positions = jax.random.randint(ks[2], (BATCH, 1), 0, 4096, dtype=jnp.int32) + jnp.arange(SEQ, dtype=jnp.int32)[None, :]
    return {
        'x': x,
        'p': p,
        'positions': positions,
        'attn_norm': gain(ks[3], (DEPTH, D_MODEL)),
        'w_in': normal(ks[4], (DEPTH, D_MODEL, D_IN), D_MODEL ** -0.5),
        'q_norm': gain(ks[5], (DEPTH, Q_LORA)),
        'w_uq': normal(ks[6], (DEPTH, Q_LORA, MLA_HEADS * QK_HEAD), Q_LORA ** -0.5),
        'kv_norm': gain(ks[7], (DEPTH, KV_LORA)),
        'w_ukv': normal(ks[8], (DEPTH, KV_LORA, MLA_HEADS * (QK_NOPE + V_HEAD)), KV_LORA ** -0.5),
        'mla_norm': gain(ks[9], (DEPTH, D_MLA)),
        'hg_lb_logits': normal(ks[10], (DEPTH + 1, HG_HEADS * HG_DK), 0.5),
        'hg_norm': gain(ks[11], (DEPTH, HG_HEADS, HG_DV)),
        'w_out': normal(ks[12], (DEPTH, D_MIX, D_MODEL), D_MIX ** -0.5),
        'ffn_norm': gain(ks[13], (DEPTH, D_MODEL)),
        'w_router_group': normal(ks[14], (DEPTH, D_MODEL, N_GROUPS), D_MODEL ** -0.5),
        'b_router_group': normal(ks[15], (DEPTH, N_GROUPS), 0.01),
        'w_router_expert': normal(ks[16], (DEPTH, D_MODEL, N_EXPERTS), D_MODEL ** -0.5),
        'b_router_expert': normal(ks[17], (DEPTH, N_EXPERTS), 0.01),
        'w_exp_gate': normal(ks[18], (DEPTH, N_EXPERTS, D_MODEL, D_EXPERT), D_MODEL ** -0.5),
        'w_exp_up': normal(ks[19], (DEPTH, N_EXPERTS, D_MODEL, D_EXPERT), D_MODEL ** -0.5),
        'w_exp_down': normal(ks[20], (DEPTH, N_EXPERTS, D_EXPERT, D_MODEL), D_EXPERT ** -0.5),
        'ple_norm': gain(ks[21], (DEPTH, D_MODEL)),
        'w_ple_gate': normal(ks[22], (DEPTH, D_MODEL, D_MODEL), D_MODEL ** -0.5),
        'b_ple_gate': normal(ks[23], (DEPTH, D_MODEL), 0.01),
        'w_ple_proj': normal(ks[24], (DEPTH, PLE_DIM, D_MODEL), PLE_DIM ** -0.5),
        'final_norm': gain(ks[25], (D_MODEL,)),
    }


def reference(x, p, positions, attn_norm, w_in, q_norm, w_uq, kv_norm, w_ukv, mla_norm,
              hg_lb_logits, hg_norm, w_out, ffn_norm, w_router_group, b_router_group,
              w_router_expert, b_router_expert, w_exp_gate, w_exp_up, w_exp_down,
              ple_norm, w_ple_gate, b_ple_gate, w_ple_proj, final_norm):
    B, S, D = x.shape
    cos, sin = rotary_tables(positions)
    lb_table = jnp.cumsum(jax.nn.softmax(hg_lb_logits.astype(jnp.float32), axis=0), axis=0)
    split_pts = np.cumsum(IN_SPLITS)[:-1].tolist()
    h = x
    for li in range(DEPTH):
        hn = rms_norm(h, attn_norm[li])
        proj = hn @ w_in[li]
        c_q, c_kv, k_pe, hq, hf, hi, hg = jnp.split(proj, split_pts, axis=-1)
        y_mla = mla_group(c_q, c_kv, k_pe, cos, sin, q_norm[li], w_uq[li], kv_norm[li], w_ukv[li], mla_norm[li])
        y_hg = hgrn2_group(hq, hf, hi, hg, lb_table[li], hg_norm[li])
        h = h + jnp.concatenate([y_mla, y_hg], axis=-1) @ w_out[li]
        hn = rms_norm(h, ffn_norm[li]).reshape(B * S, D)
        eid, ew = hier_route(hn, w_router_group[li], b_router_group[li], w_router_expert[li], b_router_expert[li])
        h = h + moe_dispatch(hn, eid, ew, w_exp_gate[li], w_exp_up[li], w_exp_down[li]).reshape(B, S, D)
        hn = rms_norm(h, ple_norm[li])
        gate = jax.nn.sigmoid(hn @ w_ple_gate[li] + b_ple_gate[li])
        h = h + gate * (p[li] @ w_ple_proj[li])
    return rms_norm(h, final_norm)
```

```cpp
#include <hip/hip_runtime.h>
#include <cstdint>
#include <cstdio>

#define LAS __attribute__((address_space(3)))
typedef unsigned short bf16_t;
typedef float f32x4 __attribute__((ext_vector_type(4)));
typedef unsigned u32x4 __attribute__((ext_vector_type(4)));
typedef unsigned u32x2 __attribute__((ext_vector_type(2)));

constexpr int S_ = 8192, D_ = 2048, DIN = 4928, DINP = 5120;
constexpr int NH = 8, QKD = 192, VD = 128;
constexpr int NE = 64, DE = 512, PLE = 256;
constexpr float EPS = 1e-6f;
constexpr float QSCALE = 0.07216878364870323f * 1.4426950408889634f;
constexpr int PC_CQ = 0, PC_CKV = 512, PC_HQ = 768, PC_HF = 1792, PC_HI = 2816, PC_HG = 3840, PC_KPE = 4864;
constexpr int LISTCAP = 8192;

constexpr size_t MiB = 1u << 20;
constexpr size_t WS_CTL = 0;
constexpr size_t WS_RSTDX = 1 * MiB, WS_RSTD1 = WS_RSTDX + 32768, WS_RSTD2 = WS_RSTD1 + 32768, WS_LB = WS_RSTD2 + 32768, WS_TILEB = WS_LB + 4096;
constexpr size_t WS_COS = 2 * MiB, WS_SIN = 3 * MiB, WS_PARTQ = 4 * MiB, WS_PART1 = 5 * MiB, WS_PART3 = 6 * MiB, WS_WR = 7 * MiB;
constexpr size_t WS_ML = 8 * MiB, WS_DVEC = 9 * MiB, WS_EID = 10 * MiB, WS_EW = WS_EID + 65536, WS_LIST = 11 * MiB;
constexpr size_t WS_WUQ = 16 * MiB, WS_WUKV = 18 * MiB, WS_WPP = 19 * MiB, WS_WIN = 20 * MiB, WS_WOUT = 40 * MiB, WS_WPG = 48 * MiB;
constexpr size_t WS_PB = 56 * MiB, WS_XB = 64 * MiB, WS_PROJ = 96 * MiB, WS_PP = 176 * MiB, WS_QB = 208 * MiB, WS_KB = 232 * MiB, WS_VB = 256 * MiB;
constexpr size_t WS_LST = 272 * MiB, WS_SST = 304 * MiB, WS_OPART = 336 * MiB, WS_YMIX = 368 * MiB, WS_H1B = 400 * MiB, WS_H2B = 432 * MiB;
constexpr size_t WS_HMID = 464 * MiB, WS_Y = 496 * MiB, WS_WGU = 560 * MiB, WS_WD = 816 * MiB, WS_END = 944 * MiB;

struct Params {
    const float *x, *p; const int* pos;
    const float *attn_norm, *w_in, *q_norm, *w_uq, *kv_norm, *w_ukv, *mla_norm, *lb_logits, *hg_norm, *w_out, *ffn_norm;
    const float *w_rg, *b_rg, *w_re, *b_re, *w_eg, *w_eu, *w_ed, *ple_norm, *w_pg, *b_pg, *w_pp, *final_norm;
    float* out; unsigned char* ws;
};
#define WSP(T, off) ((T*)(P.ws + (off)))

__device__ __forceinline__ unsigned f2bf(float f) { unsigned u = __builtin_bit_cast(unsigned, f); return (u + 0x7fffu + ((u >> 16) & 1u)) >> 16; }
__device__ __forceinline__ float bf2f(unsigned h) { return __builtin_bit_cast(float, h << 16); }
__device__ __forceinline__ unsigned pk2(float lo, float hi) { return f2bf(lo) | (f2bf(hi) << 16); }
__device__ __forceinline__ float wave_sum(float v) {
#pragma unroll
    for (int o = 1; o < 64; o <<= 1) v += __shfl_xor(v, o);
    return v;
}
__device__ __forceinline__ float sigmoidf_(float x) { return 1.f / (1.f + __expf(-x)); }
__device__ __forceinline__ float siluf_(float x) { return x / (1.f + __expf(-x)); }

struct SrcWin { const float* W; const float* g;
    __device__ __forceinline__ float operator()(int k, int n) const {
        int src;
        if (n < 768) src = n;
        else if (n < 4864) src = n + 64;
        else if (n < 4928) { const int j = n - 4864; src = 768 + ((j & 1) ? 32 + (j >> 1) : (j >> 1)); }
        else return 0.f;
        return W[(size_t)k * DIN + src] * g[k];
    } };
struct SrcWuq { const float* W; const float* g;
    __device__ __forceinline__ float operator()(int k, int n) const {
        int src;
        if (n < 1024) src = (n >> 7) * 192 + (n & 127);
        else { const int r = n - 1024, h = r >> 6, j = r & 63; src = h * 192 + 128 + ((j & 1) ? 32 + (j >> 1) : (j >> 1)); }
        return W[(size_t)k * 1536 + src] * g[k];
    } };
struct SrcWukv { const float* W; const float* g;
    __device__ __forceinline__ float operator()(int k, int n) const {
        int src;
        if (n < 1024) src = (n >> 7) * 256 + (n & 127);
        else { const int r = n - 1024; src = (r >> 7) * 256 + 128 + (r & 127); }
        return W[(size_t)k * 2048 + src] * g[k];
    } };
struct SrcWout { const float* W; const float* g0; const float* g1;
    __device__ __forceinline__ float operator()(int k, int n) const { return W[(size_t)k * 2048 + n] * (k < 1024 ? g0[k] : g1[k - 1024]); } };
struct SrcPlain { const float* W; const float* g; int N;
    __device__ __forceinline__ float operator()(int k, int n) const { const float w = W[(size_t)k * N + n]; return g ? w * g[k] : w; } };
struct SrcGU { const float* W; const float* g;
    __device__ __forceinline__ float operator()(int k, int n) const { return W[(size_t)k * DE + 128 * (n >> 8) + (n & 127)] * g[k]; } };

template <class Src>
__device__ __forceinline__ void tconv_item(const Src& src, int K, int nblk, bf16_t* WT, LAS float* scr, int item, int lane) {
    const int kb = item / nblk, nb = item % nblk, k0 = 64 * kb, n0 = 32 * nb;
#pragma unroll 8
    for (int i = 0; i < 32; ++i) { const int kk = 2 * i + (lane >> 5); scr[kk * 33 + (lane & 31)] = src(k0 + kk, n0 + (lane & 31)); }
    asm volatile("s_waitcnt lgkmcnt(0)" ::: "memory");
    const int c = lane & 7;
#pragma unroll
    for (int j = 0; j < 4; ++j) { const int n = (lane >> 3) + 8 * j; const LAS float* s = scr + (8 * c) * 33 + n;
        u32x4 o; o.x = pk2(s[0 * 33], s[1 * 33]); o.y = pk2(s[2 * 33], s[3 * 33]); o.z = pk2(s[4 * 33], s[5 * 33]); o.w = pk2(s[6 * 33], s[7 * 33]);
        *(u32x4*)(WT + (size_t)(n0 + n) * K + k0 + 8 * c) = o; }
    asm volatile("s_waitcnt lgkmcnt(0)" ::: "memory");
}

__device__ __forceinline__ void p0_run(const Params& P, int wg, int nwg, LAS unsigned char* lds) {
    const int tid = threadIdx.x, lane = tid & 63, wave = tid >> 6;
    const int gw = wg * 8 + wave, NGW = nwg * 8;
    LAS float* scr = (LAS float*)(lds + wave * 8704);
    constexpr int I_WIN = 32 * 160, I_WUQ = 8 * 48, I_WUKV = 4 * 64, I_WOUT = 32 * 64, I_WPG = 32 * 64, I_WPP = 4 * 64, I_GU = 32 * 32, I_DN = 8 * 64;
    constexpr int NITEMS = I_WIN + I_WUQ + I_WUKV + I_WOUT + I_WPG + I_WPP + NE * I_GU + NE * I_DN;
    for (int it = gw; it < NITEMS; it += NGW) {
        int r = it;
        if (r < I_WIN) { tconv_item(SrcWin{P.w_in, P.attn_norm}, 2048, 160, WSP(bf16_t, WS_WIN), scr, r, lane); continue; } r -= I_WIN;
        if (r < I_WUQ) { tconv_item(SrcWuq{P.w_uq, P.q_norm}, 512, 48, WSP(bf16_t, WS_WUQ), scr, r, lane); continue; } r -= I_WUQ;
        if (r < I_WUKV) { tconv_item(SrcWukv{P.w_ukv, P.kv_norm}, 256, 64, WSP(bf16_t, WS_WUKV), scr, r, lane); continue; } r -= I_WUKV;
        if (r < I_WOUT) { tconv_item(SrcWout{P.w_out, P.mla_norm, P.hg_norm}, 2048, 64, WSP(bf16_t, WS_WOUT), scr, r, lane); continue; } r -= I_WOUT;
        if (r < I_WPG) { tconv_item(SrcPlain{P.w_pg, P.ple_norm, 2048}, 2048, 64, WSP(bf16_t, WS_WPG), scr, r, lane); continue; } r -= I_WPG;
        if (r < I_WPP) { tconv_item(SrcPlain{P.w_pp, nullptr, 2048}, 256, 64, WSP(bf16_t, WS_WPP), scr, r, lane); continue; } r -= I_WPP;
        if (r < NE * I_GU) { const int e = r / I_GU; r -= e * I_GU;
            const bool isup = (((r % 32) * 32) & 255) >= 128;
            const float* Wsel = isup ? P.w_eu : P.w_eg;
            tconv_item(SrcGU{Wsel + (size_t)e * 2048 * DE, P.ffn_norm}, 2048, 32, WSP(bf16_t, WS_WGU) + (size_t)e * 1024 * 2048, scr, r, lane); continue; }
        r -= NE * I_GU;
        { const int e = r / I_DN; r -= e * I_DN;
          tconv_item(SrcPlain{P.w_ed + (size_t)e * DE * 2048, nullptr, 2048}, DE, 64, WSP(bf16_t, WS_WD) + (size_t)e * 2048 * DE, scr, r, lane); }
    }
    for (int m = gw; m < S_; m += NGW) {
        const f32x4* xr = (const f32x4*)(P.x + (size_t)m * D_) + lane; f32x4 v[8]; float s = 0.f;
#pragma unroll
        for (int j = 0; j < 8; ++j) { v[j] = xr[64 * j]; s += (v[j].x * v[j].x + v[j].y * v[j].y) + (v[j].z * v[j].z + v[j].w * v[j].w); }
        s = wave_sum(s);
        if (lane == 0) WSP(float, WS_RSTDX)[m] = 1.f / sqrtf(s * (1.f / D_) + EPS);
        u32x2* o = (u32x2*)(WSP(bf16_t, WS_XB) + (size_t)m * D_) + lane;
#pragma unroll
        for (int j = 0; j < 8; ++j) { u32x2 w; w.x = pk2(v[j].x, v[j].y); w.y = pk2(v[j].z, v[j].w); o[64 * j] = w; }
    }
    const int gt = wg * 512 + tid, NGT = nwg * 512;
    for (int i = gt; i < S_ * PLE / 4; i += NGT) { const f32x4 v = ((const f32x4*)P.p)[i]; u32x2 w; w.x = pk2(v.x, v.y); w.y = pk2(v.z, v.w); WSP(u32x2, WS_PB)[i] = w; }
    for (int i = gt; i < S_ * 32; i += NGT) { const int s = i >> 5, j = i & 31;
        const float invf = exp2f(-(float)j * (13.287712379549449f / 32.0f));
        const double tr = (double)P.pos[s] * (double)invf * 0.15915494309189535;
        const float fr = (float)(tr - floor(tr));
        WSP(float, WS_COS)[i] = __builtin_amdgcn_cosf(fr); WSP(float, WS_SIN)[i] = __builtin_amdgcn_sinf(fr); }
    for (int i = gt; i < 1024; i += NGT) WSP(float, WS_LB)[i] = 1.f / (1.f + expf(P.lb_logits[1024 + i] - P.lb_logits[i]));
    for (int i = gt; i < 2048 * 80; i += NGT) { const int k = i / 80, c = i % 80;
        float w = 0.f; if (c < 8) w = P.w_rg[k * 8 + c]; else if (c < 72) w = P.w_re[k * 64 + (c - 8)];
        WSP(float, WS_WR)[i] = w * P.ffn_norm[k]; }
}

struct RowId { __device__ __forceinline__ int operator()(int m) const { return m; } };
template <class F, class RowMap>
__device__ __forceinline__ void naive_gemm_item(const bf16_t* A, int lda, const bf16_t* Bt, int ldb, int K, int m0, int nrows, int n0, const F& f, const RowMap& rm, int lane) {
    const int m = m0 + lane; const bool valid = lane < nrows;
    const bf16_t* ar = A + (size_t)rm(valid ? m : m0) * lda;
    float acc[64];
#pragma unroll
    for (int c = 0; c < 64; ++c) acc[c] = 0.f;
    for (int k = 0; k < K; k += 8) {
        const u32x4 a = *(const u32x4*)(ar + k);
        float af[8];
        af[0] = bf2f(a.x & 0xffffu); af[1] = bf2f(a.x >> 16); af[2] = bf2f(a.y & 0xffffu); af[3] = bf2f(a.y >> 16);
        af[4] = bf2f(a.z & 0xffffu); af[5] = bf2f(a.z >> 16); af[6] = bf2f(a.w & 0xffffu); af[7] = bf2f(a.w >> 16);
#pragma unroll
        for (int c = 0; c < 64; ++c) {
            const u32x4 b = *(const u32x4*)(Bt + (size_t)(n0 + c) * ldb + k);
            float s = acc[c];
            s = fmaf(af[0], bf2f(b.x & 0xffffu), s); s = fmaf(af[1], bf2f(b.x >> 16), s); s = fmaf(af[2], bf2f(b.y & 0xffffu), s); s = fmaf(af[3], bf2f(b.y >> 16), s);
            s = fmaf(af[4], bf2f(b.z & 0xffffu), s); s = fmaf(af[5], bf2f(b.z >> 16), s); s = fmaf(af[6], bf2f(b.w & 0xffffu), s); s = fmaf(af[7], bf2f(b.w >> 16), s);
            acc[c] = s;
        }
    }
    if (valid) {
        float ss = 0.f;
#pragma unroll
        for (int q = 0; q < 16; ++q) { const f32x4 v = f(m, n0 + 4 * q, (f32x4){acc[4 * q], acc[4 * q + 1], acc[4 * q + 2], acc[4 * q + 3]});
            ss += (v.x * v.x + v.y * v.y) + (v.z * v.z + v.w * v.w); }
        f.partial(m, n0 >> 6, ss);
    }
}
template <class F>
__device__ __forceinline__ void naive_gemm(const bf16_t* A, int lda, const bf16_t* Bt, int ldb, int M, int N, int K, const F& f, int wg, int nwg) {
    const int lane = threadIdx.x & 63, gw = wg * 8 + (threadIdx.x >> 6), NGW = nwg * 8;
    const int nmt = M / 64, nnt = N / 64;
    for (int it = gw; it < nmt * nnt; it += NGW) { const int mt = it % nmt, nt = it / nmt;
        naive_gemm_item(A, lda, Bt, ldb, K, mt * 64, 64, nt * 64, f, RowId{}, lane); }
}

__device__ __forceinline__ void st_bf4(bf16_t* p, f32x4 v) { u32x2 w; w.x = pk2(v.x, v.y); w.y = pk2(v.z, v.w); *(u32x2*)p = w; }
struct FProj { bf16_t* proj; const float* rstd; float* partq;
    __device__ __forceinline__ f32x4 operator()(int m, int c, f32x4 v) const { v = v * rstd[m]; st_bf4(proj + (size_t)m * DINP + c, v); return v; }
    __device__ __forceinline__ void partial(int m, int g, float ss) const { if (g < 12) partq[m * 12 + g] = ss; } };
struct FPP { bf16_t* pp;
    __device__ __forceinline__ f32x4 operator()(int m, int c, f32x4 v) const { st_bf4(pp + (size_t)m * D_ + c, v); return v; }
    __device__ __forceinline__ void partial(int, int, float) const {} };
struct FQ { bf16_t* Qb; const float* partq; const float* cs; const float* sn;
    __device__ __forceinline__ f32x4 operator()(int m, int c, f32x4 v) const {
        float ss = 0.f;
#pragma unroll
        for (int i = 0; i < 8; ++i) ss += partq[m * 12 + i];
        v = v * (QSCALE / sqrtf(ss * (1.f / 512.f) + EPS));
        if (c < 1024) { st_bf4(Qb + (size_t)m * 1536 + (c >> 7) * 192 + (c & 127), v); }
        else { const int r = c - 1024, h = r >> 6, j = r & 63, i0 = j >> 1;
            const float c0 = cs[m * 32 + i0], s0 = sn[m * 32 + i0], c1 = cs[m * 32 + i0 + 1], s1 = sn[m * 32 + i0 + 1];
            const f32x4 o = {v.x * c0 - v.y * s0, v.y * c0 + v.x * s0, v.z * c1 - v.w * s1, v.w * c1 + v.z * s1};
            st_bf4(Qb + (size_t)m * 1536 + h * 192 + 128 + j, o); }
        return v; }
    __device__ __forceinline__ void partial(int, int, float) const {} };
struct FKV { bf16_t* Kb; bf16_t* Vb; const float* partq;
    __device__ __forceinline__ f32x4 operator()(int m, int c, f32x4 v) const {
        const float ss = (partq[m * 12 + 8] + partq[m * 12 + 9]) + (partq[m * 12 + 10] + partq[m * 12 + 11]);
        v = v * (1.f / sqrtf(ss * (1.f / 256.f) + EPS));
        if (c < 1024) st_bf4(Kb + (size_t)m * 1536 + (c >> 7) * 192 + (c & 127), v); else st_bf4(Vb + (size_t)m * 1024 + (c - 1024), v);
        return v; }
    __device__ __forceinline__ void partial(int, int, float) const {} };
struct FOut { const float* x; float* out; bf16_t* hb; float* part;
    __device__ __forceinline__ f32x4 operator()(int m, int c, f32x4 v) const { const f32x4 h = *(const f32x4*)(x + (size_t)m * D_ + c) + v;
        *(f32x4*)(out + (size_t)m * D_ + c) = h; st_bf4(hb + (size_t)m * D_ + c, h); return h; }
    __device__ __forceinline__ void partial(int m, int g, float ss) const { part[m * 32 + g] = ss; } };
struct FPle { float* out; const bf16_t* pp; const float* rstd; const float* bias; float* part;
    __device__ __forceinline__ f32x4 operator()(int m, int c, f32x4 v) const {
        const float r = rstd[m]; const f32x4 b = *(const f32x4*)(bias + c); const u32x2 pw = *(const u32x2*)(pp + (size_t)m * D_ + c);
        const f32x4 pv = {bf2f(pw.x & 0xffffu), bf2f(pw.x >> 16), bf2f(pw.y & 0xffffu), bf2f(pw.y >> 16)};
        f32x4 h = *(const f32x4*)(out + (size_t)m * D_ + c);
        h.x += sigmoidf_(v.x * r + b.x) * pv.x; h.y += sigmoidf_(v.y * r + b.y) * pv.y; h.z += sigmoidf_(v.z * r + b.z) * pv.z; h.w += sigmoidf_(v.w * r + b.w) * pv.w;
        *(f32x4*)(out + (size_t)m * D_ + c) = h; return h; }
    __device__ __forceinline__ void partial(int m, int g, float ss) const { part[m * 32 + g] = ss; } };

__device__ __forceinline__ void kpe_run(const Params& P, int wg, int nwg) {
    const int gt = wg * 512 + threadIdx.x, NGT = nwg * 512;
    const bf16_t* proj = WSP(bf16_t, WS_PROJ); bf16_t* Kb = WSP(bf16_t, WS_KB); const float* cs = WSP(float, WS_COS); const float* sn = WSP(float, WS_SIN);
    for (int i = gt; i < S_ * 32; i += NGT) { const int m = i >> 5, j = i & 31;
        const unsigned w = *(const unsigned*)(proj + (size_t)m * DINP + PC_KPE + 2 * j);
        const float a = bf2f(w & 0xffffu), b = bf2f(w >> 16), c = cs[i], s = sn[i];
        const unsigned o = pk2(a * c - b * s, b * c + a * s);
#pragma unroll
        for (int h = 0; h < NH; ++h) *(unsigned*)(Kb + (size_t)m * 1536 + h * 192 + 128 + 2 * j) = o; }
}

__device__ __forceinline__ void attn_naive_run(const Params& P, int wg, int nwg) {
    const int lane = threadIdx.x & 63, gw = wg * 8 + (threadIdx.x >> 6), NGW = nwg * 8;
    const bf16_t* Qb = WSP(bf16_t, WS_QB); const bf16_t* Kb = WSP(bf16_t, WS_KB); const bf16_t* Vb = WSP(bf16_t, WS_VB);
    bf16_t* Op = WSP(bf16_t, WS_OPART); float* ml = WSP(float, WS_ML);
    for (int it = gw; it < S_ * NH; it += NGW) {
        const int h = it & 7, m = S_ - 1 - (it >> 3);
        const bf16_t* q = Qb + (size_t)m * 1536 + h * 192 + 3 * lane;
        const float q0 = bf2f(q[0]), q1 = bf2f(q[1]), q2 = bf2f(q[2]);
        float mx = -1e30f, l = 0.f, o0 = 0.f, o1 = 0.f;
        for (int key = 0; key <= m; ++key) {
            const bf16_t* kr = Kb + (size_t)key * 1536 + h * 192 + 3 * lane;
            float s = q0 * bf2f(kr[0]) + q1 * bf2f(kr[1]) + q2 * bf2f(kr[2]);
            s = wave_sum(s);
            const float mn = fmaxf(mx, s), al = exp2f(mx - mn), p = exp2f(s - mn);
            const unsigned vw = *(const unsigned*)(Vb + (size_t)key * 1024 + h * 128 + 2 * lane);
            l = l * al + p; o0 = o0 * al + p * bf2f(vw & 0xffffu); o1 = o1 * al + p * bf2f(vw >> 16); mx = mn;
        }
        const float rl = 1.f / l;
        *(unsigned*)(Op + (size_t)m * 1024 + h * 128 + 2 * lane) = pk2(o0 * rl, o1 * rl);
        *(unsigned*)(Op + (size_t)S_ * 1024 + (size_t)m * 1024 + h * 128 + 2 * lane) = 0u;
        if (lane == 0) { float* a = ml + ((size_t)m * 8 + h) * 2; a[0] = 0.f; a[1] = 1.f; float* b = ml + (size_t)S_ * 16 + ((size_t)m * 8 + h) * 2; b[0] = -1e30f; b[1] = 0.f; }
    }
}
__device__ __forceinline__ void combine_run(const Params& P, int wg, int nwg) {
    const int lane = threadIdx.x & 63, gw = wg * 8 + (threadIdx.x >> 6), NGW = nwg * 8;
    const bf16_t* Op = WSP(bf16_t, WS_OPART); const float* ml = WSP(float, WS_ML); bf16_t* ymix = WSP(bf16_t, WS_YMIX);
    for (int m = gw; m < S_; m += NGW) {
        const int h = lane >> 3;
        const float m0 = ml[((size_t)m * 8 + h) * 2], l0 = ml[((size_t)m * 8 + h) * 2 + 1];
        const float m1 = ml[(size_t)S_ * 16 + ((size_t)m * 8 + h) * 2], l1 = ml[(size_t)S_ * 16 + ((size_t)m * 8 + h) * 2 + 1];
        const float mm = fmaxf(m0, m1); float w0 = l0 * exp2f(m0 - mm), w1 = l1 * exp2f(m1 - mm); const float rs = 1.f / (w0 + w1); w0 *= rs; w1 *= rs;
        const u32x4* a = (const u32x4*)(Op + (size_t)m * 1024 + 16 * lane); const u32x4* b = (const u32x4*)(Op + (size_t)S_ * 1024 + (size_t)m * 1024 + 16 * lane);
        float o[16]; float ss = 0.f;
#pragma unroll
        for (int j = 0; j < 2; ++j) { const u32x4 ua = a[j], ub = b[j]; const unsigned wa[4] = {ua.x, ua.y, ua.z, ua.w}, wb[4] = {ub.x, ub.y, ub.z, ub.w};
#pragma unroll
            for (int i = 0; i < 4; ++i) { o[8 * j + 2 * i] = w0 * bf2f(wa[i] & 0xffffu) + w1 * bf2f(wb[i] & 0xffffu); o[8 * j + 2 * i + 1] = w0 * bf2f(wa[i] >> 16) + w1 * bf2f(wb[i] >> 16); } }
#pragma unroll
        for (int i = 0; i < 16; ++i) ss += o[i] * o[i];
        ss = wave_sum(ss); const float r = 1.f / sqrtf(ss * (1.f / 1024.f) + EPS);
        u32x4 w0v, w1v;
        w0v.x = pk2(o[0] * r, o[1] * r); w0v.y = pk2(o[2] * r, o[3] * r); w0v.z = pk2(o[4] * r, o[5] * r); w0v.w = pk2(o[6] * r, o[7] * r);
        w1v.x = pk2(o[8] * r, o[9] * r); w1v.y = pk2(o[10] * r, o[11] * r); w1v.z = pk2(o[12] * r, o[13] * r); w1v.w = pk2(o[14] * r, o[15] * r);
        u32x4* y = (u32x4*)(ymix + (size_t)m * D_ + 16 * lane); y[0] = w0v; y[1] = w1v;
    }
}

__device__ __forceinline__ void hgrn_naive_run(const Params& P, int wg, LAS unsigned char* lds) {
    if (wg >= NH) return;
    const int h = wg, tid = threadIdx.x; const bool act = tid < 128; const int v = tid & 127;
    const bf16_t* proj = WSP(bf16_t, WS_PROJ); const float* lb = WSP(float, WS_LB); bf16_t* ymix = WSP(bf16_t, WS_YMIX);
    LAS float* sf = (LAS float*)lds; LAS float* sq = sf + 128; LAS float* red = sq + 128;
    float st[128];
#pragma unroll
    for (int k = 0; k < 128; ++k) st[k] = 0.f;
    for (int t = 0; t < S_; ++t) {
        const bf16_t* pr = proj + (size_t)t * DINP;
        if (act) { const float l = lb[h * 128 + v]; sf[v] = l + (1.f - l) * sigmoidf_(bf2f(pr[PC_HF + h * 128 + v])); sq[v] = siluf_(bf2f(pr[PC_HQ + h * 128 + v])); }
        __syncthreads();
        float o = 0.f;
        if (act) { const float iv = bf2f(pr[PC_HI + h * 128 + v]);
#pragma unroll
            for (int k = 0; k < 128; ++k) { const float f = sf[k]; st[k] = f * st[k] + (1.f - f) * iv; o += sq[k] * st[k]; } }
        float ss = act ? o * o : 0.f; ss = wave_sum(ss);
        if (act && (tid & 63) == 0) red[tid >> 6] = ss;
        __syncthreads();
        if (act) { const float r = 1.f / sqrtf((red[0] + red[1]) * (1.f / 128.f) + EPS);
            ymix[(size_t)t * D_ + 1024 + h * 128 + v] = (bf16_t)f2bf(o * r * siluf_(bf2f(pr[PC_HG + h * 128 + v]))); }
    }
}

__device__ __forceinline__ void route_run(const Params& P, int wg, int nwg, LAS unsigned char* lds) {
    const int lane = threadIdx.x & 63, wave = threadIdx.x >> 6, gw = wg * 8 + wave, NGW = nwg * 8;
    const float* h1 = P.out; const float* Wr = WSP(float, WS_WR); const float* part1 = WSP(float, WS_PART1);
    LAS float* lg = (LAS float*)lds + wave * 96;
    int* cnt = WSP(int, WS_CTL); int* list = WSP(int, WS_LIST); int* eid = WSP(int, WS_EID); float* ew = WSP(float, WS_EW); float* rstd1 = WSP(float, WS_RSTD1);
    for (int t = gw; t < S_; t += NGW) {
        float ss = (lane < 32) ? part1[t * 32 + lane] : 0.f; ss = wave_sum(ss); const float r = 1.f / sqrtf(ss * (1.f / D_) + EPS);
        float a0 = 0.f, a1 = 0.f; const float* hr = h1 + (size_t)t * D_;
        for (int k = 0; k < D_; ++k) { const float hv = hr[k]; a0 = fmaf(hv, Wr[k * 80 + lane], a0); if (lane < 16) a1 = fmaf(hv, Wr[k * 80 + 64 + lane], a1); }
        lg[lane] = a0 * r; if (lane < 16) lg[64 + lane] = a1 * r;
        asm volatile("s_waitcnt lgkmcnt(0)" ::: "memory");
        if (lane == 0) {
            rstd1[t] = r;
            int g = 0; float gm = -INFINITY;
            for (int i = 0; i < 8; ++i) { const float v = lg[i] + P.b_rg[i]; if (v > gm) { gm = v; g = i; } }
            float gs = 0.f; for (int i = 0; i < 8; ++i) gs += expf(lg[i] + P.b_rg[i] - gm);
            const float gw_ = 1.f / gs;
            int i1 = 0, i2 = 0; float l1 = -INFINITY, l2 = -INFINITY;
            for (int i = 0; i < 8; ++i) { const float e = lg[8 + g * 8 + i] + P.b_re[g * 8 + i];
                if (e > l1) { l2 = l1; i2 = i1; l1 = e; i1 = i; } else if (e > l2) { l2 = e; i2 = i; } }
            const float p2 = expf(l2 - l1), w1 = gw_ / (1.f + p2), w2 = gw_ * p2 / (1.f + p2);
            const int e1 = g * 8 + i1, e2 = g * 8 + i2;
            eid[2 * t] = e1; eid[2 * t + 1] = e2; ew[2 * t] = w1; ew[2 * t + 1] = w2;
            const int p1 = atomicAdd(&cnt[e1], 1); list[e1 * LISTCAP + p1] = 2 * t;
            const int q2 = atomicAdd(&cnt[e2], 1); list[e2 * LISTCAP + q2] = 2 * t + 1;
        }
        asm volatile("s_waitcnt lgkmcnt(0)" ::: "memory");
    }
}

__device__ __forceinline__ void moe_up_naive_run(const Params& P, int wg, int nwg) {
    const int lane = threadIdx.x & 63, gw = wg * 8 + (threadIdx.x >> 6), NGW = nwg * 8;
    const int* cnt = WSP(int, WS_CTL); const int* list = WSP(int, WS_LIST); const float* rstd1 = WSP(float, WS_RSTD1);
    const bf16_t* h1b = WSP(bf16_t, WS_H1B); bf16_t* hmid = WSP(bf16_t, WS_HMID);
    int off = 0, tbase = 0;
    for (int e = 0; e < NE; ++e) {
        const int n = cnt[e], nrg = (n + 63) >> 6, nit = nrg * 16;
        for (int it = gw - off; it < nit; it += NGW) {
            if (it < 0) continue;
            const int rg = it >> 4, cg = it & 15, c0 = cg * 32;
            const int nrows = (n - rg * 64) < 64 ? (n - rg * 64) : 64;
            const int a = list[e * LISTCAP + rg * 64 + (lane < nrows ? lane : 0)]; const int tok = a >> 1;
            const bf16_t* ar = h1b + (size_t)tok * D_;
            const bf16_t* W = WSP(bf16_t, WS_WGU) + (size_t)e * 1024 * 2048;
            const int pn = c0 >> 7, rr = c0 & 127;
            float ag[32], au[32];
#pragma unroll
            for (int c = 0; c < 32; ++c) { ag[c] = 0.f; au[c] = 0.f; }
            for (int k = 0; k < D_; k += 8) {
                const u32x4 av = *(const u32x4*)(ar + k); float af[8];
                af[0] = bf2f(av.x & 0xffffu); af[1] = bf2f(av.x >> 16); af[2] = bf2f(av.y & 0xffffu); af[3] = bf2f(av.y >> 16);
                af[4] = bf2f(av.z & 0xffffu); af[5] = bf2f(av.z >> 16); af[6] = bf2f(av.w & 0xffffu); af[7] = bf2f(av.w >> 16);
#pragma unroll
                for (int c = 0; c < 32; ++c) {
                    const u32x4 bg = *(const u32x4*)(W + (size_t)(pn * 256 + rr + c) * 2048 + k); const u32x4 bu = *(const u32x4*)(W + (size_t)(pn * 256 + 128 + rr + c) * 2048 + k);
                    float s = ag[c], u = au[c];
                    s = fmaf(af[0], bf2f(bg.x & 0xffffu), s); s = fmaf(af[1], bf2f(bg.x >> 16), s); s = fmaf(af[2], bf2f(bg.y & 0xffffu), s); s = fmaf(af[3], bf2f(bg.y >> 16), s);
                    s = fmaf(af[4], bf2f(bg.z & 0xffffu), s); s = fmaf(af[5], bf2f(bg.z >> 16), s); s = fmaf(af[6], bf2f(bg.w & 0xffffu), s); s = fmaf(af[7], bf2f(bg.w >> 16), s);
                    u = fmaf(af[0], bf2f(bu.x & 0xffffu), u); u = fmaf(af[1], bf2f(bu.x >> 16), u); u = fmaf(af[2], bf2f(bu.y & 0xffffu), u); u = fmaf(af[3], bf2f(bu.y >> 16), u);
                    u = fmaf(af[4], bf2f(bu.z & 0xffffu), u); u = fmaf(af[5], bf2f(bu.z >> 16), u); u = fmaf(af[6], bf2f(bu.w & 0xffffu), u); u = fmaf(af[7], bf2f(bu.w >> 16), u);
                    ag[c] = s; au[c] = u;
                }
            }
            if (lane < nrows) { const float r = rstd1[tok]; const int slot = tbase * 256 + rg * 64 + lane;
#pragma unroll
                for (int c = 0; c < 32; c += 2) *(unsigned*)(hmid + (size_t)slot * DE + c0 + c) = pk2(siluf_(ag[c] * r) * (au[c] * r), siluf_(ag[c + 1] * r) * (au[c + 1] * r)); }
        }
        off = (off + nit) % NGW; tbase += (n + 255) >> 8;
    }
}
struct FDown { bf16_t* y; const int* lst; int slot0; const float* ew;
    __device__ __forceinline__ f32x4 operator()(int m, int c, f32x4 v) const { const int a = lst[m - slot0]; v = v * ew[a]; st_bf4(y + (size_t)a * D_ + c, v); return v; }
    __device__ __forceinline__ void partial(int, int, float) const {} };
__device__ __forceinline__ void moe_down_naive_run(const Params& P, int wg, int nwg) {
    const int lane = threadIdx.x & 63, gw = wg * 8 + (threadIdx.x >> 6), NGW = nwg * 8;
    const int* cnt = WSP(int, WS_CTL); const int* list = WSP(int, WS_LIST); const float* ew = WSP(float, WS_EW);
    const bf16_t* hmid = WSP(bf16_t, WS_HMID); bf16_t* y = WSP(bf16_t, WS_Y);
    int off = 0, tbase = 0;
    for (int e = 0; e < NE; ++e) {
        const int n = cnt[e], nrg = (n + 63) >> 6, nit = nrg * 32;
        for (int it = gw - off; it < nit; it += NGW) {
            if (it < 0) continue;
            const int rg = it >> 5, cg = it & 31; const int nrows = (n - rg * 64) < 64 ? (n - rg * 64) : 64;
            const int slot0 = tbase * 256 + rg * 64;
            FDown f{y, list + e * LISTCAP + rg * 64, slot0, ew};
            naive_gemm_item(hmid, DE, WSP(bf16_t, WS_WD) + (size_t)e * 2048 * DE, DE, DE, slot0, nrows, cg * 64, f, RowId{}, lane);
        }
        off = (off + nit) % NGW; tbase += (n + 255) >> 8;
    }
}
__device__ __forceinline__ void moe_combine_run(const Params& P, int wg, int nwg) {
    const int lane = threadIdx.x & 63, gw = wg * 8 + (threadIdx.x >> 6), NGW = nwg * 8;
    const bf16_t* y = WSP(bf16_t, WS_Y); bf16_t* h2b = WSP(bf16_t, WS_H2B); float* rstd2 = WSP(float, WS_RSTD2);
    for (int m = gw; m < S_; m += NGW) {
        f32x4* hr = (f32x4*)(P.out + (size_t)m * D_) + lane; const u32x2* y0 = (const u32x2*)(y + (size_t)(2 * m) * D_) + lane; const u32x2* y1 = (const u32x2*)(y + (size_t)(2 * m + 1) * D_) + lane;
        u32x2* ob = (u32x2*)(h2b + (size_t)m * D_) + lane; float ss = 0.f;
#pragma unroll
        for (int j = 0; j < 8; ++j) { f32x4 h = hr[64 * j]; const u32x2 a = y0[64 * j], b = y1[64 * j];
            h.x += bf2f(a.x & 0xffffu) + bf2f(b.x & 0xffffu); h.y += bf2f(a.x >> 16) + bf2f(b.x >> 16); h.z += bf2f(a.y & 0xffffu) + bf2f(b.y & 0xffffu); h.w += bf2f(a.y >> 16) + bf2f(b.y >> 16);
            hr[64 * j] = h; u32x2 w; w.x = pk2(h.x, h.y); w.y = pk2(h.z, h.w); ob[64 * j] = w; ss += (h.x * h.x + h.y * h.y) + (h.z * h.z + h.w * h.w); }
        ss = wave_sum(ss); if (lane == 0) rstd2[m] = 1.f / sqrtf(ss * (1.f / D_) + EPS);
    }
}
__device__ __forceinline__ void final_run(const Params& P, int wg, int nwg) {
    const int lane = threadIdx.x & 63, gw = wg * 8 + (threadIdx.x >> 6), NGW = nwg * 8; const float* part3 = WSP(float, WS_PART3);
    for (int m = gw; m < S_; m += NGW) {
        float ss = (lane < 32) ? part3[m * 32 + lane] : 0.f; ss = wave_sum(ss); const float r = 1.f / sqrtf(ss * (1.f / D_) + EPS);
        f32x4* hr = (f32x4*)(P.out + (size_t)m * D_) + lane; const f32x4* g = (const f32x4*)P.final_norm + lane;
#pragma unroll
        for (int j = 0; j < 8; ++j) hr[64 * j] = hr[64 * j] * r * g[64 * j];
    }
}

constexpr int LDS_BYTES = 8 * 8704;
template <int stage> __global__ void __launch_bounds__(512) k_stage(Params P) {
    extern __shared__ __attribute__((aligned(16))) unsigned char lds_raw[];
    LAS unsigned char* lds = (LAS unsigned char*)lds_raw;
    const int wg = blockIdx.x, nwg = gridDim.x;
    switch (stage) {
    case 0: p0_run(P, wg, nwg, lds); break;
    case 1: naive_gemm(WSP(bf16_t, WS_XB), D_, WSP(bf16_t, WS_WIN), D_, S_, DINP, D_, FProj{WSP(bf16_t, WS_PROJ), WSP(float, WS_RSTDX), WSP(float, WS_PARTQ)}, wg, nwg);
            naive_gemm(WSP(bf16_t, WS_PB), PLE, WSP(bf16_t, WS_WPP), PLE, S_, D_, PLE, FPP{WSP(bf16_t, WS_PP)}, wg, nwg); break;
    case 2: naive_gemm(WSP(bf16_t, WS_PROJ) + PC_CQ, DINP, WSP(bf16_t, WS_WUQ), 512, S_, 1536, 512, FQ{WSP(bf16_t, WS_QB), WSP(float, WS_PARTQ), WSP(float, WS_COS), WSP(float, WS_SIN)}, wg, nwg);
            naive_gemm(WSP(bf16_t, WS_PROJ) + PC_CKV, DINP, WSP(bf16_t, WS_WUKV), 256, S_, 2048, 256, FKV{WSP(bf16_t, WS_KB), WSP(bf16_t, WS_VB), WSP(float, WS_PARTQ)}, wg, nwg);
            kpe_run(P, wg, nwg); break;
    case 3: attn_naive_run(P, wg, nwg); break;
    case 4: hgrn_naive_run(P, wg, lds); break;
    case 5: combine_run(P, wg, nwg); break;
    case 6: naive_gemm(WSP(bf16_t, WS_YMIX), D_, WSP(bf16_t, WS_WOUT), D_, S_, D_, D_, FOut{P.x, P.out, WSP(bf16_t, WS_H1B), WSP(float, WS_PART1)}, wg, nwg); break;
    case 7: route_run(P, wg, nwg, lds); break;
    case 8: moe_up_naive_run(P, wg, nwg); break;
    case 9: moe_down_naive_run(P, wg, nwg); break;
    case 10: moe_combine_run(P, wg, nwg); break;
    case 11: naive_gemm(WSP(bf16_t, WS_H2B), D_, WSP(bf16_t, WS_WPG), D_, S_, D_, D_, FPle{P.out, WSP(bf16_t, WS_PP), WSP(float, WS_RSTD2), P.b_pg, WSP(float, WS_PART3)}, wg, nwg); break;
    case 12: final_run(P, wg, nwg); break;
    }
}

extern "C" void kernel_launch(void* const* d_in, const int* in_sizes, int n_in, void* d_out, int out_size, void* d_ws, size_t ws_size, hipStream_t stream) {
    if (n_in != 26 || ws_size < WS_END) { fprintf(stderr, "kernel_launch: unexpected n_in %d or ws_size %zu (< %zu)\n", n_in, ws_size, (size_t)WS_END); return; }
    static bool attr = false;
    if (!attr) { attr = true; (void)hipFuncSetAttribute((const void*)k_stage<0>, hipFuncAttributeMaxDynamicSharedMemorySize, LDS_BYTES); }
    Params P{};
    P.x = (const float*)d_in[0]; P.p = (const float*)d_in[1]; P.pos = (const int*)d_in[2];
    P.attn_norm = (const float*)d_in[3]; P.w_in = (const float*)d_in[4]; P.q_norm = (const float*)d_in[5]; P.w_uq = (const float*)d_in[6];
    P.kv_norm = (const float*)d_in[7]; P.w_ukv = (const float*)d_in[8]; P.mla_norm = (const float*)d_in[9]; P.lb_logits = (const float*)d_in[10];
    P.hg_norm = (const float*)d_in[11]; P.w_out = (const float*)d_in[12]; P.ffn_norm = (const float*)d_in[13];
    P.w_rg = (const float*)d_in[14]; P.b_rg = (const float*)d_in[15]; P.w_re = (const float*)d_in[16]; P.b_re = (const float*)d_in[17];
    P.w_eg = (const float*)d_in[18]; P.w_eu = (const float*)d_in[19]; P.w_ed = (const float*)d_in[20];
    P.ple_norm = (const float*)d_in[21]; P.w_pg = (const float*)d_in[22]; P.b_pg = (const float*)d_in[23]; P.w_pp = (const float*)d_in[24]; P.final_norm = (const float*)d_in[25];
    P.out = (float*)d_out; P.ws = (unsigned char*)d_ws;
    (void)hipMemsetAsync((char*)d_ws + WS_CTL, 0, 1 * MiB, stream);
#define LAUNCH(st, g, l) hipLaunchKernelGGL(k_stage<st>, dim3(g), dim3(512), l, stream, P)
    LAUNCH(0, 1024, LDS_BYTES); LAUNCH(1, 1024, 0); LAUNCH(2, 1024, 0); LAUNCH(3, 1024, 0); LAUNCH(4, 8, 4096); LAUNCH(5, 1024, 0); LAUNCH(6, 1024, 0);
    LAUNCH(7, 1024, 4096); LAUNCH(8, 1024, 0); LAUNCH(9, 1024, 0); LAUNCH(10, 1024, 0); LAUNCH(11, 1024, 0); LAUNCH(12, 1024, 0);
#undef LAUNCH
}
```

```cpp
#include <hip/hip_runtime.h>
#include <hip/hip_cooperative_groups.h>
#include <cstdint>
#include <cstdio>

#define LAS __attribute__((address_space(3)))
typedef unsigned short bf16_t;
typedef float f32x4 __attribute__((ext_vector_type(4)));
typedef unsigned u32x4 __attribute__((ext_vector_type(4)));
typedef unsigned u32x2 __attribute__((ext_vector_type(2)));

constexpr int S_ = 8192, D_ = 2048, DIN = 4928, DINP = 5120;
constexpr int NH = 8, QKD = 192, VD = 128;
constexpr int NE = 64, DE = 512, PLE = 256;
constexpr float EPS = 1e-6f;
constexpr float QSCALE = 0.07216878364870323f * 1.4426950408889634f;
constexpr int PC_CQ = 0, PC_CKV = 512, PC_HQ = 768, PC_HF = 1792, PC_HI = 2816, PC_HG = 3840, PC_KPE = 4864;
constexpr int LISTCAP = 8192;

constexpr size_t MiB = 1u << 20;
constexpr size_t WS_CTL = 0;
constexpr size_t WS_RSTDX = 1 * MiB, WS_RSTD1 = WS_RSTDX + 32768, WS_RSTD2 = WS_RSTD1 + 32768, WS_LB = WS_RSTD2 + 32768, WS_TILEB = WS_LB + 4096;
constexpr size_t WS_COS = 2 * MiB, WS_SIN = 3 * MiB, WS_PARTQ = 4 * MiB, WS_PART1 = 5 * MiB, WS_PART3 = 6 * MiB, WS_WR = 7 * MiB;
constexpr size_t WS_ML = 8 * MiB, WS_DVEC = 9 * MiB, WS_EID = 10 * MiB, WS_EW = WS_EID + 65536, WS_LIST = 11 * MiB;
constexpr size_t WS_WUQ = 16 * MiB, WS_WUKV = 18 * MiB, WS_WPP = 19 * MiB, WS_WIN = 20 * MiB, WS_WOUT = 40 * MiB, WS_WPG = 48 * MiB;
constexpr size_t WS_PB = 56 * MiB, WS_XB = 64 * MiB, WS_PROJ = 96 * MiB, WS_PP = 176 * MiB, WS_QB = 208 * MiB, WS_KB = 232 * MiB, WS_VB = 256 * MiB;
constexpr size_t WS_LST = 272 * MiB, WS_SST = 304 * MiB, WS_OPART = 336 * MiB, WS_YMIX = 368 * MiB, WS_H1B = 400 * MiB, WS_H2B = 432 * MiB;
constexpr size_t WS_HMID = 464 * MiB, WS_Y = 496 * MiB, WS_WGU = 560 * MiB, WS_WD = 816 * MiB, WS_END = 944 * MiB;

struct Params {
    const float *x, *p; const int* pos;
    const float *attn_norm, *w_in, *q_norm, *w_uq, *kv_norm, *w_ukv, *mla_norm, *lb_logits, *hg_norm, *w_out, *ffn_norm;
    const float *w_rg, *b_rg, *w_re, *b_re, *w_eg, *w_eu, *w_ed, *ple_norm, *w_pg, *b_pg, *w_pp, *final_norm;
    float* out; unsigned char* ws;
};
#define WSP(T, off) ((T*)(P.ws + (off)))

__device__ __forceinline__ unsigned f2bf(float f) { unsigned u = __builtin_bit_cast(unsigned, f); return (u + 0x7fffu + ((u >> 16) & 1u)) >> 16; }
__device__ __forceinline__ float bf2f(unsigned h) { return __builtin_bit_cast(float, h << 16); }
__device__ __forceinline__ unsigned pk2(float lo, float hi) { return f2bf(lo) | (f2bf(hi) << 16); }
__device__ __forceinline__ float wave_sum(float v) {
#pragma unroll
    for (int o = 1; o < 64; o <<= 1) v += __shfl_xor(v, o);
    return v;
}
__device__ __forceinline__ float sigmoidf_(float x) { return 1.f / (1.f + __expf(-x)); }
__device__ __forceinline__ float siluf_(float x) { return x / (1.f + __expf(-x)); }

struct SrcWin { const float* W; const float* g;
    __device__ __forceinline__ float operator()(int k, int n) const {
        int src;
        if (n < 768) src = n;
        else if (n < 4864) src = n + 64;
        else if (n < 4928) { const int j = n - 4864; src = 768 + ((j & 1) ? 32 + (j >> 1) : (j >> 1)); }
        else return 0.f;
        return W[(size_t)k * DIN + src] * g[k];
    } };
struct SrcWuq { const float* W; const float* g;
    __device__ __forceinline__ float operator()(int k, int n) const {
        int src;
        if (n < 1024) src = (n >> 7) * 192 + (n & 127);
        else { const int r = n - 1024, h = r >> 6, j = r & 63; src = h * 192 + 128 + ((j & 1) ? 32 + (j >> 1) : (j >> 1)); }
        return W[(size_t)k * 1536 + src] * g[k];
    } };
struct SrcWukv { const float* W; const float* g;
    __device__ __forceinline__ float operator()(int k, int n) const {
        int src;
        if (n < 1024) src = (n >> 7) * 256 + (n & 127);
        else { const int r = n - 1024; src = (r >> 7) * 256 + 128 + (r & 127); }
        return W[(size_t)k * 2048 + src] * g[k];
    } };
struct SrcWout { const float* W; const float* g0; const float* g1;
    __device__ __forceinline__ float operator()(int k, int n) const { return W[(size_t)k * 2048 + n] * (k < 1024 ? g0[k] : g1[k - 1024]); } };
struct SrcPlain { const float* W; const float* g; int N;
    __device__ __forceinline__ float operator()(int k, int n) const { const float w = W[(size_t)k * N + n]; return g ? w * g[k] : w; } };
struct SrcGU { const float* W; const float* g;
    __device__ __forceinline__ float operator()(int k, int n) const { return W[(size_t)k * DE + 128 * (n >> 8) + (n & 127)] * g[k]; } };

template <class Src>
__device__ __forceinline__ void tconv_item(const Src& src, int K, int nblk, bf16_t* WT, LAS float* scr, int item, int lane) {
    const int kb = item / nblk, nb = item % nblk, k0 = 64 * kb, n0 = 32 * nb;
#pragma unroll 8
    for (int i = 0; i < 32; ++i) { const int kk = 2 * i + (lane >> 5); scr[kk * 33 + (lane & 31)] = src(k0 + kk, n0 + (lane & 31)); }
    asm volatile("s_waitcnt lgkmcnt(0)" ::: "memory");
    const int c = lane & 7;
#pragma unroll
    for (int j = 0; j < 4; ++j) { const int n = (lane >> 3) + 8 * j; const LAS float* s = scr + (8 * c) * 33 + n;
        u32x4 o; o.x = pk2(s[0 * 33], s[1 * 33]); o.y = pk2(s[2 * 33], s[3 * 33]); o.z = pk2(s[4 * 33], s[5 * 33]); o.w = pk2(s[6 * 33], s[7 * 33]);
        *(u32x4*)(WT + (size_t)(n0 + n) * K + k0 + 8 * c) = o; }
    asm volatile("s_waitcnt lgkmcnt(0)" ::: "memory");
}

__device__ __forceinline__ void p0_run(const Params& P, int wg, int nwg, LAS unsigned char* lds) {
    const int tid = threadIdx.x, lane = tid & 63, wave = tid >> 6;
    const int gw = wg * 8 + wave, NGW = nwg * 8;
    LAS float* scr = (LAS float*)(lds + wave * 8704);
    constexpr int I_WIN = 32 * 160, I_WUQ = 8 * 48, I_WUKV = 4 * 64, I_WOUT = 32 * 64, I_WPG = 32 * 64, I_WPP = 4 * 64, I_GU = 32 * 32, I_DN = 8 * 64;
    constexpr int NITEMS = I_WIN + I_WUQ + I_WUKV + I_WOUT + I_WPG + I_WPP + NE * I_GU + NE * I_DN;
    for (int it = gw; it < NITEMS; it += NGW) {
        int r = it;
        if (r < I_WIN) { tconv_item(SrcWin{P.w_in, P.attn_norm}, 2048, 160, WSP(bf16_t, WS_WIN), scr, r, lane); continue; } r -= I_WIN;
        if (r < I_WUQ) { tconv_item(SrcWuq{P.w_uq, P.q_norm}, 512, 48, WSP(bf16_t, WS_WUQ), scr, r, lane); continue; } r -= I_WUQ;
        if (r < I_WUKV) { tconv_item(SrcWukv{P.w_ukv, P.kv_norm}, 256, 64, WSP(bf16_t, WS_WUKV), scr, r, lane); continue; } r -= I_WUKV;
        if (r < I_WOUT) { tconv_item(SrcWout{P.w_out, P.mla_norm, P.hg_norm}, 2048, 64, WSP(bf16_t, WS_WOUT), scr, r, lane); continue; } r -= I_WOUT;
        if (r < I_WPG) { tconv_item(SrcPlain{P.w_pg, P.ple_norm, 2048}, 2048, 64, WSP(bf16_t, WS_WPG), scr, r, lane); continue; } r -= I_WPG;
        if (r < I_WPP) { tconv_item(SrcPlain{P.w_pp, nullptr, 2048}, 256, 64, WSP(bf16_t, WS_WPP), scr, r, lane); continue; } r -= I_WPP;
        if (r < NE * I_GU) { const int e = r / I_GU; r -= e * I_GU;
            const bool isup = (((r % 32) * 32) & 255) >= 128;
            const float* Wsel = isup ? P.w_eu : P.w_eg;
            tconv_item(SrcGU{Wsel + (size_t)e * 2048 * DE, P.ffn_norm}, 2048, 32, WSP(bf16_t, WS_WGU) + (size_t)e * 1024 * 2048, scr, r, lane); continue; }
        r -= NE * I_GU;
        { const int e = r / I_DN; r -= e * I_DN;
          tconv_item(SrcPlain{P.w_ed + (size_t)e * DE * 2048, nullptr, 2048}, DE, 64, WSP(bf16_t, WS_WD) + (size_t)e * 2048 * DE, scr, r, lane); }
    }
    for (int m = gw; m < S_; m += NGW) {
        const f32x4* xr = (const f32x4*)(P.x + (size_t)m * D_) + lane; f32x4 v[8]; float s = 0.f;
#pragma unroll
        for (int j = 0; j < 8; ++j) { v[j] = xr[64 * j]; s += (v[j].x * v[j].x + v[j].y * v[j].y) + (v[j].z * v[j].z + v[j].w * v[j].w); }
        s = wave_sum(s);
        if (lane == 0) WSP(float, WS_RSTDX)[m] = 1.f / sqrtf(s * (1.f / D_) + EPS);
        u32x2* o = (u32x2*)(WSP(bf16_t, WS_XB) + (size_t)m * D_) + lane;
#pragma unroll
        for (int j = 0; j < 8; ++j) { u32x2 w; w.x = pk2(v[j].x, v[j].y); w.y = pk2(v[j].z, v[j].w); o[64 * j] = w; }
    }
    const int gt = wg * 512 + tid, NGT = nwg * 512;
    for (int i = gt; i < S_ * PLE / 4; i += NGT) { const f32x4 v = ((const f32x4*)P.p)[i]; u32x2 w; w.x = pk2(v.x, v.y); w.y = pk2(v.z, v.w); WSP(u32x2, WS_PB)[i] = w; }
    for (int i = gt; i < S_ * 32; i += NGT) { const int s = i >> 5, j = i & 31;
        const float invf = exp2f(-(float)j * (13.287712379549449f / 32.0f));
        const double tr = (double)P.pos[s] * (double)invf * 0.15915494309189535;
        const float fr = (float)(tr - floor(tr));
        WSP(float, WS_COS)[i] = __builtin_amdgcn_cosf(fr); WSP(float, WS_SIN)[i] = __builtin_amdgcn_sinf(fr); }
    for (int i = gt; i < 1024; i += NGT) WSP(float, WS_LB)[i] = 1.f / (1.f + expf(P.lb_logits[1024 + i] - P.lb_logits[i]));
    for (int i = gt; i < 2048 * 80; i += NGT) { const int k = i / 80, c = i % 80;
        float w = 0.f; if (c < 8) w = P.w_rg[k * 8 + c]; else if (c < 72) w = P.w_re[k * 64 + (c - 8)];
        WSP(float, WS_WR)[i] = w * P.ffn_norm[k]; }
}

struct RowId { __device__ __forceinline__ int operator()(int m) const { return m; } };
template <class F, class RowMap>
__device__ __forceinline__ void naive_gemm_item(const bf16_t* A, int lda, const bf16_t* Bt, int ldb, int K, int m0, int nrows, int n0, const F& f, const RowMap& rm, int lane) {
    const int m = m0 + lane; const bool valid = lane < nrows;
    const bf16_t* ar = A + (size_t)rm(valid ? m : m0) * lda;
    float acc[64];
#pragma unroll
    for (int c = 0; c < 64; ++c) acc[c] = 0.f;
    for (int k = 0; k < K; k += 8) {
        const u32x4 a = *(const u32x4*)(ar + k);
        float af[8];
        af[0] = bf2f(a.x & 0xffffu); af[1] = bf2f(a.x >> 16); af[2] = bf2f(a.y & 0xffffu); af[3] = bf2f(a.y >> 16);
        af[4] = bf2f(a.z & 0xffffu); af[5] = bf2f(a.z >> 16); af[6] = bf2f(a.w & 0xffffu); af[7] = bf2f(a.w >> 16);
#pragma unroll
        for (int c = 0; c < 64; ++c) {
            const u32x4 b = *(const u32x4*)(Bt + (size_t)(n0 + c) * ldb + k);
            float s = acc[c];
            s = fmaf(af[0], bf2f(b.x & 0xffffu), s); s = fmaf(af[1], bf2f(b.x >> 16), s); s = fmaf(af[2], bf2f(b.y & 0xffffu), s); s = fmaf(af[3], bf2f(b.y >> 16), s);
            s = fmaf(af[4], bf2f(b.z & 0xffffu), s); s = fmaf(af[5], bf2f(b.z >> 16), s); s = fmaf(af[6], bf2f(b.w & 0xffffu), s); s = fmaf(af[7], bf2f(b.w >> 16), s);
            acc[c] = s;
        }
    }
    if (valid) {
        float ss = 0.f;
#pragma unroll
        for (int q = 0; q < 16; ++q) { const f32x4 v = f(m, n0 + 4 * q, (f32x4){acc[4 * q], acc[4 * q + 1], acc[4 * q + 2], acc[4 * q + 3]});
            ss += (v.x * v.x + v.y * v.y) + (v.z * v.z + v.w * v.w); }
        f.partial(m, n0 >> 6, ss);
    }
}
template <class F>
__device__ __forceinline__ void naive_gemm(const bf16_t* A, int lda, const bf16_t* Bt, int ldb, int M, int N, int K, const F& f, int wg, int nwg) {
    const int lane = threadIdx.x & 63, gw = wg * 8 + (threadIdx.x >> 6), NGW = nwg * 8;
    const int nmt = M / 64, nnt = N / 64;
    for (int it = gw; it < nmt * nnt; it += NGW) { const int mt = it % nmt, nt = it / nmt;
        naive_gemm_item(A, lda, Bt, ldb, K, mt * 64, 64, nt * 64, f, RowId{}, lane); }
}

__device__ __forceinline__ void st_bf4(bf16_t* p, f32x4 v) { u32x2 w; w.x = pk2(v.x, v.y); w.y = pk2(v.z, v.w); *(u32x2*)p = w; }
struct FProj { bf16_t* proj; const float* rstd; float* partq;
    __device__ __forceinline__ f32x4 operator()(int m, int c, f32x4 v) const { v = v * rstd[m]; st_bf4(proj + (size_t)m * DINP + c, v); return v; }
    __device__ __forceinline__ void partial(int m, int g, float ss) const { if (g < 12) partq[m * 12 + g] = ss; } };
struct FPP { bf16_t* pp;
    __device__ __forceinline__ f32x4 operator()(int m, int c, f32x4 v) const { st_bf4(pp + (size_t)m * D_ + c, v); return v; }
    __device__ __forceinline__ void partial(int, int, float) const {} };
struct FQ { bf16_t* Qb; const float* partq; const float* cs; const float* sn;
    __device__ __forceinline__ f32x4 operator()(int m, int c, f32x4 v) const {
        float ss = 0.f;
#pragma unroll
        for (int i = 0; i < 8; ++i) ss += partq[m * 12 + i];
        v = v * (QSCALE / sqrtf(ss * (1.f / 512.f) + EPS));
        if (c < 1024) { st_bf4(Qb + (size_t)m * 1536 + (c >> 7) * 192 + (c & 127), v); }
        else { const int r = c - 1024, h = r >> 6, j = r & 63, i0 = j >> 1;
            const float c0 = cs[m * 32 + i0], s0 = sn[m * 32 + i0], c1 = cs[m * 32 + i0 + 1], s1 = sn[m * 32 + i0 + 1];
            const f32x4 o = {v.x * c0 - v.y * s0, v.y * c0 + v.x * s0, v.z * c1 - v.w * s1, v.w * c1 + v.z * s1};
            st_bf4(Qb + (size_t)m * 1536 + h * 192 + 128 + j, o); }
        return v; }
    __device__ __forceinline__ void partial(int, int, float) const {} };
struct FKV { bf16_t* Kb; bf16_t* Vb; const float* partq;
    __device__ __forceinline__ f32x4 operator()(int m, int c, f32x4 v) const {
        const float ss = (partq[m * 12 + 8] + partq[m * 12 + 9]) + (partq[m * 12 + 10] + partq[m * 12 + 11]);
        v = v * (1.f / sqrtf(ss * (1.f / 256.f) + EPS));
        if (c < 1024) st_bf4(Kb + (size_t)m * 1536 + (c >> 7) * 192 + (c & 127), v); else st_bf4(Vb + (size_t)m * 1024 + (c - 1024), v);
        return v; }
    __device__ __forceinline__ void partial(int, int, float) const {} };
struct FOut { const float* x; float* out; bf16_t* hb; float* part;
    __device__ __forceinline__ f32x4 operator()(int m, int c, f32x4 v) const { const f32x4 h = *(const f32x4*)(x + (size_t)m * D_ + c) + v;
        *(f32x4*)(out + (size_t)m * D_ + c) = h; st_bf4(hb + (size_t)m * D_ + c, h); return h; }
    __device__ __forceinline__ void partial(int m, int g, float ss) const { part[m * 32 + g] = ss; } };
struct FPle { float* out; const bf16_t* pp; const float* rstd; const float* bias; float* part;
    __device__ __forceinline__ f32x4 operator()(int m, int c, f32x4 v) const {
        const float r = rstd[m]; const f32x4 b = *(const f32x4*)(bias + c); const u32x2 pw = *(const u32x2*)(pp + (size_t)m * D_ + c);
        const f32x4 pv = {bf2f(pw.x & 0xffffu), bf2f(pw.x >> 16), bf2f(pw.y & 0xffffu), bf2f(pw.y >> 16)};
        f32x4 h = *(const f32x4*)(out + (size_t)m * D_ + c);
        h.x += sigmoidf_(v.x * r + b.x) * pv.x; h.y += sigmoidf_(v.y * r + b.y) * pv.y; h.z += sigmoidf_(v.z * r + b.z) * pv.z; h.w += sigmoidf_(v.w * r + b.w) * pv.w;
        *(f32x4*)(out + (size_t)m * D_ + c) = h; return h; }
    __device__ __forceinline__ void partial(int m, int g, float ss) const { part[m * 32 + g] = ss; } };

__device__ __forceinline__ void kpe_run(const Params& P, int wg, int nwg) {
    const int gt = wg * 512 + threadIdx.x, NGT = nwg * 512;
    const bf16_t* proj = WSP(bf16_t, WS_PROJ); bf16_t* Kb = WSP(bf16_t, WS_KB); const float* cs = WSP(float, WS_COS); const float* sn = WSP(float, WS_SIN);
    for (int i = gt; i < S_ * 32; i += NGT) { const int m = i >> 5, j = i & 31;
        const unsigned w = *(const unsigned*)(proj + (size_t)m * DINP + PC_KPE + 2 * j);
        const float a = bf2f(w & 0xffffu), b = bf2f(w >> 16), c = cs[i], s = sn[i];
        const unsigned o = pk2(a * c - b * s, b * c + a * s);
#pragma unroll
        for (int h = 0; h < NH; ++h) *(unsigned*)(Kb + (size_t)m * 1536 + h * 192 + 128 + 2 * j) = o; }
}

__device__ __forceinline__ void attn_naive_run(const Params& P, int wg, int nwg) {
    const int lane = threadIdx.x & 63, gw = wg * 8 + (threadIdx.x >> 6), NGW = nwg * 8;
    const bf16_t* Qb = WSP(bf16_t, WS_QB); const bf16_t* Kb = WSP(bf16_t, WS_KB); const bf16_t* Vb = WSP(bf16_t, WS_VB);
    bf16_t* Op = WSP(bf16_t, WS_OPART); float* ml = WSP(float, WS_ML);
    for (int it = gw; it < S_ * NH; it += NGW) {
        const int h = it & 7, m = S_ - 1 - (it >> 3);
        const bf16_t* q = Qb + (size_t)m * 1536 + h * 192 + 3 * lane;
        const float q0 = bf2f(q[0]), q1 = bf2f(q[1]), q2 = bf2f(q[2]);
        float mx = -1e30f, l = 0.f, o0 = 0.f, o1 = 0.f;
        for (int key = 0; key <= m; ++key) {
            const bf16_t* kr = Kb + (size_t)key * 1536 + h * 192 + 3 * lane;
            float s = q0 * bf2f(kr[0]) + q1 * bf2f(kr[1]) + q2 * bf2f(kr[2]);
            s = wave_sum(s);
            const float mn = fmaxf(mx, s), al = exp2f(mx - mn), p = exp2f(s - mn);
            const unsigned vw = *(const unsigned*)(Vb + (size_t)key * 1024 + h * 128 + 2 * lane);
            l = l * al + p; o0 = o0 * al + p * bf2f(vw & 0xffffu); o1 = o1 * al + p * bf2f(vw >> 16); mx = mn;
        }
        const float rl = 1.f / l;
        *(unsigned*)(Op + (size_t)m * 1024 + h * 128 + 2 * lane) = pk2(o0 * rl, o1 * rl);
        *(unsigned*)(Op + (size_t)S_ * 1024 + (size_t)m * 1024 + h * 128 + 2 * lane) = 0u;
        if (lane == 0) { float* a = ml + ((size_t)m * 8 + h) * 2; a[0] = 0.f; a[1] = 1.f; float* b = ml + (size_t)S_ * 16 + ((size_t)m * 8 + h) * 2; b[0] = -1e30f; b[1] = 0.f; }
    }
}
__device__ __forceinline__ void combine_run(const Params& P, int wg, int nwg) {
    const int lane = threadIdx.x & 63, gw = wg * 8 + (threadIdx.x >> 6), NGW = nwg * 8;
    const bf16_t* Op = WSP(bf16_t, WS_OPART); const float* ml = WSP(float, WS_ML); bf16_t* ymix = WSP(bf16_t, WS_YMIX);
    for (int m = gw; m < S_; m += NGW) {
        const int h = lane >> 3;
        const float m0 = ml[((size_t)m * 8 + h) * 2], l0 = ml[((size_t)m * 8 + h) * 2 + 1];
        const float m1 = ml[(size_t)S_ * 16 + ((size_t)m * 8 + h) * 2], l1 = ml[(size_t)S_ * 16 + ((size_t)m * 8 + h) * 2 + 1];
        const float mm = fmaxf(m0, m1); float w0 = l0 * exp2f(m0 - mm), w1 = l1 * exp2f(m1 - mm); const float rs = 1.f / (w0 + w1); w0 *= rs; w1 *= rs;
        const u32x4* a = (const u32x4*)(Op + (size_t)m * 1024 + 16 * lane); const u32x4* b = (const u32x4*)(Op + (size_t)S_ * 1024 + (size_t)m * 1024 + 16 * lane);
        float o[16]; float ss = 0.f;
#pragma unroll
        for (int j = 0; j < 2; ++j) { const u32x4 ua = a[j], ub = b[j]; const unsigned wa[4] = {ua.x, ua.y, ua.z, ua.w}, wb[4] = {ub.x, ub.y, ub.z, ub.w};
#pragma unroll
            for (int i = 0; i < 4; ++i) { o[8 * j + 2 * i] = w0 * bf2f(wa[i] & 0xffffu) + w1 * bf2f(wb[i] & 0xffffu); o[8 * j + 2 * i + 1] = w0 * bf2f(wa[i] >> 16) + w1 * bf2f(wb[i] >> 16); } }
#pragma unroll
        for (int i = 0; i < 16; ++i) ss += o[i] * o[i];
        ss = wave_sum(ss); const float r = 1.f / sqrtf(ss * (1.f / 1024.f) + EPS);
        u32x4 w0v, w1v;
        w0v.x = pk2(o[0] * r, o[1] * r); w0v.y = pk2(o[2] * r, o[3] * r); w0v.z = pk2(o[4] * r, o[5] * r); w0v.w = pk2(o[6] * r, o[7] * r);
        w1v.x = pk2(o[8] * r, o[9] * r); w1v.y = pk2(o[10] * r, o[11] * r); w1v.z = pk2(o[12] * r, o[13] * r); w1v.w = pk2(o[14] * r, o[15] * r);
        u32x4* y = (u32x4*)(ymix + (size_t)m * D_ + 16 * lane); y[0] = w0v; y[1] = w1v;
    }
}

__device__ __forceinline__ void hgrn_naive_run(const Params& P, int wg, LAS unsigned char* lds) {
    if (wg >= NH) return;
    const int h = wg, tid = threadIdx.x; const bool act = tid < 128; const int v = tid & 127;
    const bf16_t* proj = WSP(bf16_t, WS_PROJ); const float* lb = WSP(float, WS_LB); bf16_t* ymix = WSP(bf16_t, WS_YMIX);
    LAS float* sf = (LAS float*)lds; LAS float* sq = sf + 128; LAS float* red = sq + 128;
    float st[128];
#pragma unroll
    for (int k = 0; k < 128; ++k) st[k] = 0.f;
    for (int t = 0; t < S_; ++t) {
        const bf16_t* pr = proj + (size_t)t * DINP;
        if (act) { const float l = lb[h * 128 + v]; sf[v] = l + (1.f - l) * sigmoidf_(bf2f(pr[PC_HF + h * 128 + v])); sq[v] = siluf_(bf2f(pr[PC_HQ + h * 128 + v])); }
        __syncthreads();
        float o = 0.f;
        if (act) { const float iv = bf2f(pr[PC_HI + h * 128 + v]);
#pragma unroll
            for (int k = 0; k < 128; ++k) { const float f = sf[k]; st[k] = f * st[k] + (1.f - f) * iv; o += sq[k] * st[k]; } }
        float ss = act ? o * o : 0.f; ss = wave_sum(ss);
        if (act && (tid & 63) == 0) red[tid >> 6] = ss;
        __syncthreads();
        if (act) { const float r = 1.f / sqrtf((red[0] + red[1]) * (1.f / 128.f) + EPS);
            ymix[(size_t)t * D_ + 1024 + h * 128 + v] = (bf16_t)f2bf(o * r * siluf_(bf2f(pr[PC_HG + h * 128 + v]))); }
    }
}

__device__ __forceinline__ void route_run(const Params& P, int wg, int nwg, LAS unsigned char* lds) {
    const int lane = threadIdx.x & 63, wave = threadIdx.x >> 6, gw = wg * 8 + wave, NGW = nwg * 8;
    const float* h1 = P.out; const float* Wr = WSP(float, WS_WR); const float* part1 = WSP(float, WS_PART1);
    LAS float* lg = (LAS float*)lds + wave * 96;
    int* cnt = WSP(int, WS_CTL); int* list = WSP(int, WS_LIST); int* eid = WSP(int, WS_EID); float* ew = WSP(float, WS_EW); float* rstd1 = WSP(float, WS_RSTD1);
    for (int t = gw; t < S_; t += NGW) {
        float ss = (lane < 32) ? part1[t * 32 + lane] : 0.f; ss = wave_sum(ss); const float r = 1.f / sqrtf(ss * (1.f / D_) + EPS);
        float a0 = 0.f, a1 = 0.f; const float* hr = h1 + (size_t)t * D_;
        for (int k = 0; k < D_; ++k) { const float hv = hr[k]; a0 = fmaf(hv, Wr[k * 80 + lane], a0); if (lane < 16) a1 = fmaf(hv, Wr[k * 80 + 64 + lane], a1); }
        lg[lane] = a0 * r; if (lane < 16) lg[64 + lane] = a1 * r;
        asm volatile("s_waitcnt lgkmcnt(0)" ::: "memory");
        if (lane == 0) {
            rstd1[t] = r;
            int g = 0; float gm = -INFINITY;
            for (int i = 0; i < 8; ++i) { const float v = lg[i] + P.b_rg[i]; if (v > gm) { gm = v; g = i; } }
            float gs = 0.f; for (int i = 0; i < 8; ++i) gs += expf(lg[i] + P.b_rg[i] - gm);
            const float gw_ = 1.f / gs;
            int i1 = 0, i2 = 0; float l1 = -INFINITY, l2 = -INFINITY;
            for (int i = 0; i < 8; ++i) { const float e = lg[8 + g * 8 + i] + P.b_re[g * 8 + i];
                if (e > l1) { l2 = l1; i2 = i1; l1 = e; i1 = i; } else if (e > l2) { l2 = e; i2 = i; } }
            const float p2 = expf(l2 - l1), w1 = gw_ / (1.f + p2), w2 = gw_ * p2 / (1.f + p2);
            const int e1 = g * 8 + i1, e2 = g * 8 + i2;
            eid[2 * t] = e1; eid[2 * t + 1] = e2; ew[2 * t] = w1; ew[2 * t + 1] = w2;
            const int p1 = atomicAdd(&cnt[e1], 1); list[e1 * LISTCAP + p1] = 2 * t;
            const int q2 = atomicAdd(&cnt[e2], 1); list[e2 * LISTCAP + q2] = 2 * t + 1;
        }
        asm volatile("s_waitcnt lgkmcnt(0)" ::: "memory");
    }
}

__device__ __forceinline__ void moe_up_naive_run(const Params& P, int wg, int nwg) {
    const int lane = threadIdx.x & 63, gw = wg * 8 + (threadIdx.x >> 6), NGW = nwg * 8;
    const int* cnt = WSP(int, WS_CTL); const int* list = WSP(int, WS_LIST); const float* rstd1 = WSP(float, WS_RSTD1);
    const bf16_t* h1b = WSP(bf16_t, WS_H1B); bf16_t* hmid = WSP(bf16_t, WS_HMID);
    int off = 0, tbase = 0;
    for (int e = 0; e < NE; ++e) {
        const int n = cnt[e], nrg = (n + 63) >> 6, nit = nrg * 16;
        for (int it = gw - off; it < nit; it += NGW) {
            if (it < 0) continue;
            const int rg = it >> 4, cg = it & 15, c0 = cg * 32;
            const int nrows = (n - rg * 64) < 64 ? (n - rg * 64) : 64;
            const int a = list[e * LISTCAP + rg * 64 + (lane < nrows ? lane : 0)]; const int tok = a >> 1;
            const bf16_t* ar = h1b + (size_t)tok * D_;
            const bf16_t* W = WSP(bf16_t, WS_WGU) + (size_t)e * 1024 * 2048;
            const int pn = c0 >> 7, rr = c0 & 127;
            float ag[32], au[32];
#pragma unroll
            for (int c = 0; c < 32; ++c) { ag[c] = 0.f; au[c] = 0.f; }
            for (int k = 0; k < D_; k += 8) {
                const u32x4 av = *(const u32x4*)(ar + k); float af[8];
                af[0] = bf2f(av.x & 0xffffu); af[1] = bf2f(av.x >> 16); af[2] = bf2f(av.y & 0xffffu); af[3] = bf2f(av.y >> 16);
                af[4] = bf2f(av.z & 0xffffu); af[5] = bf2f(av.z >> 16); af[6] = bf2f(av.w & 0xffffu); af[7] = bf2f(av.w >> 16);
#pragma unroll
                for (int c = 0; c < 32; ++c) {
                    const u32x4 bg = *(const u32x4*)(W + (size_t)(pn * 256 + rr + c) * 2048 + k); const u32x4 bu = *(const u32x4*)(W + (size_t)(pn * 256 + 128 + rr + c) * 2048 + k);
                    float s = ag[c], u = au[c];
                    s = fmaf(af[0], bf2f(bg.x & 0xffffu), s); s = fmaf(af[1], bf2f(bg.x >> 16), s); s = fmaf(af[2], bf2f(bg.y & 0xffffu), s); s = fmaf(af[3], bf2f(bg.y >> 16), s);
                    s = fmaf(af[4], bf2f(bg.z & 0xffffu), s); s = fmaf(af[5], bf2f(bg.z >> 16), s); s = fmaf(af[6], bf2f(bg.w & 0xffffu), s); s = fmaf(af[7], bf2f(bg.w >> 16), s);
                    u = fmaf(af[0], bf2f(bu.x & 0xffffu), u); u = fmaf(af[1], bf2f(bu.x >> 16), u); u = fmaf(af[2], bf2f(bu.y & 0xffffu), u); u = fmaf(af[3], bf2f(bu.y >> 16), u);
                    u = fmaf(af[4], bf2f(bu.z & 0xffffu), u); u = fmaf(af[5], bf2f(bu.z >> 16), u); u = fmaf(af[6], bf2f(bu.w & 0xffffu), u); u = fmaf(af[7], bf2f(bu.w >> 16), u);
                    ag[c] = s; au[c] = u;
                }
            }
            if (lane < nrows) { const float r = rstd1[tok]; const int slot = tbase * 256 + rg * 64 + lane;
#pragma unroll
                for (int c = 0; c < 32; c += 2) *(unsigned*)(hmid + (size_t)slot * DE + c0 + c) = pk2(siluf_(ag[c] * r) * (au[c] * r), siluf_(ag[c + 1] * r) * (au[c + 1] * r)); }
        }
        off = (off + nit) % NGW; tbase += (n + 255) >> 8;
    }
}
struct FDown { bf16_t* y; const int* lst; int slot0; const float* ew;
    __device__ __forceinline__ f32x4 operator()(int m, int c, f32x4 v) const { const int a = lst[m - slot0]; v = v * ew[a]; st_bf4(y + (size_t)a * D_ + c, v); return v; }
    __device__ __forceinline__ void partial(int, int, float) const {} };
__device__ __forceinline__ void moe_down_naive_run(const Params& P, int wg, int nwg) {
    const int lane = threadIdx.x & 63, gw = wg * 8 + (threadIdx.x >> 6), NGW = nwg * 8;
    const int* cnt = WSP(int, WS_CTL); const int* list = WSP(int, WS_LIST); const float* ew = WSP(float, WS_EW);
    const bf16_t* hmid = WSP(bf16_t, WS_HMID); bf16_t* y = WSP(bf16_t, WS_Y);
    int off = 0, tbase = 0;
    for (int e = 0; e < NE; ++e) {
        const int n = cnt[e], nrg = (n + 63) >> 6, nit = nrg * 32;
        for (int it = gw - off; it < nit; it += NGW) {
            if (it < 0) continue;
            const int rg = it >> 5, cg = it & 31; const int nrows = (n - rg * 64) < 64 ? (n - rg * 64) : 64;
            const int slot0 = tbase * 256 + rg * 64;
            FDown f{y, list + e * LISTCAP + rg * 64, slot0, ew};
            naive_gemm_item(hmid, DE, WSP(bf16_t, WS_WD) + (size_t)e * 2048 * DE, DE, DE, slot0, nrows, cg * 64, f, RowId{}, lane);
        }
        off = (off + nit) % NGW; tbase += (n + 255) >> 8;
    }
}
__device__ __forceinline__ void moe_combine_run(const Params& P, int wg, int nwg) {
    const int lane = threadIdx.x & 63, gw = wg * 8 + (threadIdx.x >> 6), NGW = nwg * 8;
    const bf16_t* y = WSP(bf16_t, WS_Y); bf16_t* h2b = WSP(bf16_t, WS_H2B); float* rstd2 = WSP(float, WS_RSTD2);
    for (int m = gw; m < S_; m += NGW) {
        f32x4* hr = (f32x4*)(P.out + (size_t)m * D_) + lane; const u32x2* y0 = (const u32x2*)(y + (size_t)(2 * m) * D_) + lane; const u32x2* y1 = (const u32x2*)(y + (size_t)(2 * m + 1) * D_) + lane;
        u32x2* ob = (u32x2*)(h2b + (size_t)m * D_) + lane; float ss = 0.f;
#pragma unroll
        for (int j = 0; j < 8; ++j) { f32x4 h = hr[64 * j]; const u32x2 a = y0[64 * j], b = y1[64 * j];
            h.x += bf2f(a.x & 0xffffu) + bf2f(b.x & 0xffffu); h.y += bf2f(a.x >> 16) + bf2f(b.x >> 16); h.z += bf2f(a.y & 0xffffu) + bf2f(b.y & 0xffffu); h.w += bf2f(a.y >> 16) + bf2f(b.y >> 16);
            hr[64 * j] = h; u32x2 w; w.x = pk2(h.x, h.y); w.y = pk2(h.z, h.w); ob[64 * j] = w; ss += (h.x * h.x + h.y * h.y) + (h.z * h.z + h.w * h.w); }
        ss = wave_sum(ss); if (lane == 0) rstd2[m] = 1.f / sqrtf(ss * (1.f / D_) + EPS);
    }
}
__device__ __forceinline__ void final_run(const Params& P, int wg, int nwg) {
    const int lane = threadIdx.x & 63, gw = wg * 8 + (threadIdx.x >> 6), NGW = nwg * 8; const float* part3 = WSP(float, WS_PART3);
    for (int m = gw; m < S_; m += NGW) {
        float ss = (lane < 32) ? part3[m * 32 + lane] : 0.f; ss = wave_sum(ss); const float r = 1.f / sqrtf(ss * (1.f / D_) + EPS);
        f32x4* hr = (f32x4*)(P.out + (size_t)m * D_) + lane; const f32x4* g = (const f32x4*)P.final_norm + lane;
#pragma unroll
        for (int j = 0; j < 8; ++j) hr[64 * j] = hr[64 * j] * r * g[64 * j];
    }
}

namespace cg = cooperative_groups;
constexpr int LDS_BYTES = 147456;
constexpr int NPHASE = 12;
#ifndef MK_MULTI
#define MK_MULTI 0
#endif
__global__ void __launch_bounds__(512, 2) mk_fwd(Params P, int ph_lo, int ph_hi) {
    extern __shared__ __attribute__((aligned(16))) unsigned char lds_raw[];
    LAS unsigned char* lds = (LAS unsigned char*)lds_raw;
    const int wg = blockIdx.x, nwg = gridDim.x;
#define PH(k) if (ph_lo <= (k) && (k) < ph_hi)
#define SEAM(k) do { if ((k) + 1 < ph_hi) cg::this_grid().sync(); } while (0)
    PH(0) { p0_run(P, wg, nwg, lds); SEAM(0); }
    PH(1) { naive_gemm(WSP(bf16_t, WS_XB), D_, WSP(bf16_t, WS_WIN), D_, S_, DINP, D_, FProj{WSP(bf16_t, WS_PROJ), WSP(float, WS_RSTDX), WSP(float, WS_PARTQ)}, wg, nwg);
            naive_gemm(WSP(bf16_t, WS_PB), PLE, WSP(bf16_t, WS_WPP), PLE, S_, D_, PLE, FPP{WSP(bf16_t, WS_PP)}, wg, nwg); SEAM(1); }
    PH(2) { naive_gemm(WSP(bf16_t, WS_PROJ) + PC_CQ, DINP, WSP(bf16_t, WS_WUQ), 512, S_, 1536, 512, FQ{WSP(bf16_t, WS_QB), WSP(float, WS_PARTQ), WSP(float, WS_COS), WSP(float, WS_SIN)}, wg, nwg);
            naive_gemm(WSP(bf16_t, WS_PROJ) + PC_CKV, DINP, WSP(bf16_t, WS_WUKV), 256, S_, 2048, 256, FKV{WSP(bf16_t, WS_KB), WSP(bf16_t, WS_VB), WSP(float, WS_PARTQ)}, wg, nwg);
            kpe_run(P, wg, nwg); SEAM(2); }
    PH(3) { hgrn_naive_run(P, wg, lds); attn_naive_run(P, wg, nwg); SEAM(3); }
    PH(4) { combine_run(P, wg, nwg); SEAM(4); }
    PH(5) { naive_gemm(WSP(bf16_t, WS_YMIX), D_, WSP(bf16_t, WS_WOUT), D_, S_, D_, D_, FOut{P.x, P.out, WSP(bf16_t, WS_H1B), WSP(float, WS_PART1)}, wg, nwg); SEAM(5); }
    PH(6) { route_run(P, wg, nwg, lds); SEAM(6); }
    PH(7) { moe_up_naive_run(P, wg, nwg); SEAM(7); }
    PH(8) { moe_down_naive_run(P, wg, nwg); SEAM(8); }
    PH(9) { moe_combine_run(P, wg, nwg); SEAM(9); }
    PH(10) { naive_gemm(WSP(bf16_t, WS_H2B), D_, WSP(bf16_t, WS_WPG), D_, S_, D_, D_, FPle{P.out, WSP(bf16_t, WS_PP), WSP(float, WS_RSTD2), P.b_pg, WSP(float, WS_PART3)}, wg, nwg); SEAM(10); }
    PH(11) { final_run(P, wg, nwg); }
#undef PH
#undef SEAM
}

extern "C" void kernel_launch(void* const* d_in, const int* in_sizes, int n_in, void* d_out, int out_size, void* d_ws, size_t ws_size, hipStream_t stream) {
    if (n_in != 26 || ws_size < WS_END) { fprintf(stderr, "kernel_launch: unexpected n_in %d or ws_size %zu (< %zu)\n", n_in, ws_size, (size_t)WS_END); return; }
    static int grid = 0;
    if (grid == 0) {
        int dev = 0, cus = 0, per_cu = 0;
        (void)hipGetDevice(&dev); (void)hipDeviceGetAttribute(&cus, hipDeviceAttributeMultiprocessorCount, dev);
        (void)hipFuncSetAttribute((const void*)mk_fwd, hipFuncAttributeMaxDynamicSharedMemorySize, LDS_BYTES);
        if (hipOccupancyMaxActiveBlocksPerMultiprocessor(&per_cu, (const void*)mk_fwd, 512, LDS_BYTES) != hipSuccess || per_cu < 1) { fprintf(stderr, "kernel_launch: occupancy query says %d blocks/CU\n", per_cu); per_cu = 1; }
        (void)hipGetLastError();
        grid = cus > 0 ? cus : 256;
    }
    Params P{};
    P.x = (const float*)d_in[0]; P.p = (const float*)d_in[1]; P.pos = (const int*)d_in[2];
    P.attn_norm = (const float*)d_in[3]; P.w_in = (const float*)d_in[4]; P.q_norm = (const float*)d_in[5]; P.w_uq = (const float*)d_in[6];
    P.kv_norm = (const float*)d_in[7]; P.w_ukv = (const float*)d_in[8]; P.mla_norm = (const float*)d_in[9]; P.lb_logits = (const float*)d_in[10];
    P.hg_norm = (const float*)d_in[11]; P.w_out = (const float*)d_in[12]; P.ffn_norm = (const float*)d_in[13];
    P.w_rg = (const float*)d_in[14]; P.b_rg = (const float*)d_in[15]; P.w_re = (const float*)d_in[16]; P.b_re = (const float*)d_in[17];
    P.w_eg = (const float*)d_in[18]; P.w_eu = (const float*)d_in[19]; P.w_ed = (const float*)d_in[20];
    P.ple_norm = (const float*)d_in[21]; P.w_pg = (const float*)d_in[22]; P.b_pg = (const float*)d_in[23]; P.w_pp = (const float*)d_in[24]; P.final_norm = (const float*)d_in[25];
    P.out = (float*)d_out; P.ws = (unsigned char*)d_ws;
    (void)hipMemsetAsync((char*)d_ws + WS_CTL, 0, 1 * MiB, stream);
#if MK_MULTI
    for (int ph = 0; ph < NPHASE; ++ph) hipLaunchKernelGGL(mk_fwd, dim3(grid), dim3(512), LDS_BYTES, stream, P, ph, ph + 1);
#else
    int lo = 0, hi = NPHASE; void* args[] = {&P, &lo, &hi};
    hipError_t e = hipLaunchCooperativeKernel((const void*)mk_fwd, dim3(grid), dim3(512), args, LDS_BYTES, stream);
    if (e != hipSuccess) fprintf(stderr, "kernel_launch: cooperative launch failed: %s (grid %d)\n", hipGetErrorString(e), grid);
#endif
}
```

```cpp
#include <hip/hip_runtime.h>
#include <hip/hip_cooperative_groups.h>
#include <cstdint>
#include <cstdio>

#define LAS __attribute__((address_space(3)))
typedef unsigned short bf16_t;
typedef float f32x4 __attribute__((ext_vector_type(4)));
typedef unsigned u32x4 __attribute__((ext_vector_type(4)));
typedef unsigned u32x2 __attribute__((ext_vector_type(2)));

constexpr int S_ = 8192, D_ = 2048, DIN = 4928, DINP = 5120;
constexpr int NH = 8, QKD = 192, VD = 128;
constexpr int NE = 64, DE = 512, PLE = 256;
constexpr float EPS = 1e-6f;
constexpr float QSCALE = 0.07216878364870323f * 1.4426950408889634f;
constexpr int PC_CQ = 0, PC_CKV = 512, PC_HQ = 768, PC_HF = 1792, PC_HI = 2816, PC_HG = 3840, PC_KPE = 4864;
constexpr int LISTCAP = 8192;

constexpr size_t MiB = 1u << 20;
constexpr size_t WS_CTL = 0;
constexpr size_t WS_RSTDX = 1 * MiB, WS_RSTD1 = WS_RSTDX + 32768, WS_RSTD2 = WS_RSTD1 + 32768, WS_LB = WS_RSTD2 + 32768, WS_TILEB = WS_LB + 4096;
constexpr size_t WS_COS = 2 * MiB, WS_SIN = 3 * MiB, WS_PARTQ = 4 * MiB, WS_PART1 = 5 * MiB, WS_PART3 = 6 * MiB, WS_WR = 7 * MiB;
constexpr size_t WS_ML = 8 * MiB, WS_DVEC = 9 * MiB, WS_EID = 10 * MiB, WS_EW = WS_EID + 65536, WS_LIST = 11 * MiB;
constexpr size_t WS_WUQ = 16 * MiB, WS_WUKV = 18 * MiB, WS_WPP = 19 * MiB, WS_WIN = 20 * MiB, WS_WOUT = 40 * MiB, WS_WPG = 48 * MiB;
constexpr size_t WS_PB = 56 * MiB, WS_XB = 64 * MiB, WS_PROJ = 96 * MiB, WS_PP = 176 * MiB, WS_QB = 208 * MiB, WS_KB = 232 * MiB, WS_VB = 256 * MiB;
constexpr size_t WS_LST = 272 * MiB, WS_SST = 304 * MiB, WS_OPART = 336 * MiB, WS_YMIX = 368 * MiB, WS_H1B = 400 * MiB, WS_H2B = 432 * MiB;
constexpr size_t WS_HMID = 464 * MiB, WS_Y = 496 * MiB, WS_WGU = 560 * MiB, WS_WD = 816 * MiB, WS_END = 944 * MiB;

struct Params {
    const float *x, *p; const int* pos;
    const float *attn_norm, *w_in, *q_norm, *w_uq, *kv_norm, *w_ukv, *mla_norm, *lb_logits, *hg_norm, *w_out, *ffn_norm;
    const float *w_rg, *b_rg, *w_re, *b_re, *w_eg, *w_eu, *w_ed, *ple_norm, *w_pg, *b_pg, *w_pp, *final_norm;
    float* out; unsigned char* ws;
};
#define WSP(T, off) ((T*)(P.ws + (off)))

__device__ __forceinline__ unsigned f2bf(float f) { unsigned u = __builtin_bit_cast(unsigned, f); return (u + 0x7fffu + ((u >> 16) & 1u)) >> 16; }
__device__ __forceinline__ float bf2f(unsigned h) { return __builtin_bit_cast(float, h << 16); }
__device__ __forceinline__ unsigned pk2(float lo, float hi) { return f2bf(lo) | (f2bf(hi) << 16); }
__device__ __forceinline__ float wave_sum(float v) {
#pragma unroll
    for (int o = 1; o < 64; o <<= 1) v += __shfl_xor(v, o);
    return v;
}
__device__ __forceinline__ int lane_id_() { return (int)__builtin_amdgcn_mbcnt_hi(~0u, __builtin_amdgcn_mbcnt_lo(~0u, 0u)); }
__device__ __forceinline__ int threadIdx_x_raw() { return (int)__builtin_amdgcn_workitem_id_x(); }
#define TIDX (wv * 64 + lane_id_())
__device__ __forceinline__ float sigmoidf_(float x) { return 1.f / (1.f + __expf(-x)); }
__device__ __forceinline__ float siluf_(float x) { return x / (1.f + __expf(-x)); }

struct SrcWin { const float* W; const float* g;
    __device__ __forceinline__ float operator()(int k, int n) const {
        int src;
        if (n < 768) src = n;
        else if (n < 4864) src = n + 64;
        else if (n < 4928) { const int j = n - 4864; src = 768 + ((j & 1) ? 32 + (j >> 1) : (j >> 1)); }
        else return 0.f;
        return W[(size_t)k * DIN + src] * g[k];
    } };
struct SrcWuq { const float* W; const float* g;
    __device__ __forceinline__ float operator()(int k, int n) const {
        int src;
        if (n < 1024) src = (n >> 7) * 192 + (n & 127);
        else { const int r = n - 1024, h = r >> 6, j = r & 63; src = h * 192 + 128 + ((j & 1) ? 32 + (j >> 1) : (j >> 1)); }
        return W[(size_t)k * 1536 + src] * g[k];
    } };
struct SrcWukv { const float* W; const float* g;
    __device__ __forceinline__ float operator()(int k, int n) const {
        int src;
        if (n < 1024) src = (n >> 7) * 256 + (n & 127);
        else { const int r = n - 1024; src = (r >> 7) * 256 + 128 + (r & 127); }
        return W[(size_t)k * 2048 + src] * g[k];
    } };
struct SrcWout { const float* W; const float* g0; const float* g1;
    __device__ __forceinline__ float operator()(int k, int n) const { return W[(size_t)k * 2048 + n] * (k < 1024 ? g0[k] : g1[k - 1024]); } };
struct SrcPlain { const float* W; const float* g; int N;
    __device__ __forceinline__ float operator()(int k, int n) const { const float w = W[(size_t)k * N + n]; return g ? w * g[k] : w; } };
struct SrcGU { const float* W; const float* g;
    __device__ __forceinline__ float operator()(int k, int n) const { return W[(size_t)k * DE + 128 * (n >> 8) + (n & 127)] * g[k]; } };

template <class Src>
__device__ __forceinline__ void tconv_item(const Src& src, int K, int nblk, bf16_t* WT, LAS float* scr, int item, int lane) {
    const int kb = item / nblk, nb = item % nblk, k0 = 64 * kb, n0 = 32 * nb;
#pragma unroll 8
    for (int i = 0; i < 32; ++i) { const int kk = 2 * i + (lane >> 5); scr[kk * 33 + (lane & 31)] = src(k0 + kk, n0 + (lane & 31)); }
    asm volatile("s_waitcnt lgkmcnt(0)" ::: "memory");
    const int c = lane & 7;
#pragma unroll
    for (int j = 0; j < 4; ++j) { const int n = (lane >> 3) + 8 * j; const LAS float* s = scr + (8 * c) * 33 + n;
        u32x4 o; o.x = pk2(s[0 * 33], s[1 * 33]); o.y = pk2(s[2 * 33], s[3 * 33]); o.z = pk2(s[4 * 33], s[5 * 33]); o.w = pk2(s[6 * 33], s[7 * 33]);
        *(u32x4*)(WT + (size_t)(n0 + n) * K + k0 + 8 * c) = o; }
    asm volatile("s_waitcnt lgkmcnt(0)" ::: "memory");
}

__device__ __forceinline__ void p0_run(const Params& P, int wg, int nwg, int wv, LAS unsigned char* lds) {
    const int tid = TIDX, lane = tid & 63, wave = tid >> 6;
    const int gw = wg * 8 + wave, NGW = nwg * 8;
    LAS float* scr = (LAS float*)(lds + wave * 8704);
    constexpr int I_WIN = 32 * 160, I_WUQ = 8 * 48, I_WUKV = 4 * 64, I_WOUT = 32 * 64, I_WPG = 32 * 64, I_WPP = 4 * 64, I_GU = 32 * 32, I_DN = 8 * 64;
    constexpr int NITEMS = I_WIN + I_WUQ + I_WUKV + I_WOUT + I_WPG + I_WPP + NE * I_GU + NE * I_DN;
    for (int it = gw; it < NITEMS; it += NGW) {
        int r = it;
        if (r < I_WIN) { tconv_item(SrcWin{P.w_in, P.attn_norm}, 2048, 160, WSP(bf16_t, WS_WIN), scr, r, lane); continue; } r -= I_WIN;
        if (r < I_WUQ) { tconv_item(SrcWuq{P.w_uq, P.q_norm}, 512, 48, WSP(bf16_t, WS_WUQ), scr, r, lane); continue; } r -= I_WUQ;
        if (r < I_WUKV) { tconv_item(SrcWukv{P.w_ukv, P.kv_norm}, 256, 64, WSP(bf16_t, WS_WUKV), scr, r, lane); continue; } r -= I_WUKV;
        if (r < I_WOUT) { tconv_item(SrcWout{P.w_out, P.mla_norm, P.hg_norm}, 2048, 64, WSP(bf16_t, WS_WOUT), scr, r, lane); continue; } r -= I_WOUT;
        if (r < I_WPG) { tconv_item(SrcPlain{P.w_pg, P.ple_norm, 2048}, 2048, 64, WSP(bf16_t, WS_WPG), scr, r, lane); continue; } r -= I_WPG;
        if (r < I_WPP) { tconv_item(SrcPlain{P.w_pp, nullptr, 2048}, 256, 64, WSP(bf16_t, WS_WPP), scr, r, lane); continue; } r -= I_WPP;
        if (r < NE * I_GU) { const int e = r / I_GU; r -= e * I_GU;
            const bool isup = (((r % 32) * 32) & 255) >= 128;
            const float* Wsel = isup ? P.w_eu : P.w_eg;
            tconv_item(SrcGU{Wsel + (size_t)e * 2048 * DE, P.ffn_norm}, 2048, 32, WSP(bf16_t, WS_WGU) + (size_t)e * 1024 * 2048, scr, r, lane); continue; }
        r -= NE * I_GU;
        { const int e = r / I_DN; r -= e * I_DN;
          tconv_item(SrcPlain{P.w_ed + (size_t)e * DE * 2048, nullptr, 2048}, DE, 64, WSP(bf16_t, WS_WD) + (size_t)e * 2048 * DE, scr, r, lane); }
    }
    for (int m = gw; m < S_; m += NGW) {
        const f32x4* xr = (const f32x4*)(P.x + (size_t)m * D_) + lane; f32x4 v[8]; float s = 0.f;
#pragma unroll
        for (int j = 0; j < 8; ++j) { v[j] = xr[64 * j]; s += (v[j].x * v[j].x + v[j].y * v[j].y) + (v[j].z * v[j].z + v[j].w * v[j].w); }
        s = wave_sum(s);
        if (lane == 0) WSP(float, WS_RSTDX)[m] = 1.f / sqrtf(s * (1.f / D_) + EPS);
        u32x2* o = (u32x2*)(WSP(bf16_t, WS_XB) + (size_t)m * D_) + lane;
#pragma unroll
        for (int j = 0; j < 8; ++j) { u32x2 w; w.x = pk2(v[j].x, v[j].y); w.y = pk2(v[j].z, v[j].w); o[64 * j] = w; }
    }
    const int gt = wg * 512 + tid, NGT = nwg * 512;
    for (int i = gt; i < S_ * PLE / 4; i += NGT) { const f32x4 v = ((const f32x4*)P.p)[i]; u32x2 w; w.x = pk2(v.x, v.y); w.y = pk2(v.z, v.w); WSP(u32x2, WS_PB)[i] = w; }
    for (int i = gt; i < S_ * 32; i += NGT) { const int s = i >> 5, j = i & 31;
        const float invf = exp2f(-(float)j * (13.287712379549449f / 32.0f));
        const double tr = (double)P.pos[s] * (double)invf * 0.15915494309189535;
        const float fr = (float)(tr - floor(tr));
        WSP(float, WS_COS)[i] = __builtin_amdgcn_cosf(fr); WSP(float, WS_SIN)[i] = __builtin_amdgcn_sinf(fr); }
    for (int i = gt; i < 1024; i += NGT) WSP(float, WS_LB)[i] = 1.f / (1.f + expf(P.lb_logits[1024 + i] - P.lb_logits[i]));
    for (int i = gt; i < 2048 * 80; i += NGT) { const int k = i / 80, c = i % 80;
        float w = 0.f; if (c < 8) w = P.w_rg[k * 8 + c]; else if (c < 72) w = P.w_re[k * 64 + (c - 8)];
        WSP(float, WS_WR)[i] = w * P.ffn_norm[k]; }
}

struct RowId { __device__ __forceinline__ int operator()(int m) const { return m; } };
template <class F, class RowMap>
__device__ __forceinline__ void naive_gemm_item(const bf16_t* A, int lda, const bf16_t* Bt, int ldb, int K, int m0, int nrows, int n0, const F& f, const RowMap& rm, int lane) {
    const int m = m0 + lane; const bool valid = lane < nrows;
    const bf16_t* ar = A + (size_t)rm(valid ? m : m0) * lda;
    float acc[64];
#pragma unroll
    for (int c = 0; c < 64; ++c) acc[c] = 0.f;
    for (int k = 0; k < K; k += 8) {
        const u32x4 a = *(const u32x4*)(ar + k);
        float af[8];
        af[0] = bf2f(a.x & 0xffffu); af[1] = bf2f(a.x >> 16); af[2] = bf2f(a.y & 0xffffu); af[3] = bf2f(a.y >> 16);
        af[4] = bf2f(a.z & 0xffffu); af[5] = bf2f(a.z >> 16); af[6] = bf2f(a.w & 0xffffu); af[7] = bf2f(a.w >> 16);
#pragma unroll
        for (int c = 0; c < 64; ++c) {
            const u32x4 b = *(const u32x4*)(Bt + (size_t)(n0 + c) * ldb + k);
            float s = acc[c];
            s = fmaf(af[0], bf2f(b.x & 0xffffu), s); s = fmaf(af[1], bf2f(b.x >> 16), s); s = fmaf(af[2], bf2f(b.y & 0xffffu), s); s = fmaf(af[3], bf2f(b.y >> 16), s);
            s = fmaf(af[4], bf2f(b.z & 0xffffu), s); s = fmaf(af[5], bf2f(b.z >> 16), s); s = fmaf(af[6], bf2f(b.w & 0xffffu), s); s = fmaf(af[7], bf2f(b.w >> 16), s);
            acc[c] = s;
        }
    }
    if (valid) {
        float ss = 0.f;
#pragma unroll
        for (int q = 0; q < 16; ++q) { const f32x4 v = f(m, n0 + 4 * q, (f32x4){acc[4 * q], acc[4 * q + 1], acc[4 * q + 2], acc[4 * q + 3]});
            ss += (v.x * v.x + v.y * v.y) + (v.z * v.z + v.w * v.w); }
        f.partial(m, n0 >> 6, ss);
    }
}
template <class F>
__device__ __forceinline__ void naive_gemm(const bf16_t* A, int lda, const bf16_t* Bt, int ldb, int M, int N, int K, const F& f, int wg, int nwg, int wv) {
    const int lane = TIDX & 63, gw = wg * 8 + (TIDX >> 6), NGW = nwg * 8;
    const int nmt = M / 64, nnt = N / 64;
    for (int it = gw; it < nmt * nnt; it += NGW) { const int mt = it % nmt, nt = it / nmt;
        naive_gemm_item(A, lda, Bt, ldb, K, mt * 64, 64, nt * 64, f, RowId{}, lane); }
}

__device__ __forceinline__ void st_bf4(bf16_t* p, f32x4 v) { u32x2 w; w.x = pk2(v.x, v.y); w.y = pk2(v.z, v.w); *(u32x2*)p = w; }
struct FProj { bf16_t* proj; const float* rstd; float* partq;
    __device__ __forceinline__ f32x4 operator()(int m, int c, f32x4 v) const { v = v * rstd[m]; st_bf4(proj + (size_t)m * DINP + c, v); return v; }
    __device__ __forceinline__ void partial(int m, int g, float ss) const { if (g < 12) partq[m * 12 + g] = ss; } };
struct FPP { bf16_t* pp;
    __device__ __forceinline__ f32x4 operator()(int m, int c, f32x4 v) const { st_bf4(pp + (size_t)m * D_ + c, v); return v; }
    __device__ __forceinline__ void partial(int, int, float) const {} };
struct FQ { bf16_t* Qb; const float* partq; const float* cs; const float* sn;
    __device__ __forceinline__ f32x4 operator()(int m, int c, f32x4 v) const {
        float ss = 0.f;
#pragma unroll
        for (int i = 0; i < 8; ++i) ss += partq[m * 12 + i];
        v = v * (QSCALE / sqrtf(ss * (1.f / 512.f) + EPS));
        if (c < 1024) { st_bf4(Qb + (size_t)m * 1536 + (c >> 7) * 192 + (c & 127), v); }
        else { const int r = c - 1024, h = r >> 6, j = r & 63, i0 = j >> 1;
            const float c0 = cs[m * 32 + i0], s0 = sn[m * 32 + i0], c1 = cs[m * 32 + i0 + 1], s1 = sn[m * 32 + i0 + 1];
            const f32x4 o = {v.x * c0 - v.y * s0, v.y * c0 + v.x * s0, v.z * c1 - v.w * s1, v.w * c1 + v.z * s1};
            st_bf4(Qb + (size_t)m * 1536 + h * 192 + 128 + j, o); }
        return v; }
    __device__ __forceinline__ void partial(int, int, float) const {} };
struct FKV { bf16_t* Kb; bf16_t* Vb; const float* partq;
    __device__ __forceinline__ f32x4 operator()(int m, int c, f32x4 v) const {
        const float ss = (partq[m * 12 + 8] + partq[m * 12 + 9]) + (partq[m * 12 + 10] + partq[m * 12 + 11]);
        v = v * (1.f / sqrtf(ss * (1.f / 256.f) + EPS));
        if (c < 1024) st_bf4(Kb + (size_t)m * 1536 + (c >> 7) * 192 + (c & 127), v); else st_bf4(Vb + (size_t)m * 1024 + (c - 1024), v);
        return v; }
    __device__ __forceinline__ void partial(int, int, float) const {} };
struct FOut { const float* x; float* out; bf16_t* hb; float* part;
    __device__ __forceinline__ f32x4 operator()(int m, int c, f32x4 v) const { const f32x4 h = *(const f32x4*)(x + (size_t)m * D_ + c) + v;
        *(f32x4*)(out + (size_t)m * D_ + c) = h; st_bf4(hb + (size_t)m * D_ + c, h); return h; }
    __device__ __forceinline__ void partial(int m, int g, float ss) const { part[m * 32 + g] = ss; } };
struct FPle { float* out; const bf16_t* pp; const float* rstd; const float* bias; float* part;
    __device__ __forceinline__ f32x4 operator()(int m, int c, f32x4 v) const {
        const float r = rstd[m]; const f32x4 b = *(const f32x4*)(bias + c); const u32x2 pw = *(const u32x2*)(pp + (size_t)m * D_ + c);
        const f32x4 pv = {bf2f(pw.x & 0xffffu), bf2f(pw.x >> 16), bf2f(pw.y & 0xffffu), bf2f(pw.y >> 16)};
        f32x4 h = *(const f32x4*)(out + (size_t)m * D_ + c);
        h.x += sigmoidf_(v.x * r + b.x) * pv.x; h.y += sigmoidf_(v.y * r + b.y) * pv.y; h.z += sigmoidf_(v.z * r + b.z) * pv.z; h.w += sigmoidf_(v.w * r + b.w) * pv.w;
        *(f32x4*)(out + (size_t)m * D_ + c) = h; return h; }
    __device__ __forceinline__ void partial(int m, int g, float ss) const { part[m * 32 + g] = ss; } };

__device__ __forceinline__ void kpe_run(const Params& P, int wg, int nwg, int wv) {
    const int gt = wg * 512 + TIDX, NGT = nwg * 512;
    const bf16_t* proj = WSP(bf16_t, WS_PROJ); bf16_t* Kb = WSP(bf16_t, WS_KB); const float* cs = WSP(float, WS_COS); const float* sn = WSP(float, WS_SIN);
    for (int i = gt; i < S_ * 32; i += NGT) { const int m = i >> 5, j = i & 31;
        const unsigned w = *(const unsigned*)(proj + (size_t)m * DINP + PC_KPE + 2 * j);
        const float a = bf2f(w & 0xffffu), b = bf2f(w >> 16), c = cs[i], s = sn[i];
        const unsigned o = pk2(a * c - b * s, b * c + a * s);
#pragma unroll
        for (int h = 0; h < NH; ++h) *(unsigned*)(Kb + (size_t)m * 1536 + h * 192 + 128 + 2 * j) = o; }
}

__device__ __forceinline__ void attn_naive_run(const Params& P, int wg, int nwg, int wv) {
    const int lane = TIDX & 63, gw = wg * 8 + (TIDX >> 6), NGW = nwg * 8;
    const bf16_t* Qb = WSP(bf16_t, WS_QB); const bf16_t* Kb = WSP(bf16_t, WS_KB); const bf16_t* Vb = WSP(bf16_t, WS_VB);
    bf16_t* Op = WSP(bf16_t, WS_OPART); float* ml = WSP(float, WS_ML);
    for (int it = gw; it < S_ * NH; it += NGW) {
        const int h = it & 7, m = S_ - 1 - (it >> 3);
        const bf16_t* q = Qb + (size_t)m * 1536 + h * 192 + 3 * lane;
        const float q0 = bf2f(q[0]), q1 = bf2f(q[1]), q2 = bf2f(q[2]);
        float mx = -1e30f, l = 0.f, o0 = 0.f, o1 = 0.f;
        for (int key = 0; key <= m; ++key) {
            const bf16_t* kr = Kb + (size_t)key * 1536 + h * 192 + 3 * lane;
            float s = q0 * bf2f(kr[0]) + q1 * bf2f(kr[1]) + q2 * bf2f(kr[2]);
            s = wave_sum(s);
            const float mn = fmaxf(mx, s), al = exp2f(mx - mn), p = exp2f(s - mn);
            const unsigned vw = *(const unsigned*)(Vb + (size_t)key * 1024 + h * 128 + 2 * lane);
            l = l * al + p; o0 = o0 * al + p * bf2f(vw & 0xffffu); o1 = o1 * al + p * bf2f(vw >> 16); mx = mn;
        }
        const float rl = 1.f / l;
        *(unsigned*)(Op + (size_t)m * 1024 + h * 128 + 2 * lane) = pk2(o0 * rl, o1 * rl);
        *(unsigned*)(Op + (size_t)S_ * 1024 + (size_t)m * 1024 + h * 128 + 2 * lane) = 0u;
        if (lane == 0) { float* a = ml + ((size_t)m * 8 + h) * 2; a[0] = 0.f; a[1] = 1.f; float* b = ml + (size_t)S_ * 16 + ((size_t)m * 8 + h) * 2; b[0] = -1e30f; b[1] = 0.f; }
    }
}
__device__ __forceinline__ void combine_run(const Params& P, int wg, int nwg, int wv) {
    const int lane = TIDX & 63, gw = wg * 8 + (TIDX >> 6), NGW = nwg * 8;
    const bf16_t* Op = WSP(bf16_t, WS_OPART); const float* ml = WSP(float, WS_ML); bf16_t* ymix = WSP(bf16_t, WS_YMIX);
    for (int m = gw; m < S_; m += NGW) {
        const int h = lane >> 3;
        const float m0 = ml[((size_t)m * 8 + h) * 2], l0 = ml[((size_t)m * 8 + h) * 2 + 1];
        const float m1 = ml[(size_t)S_ * 16 + ((size_t)m * 8 + h) * 2], l1 = ml[(size_t)S_ * 16 + ((size_t)m * 8 + h) * 2 + 1];
        const float mm = fmaxf(m0, m1); float w0 = l0 * exp2f(m0 - mm), w1 = l1 * exp2f(m1 - mm); const float rs = 1.f / (w0 + w1); w0 *= rs; w1 *= rs;
        const u32x4* a = (const u32x4*)(Op + (size_t)m * 1024 + 16 * lane); const u32x4* b = (const u32x4*)(Op + (size_t)S_ * 1024 + (size_t)m * 1024 + 16 * lane);
        float o[16]; float ss = 0.f;
#pragma unroll
        for (int j = 0; j < 2; ++j) { const u32x4 ua = a[j], ub = b[j]; const unsigned wa[4] = {ua.x, ua.y, ua.z, ua.w}, wb[4] = {ub.x, ub.y, ub.z, ub.w};
#pragma unroll
            for (int i = 0; i < 4; ++i) { o[8 * j + 2 * i] = w0 * bf2f(wa[i] & 0xffffu) + w1 * bf2f(wb[i] & 0xffffu); o[8 * j + 2 * i + 1] = w0 * bf2f(wa[i] >> 16) + w1 * bf2f(wb[i] >> 16); } }
#pragma unroll
        for (int i = 0; i < 16; ++i) ss += o[i] * o[i];
        ss = wave_sum(ss); const float r = 1.f / sqrtf(ss * (1.f / 1024.f) + EPS);
        u32x4 w0v, w1v;
        w0v.x = pk2(o[0] * r, o[1] * r); w0v.y = pk2(o[2] * r, o[3] * r); w0v.z = pk2(o[4] * r, o[5] * r); w0v.w = pk2(o[6] * r, o[7] * r);
        w1v.x = pk2(o[8] * r, o[9] * r); w1v.y = pk2(o[10] * r, o[11] * r); w1v.z = pk2(o[12] * r, o[13] * r); w1v.w = pk2(o[14] * r, o[15] * r);
        u32x4* y = (u32x4*)(ymix + (size_t)m * D_ + 16 * lane); y[0] = w0v; y[1] = w1v;
    }
}

__device__ __forceinline__ void hgrn_naive_run(const Params& P, int wg, int wv, LAS unsigned char* lds) {
    if (wg >= NH) return;
    const int h = wg, tid = TIDX; const bool act = tid < 128; const int v = tid & 127;
    const bf16_t* proj = WSP(bf16_t, WS_PROJ); const float* lb = WSP(float, WS_LB); bf16_t* ymix = WSP(bf16_t, WS_YMIX);
    LAS float* sf = (LAS float*)lds; LAS float* sq = sf + 128; LAS float* red = sq + 128;
    float st[128];
#pragma unroll
    for (int k = 0; k < 128; ++k) st[k] = 0.f;
    for (int t = 0; t < S_; ++t) {
        const bf16_t* pr = proj + (size_t)t * DINP;
        if (act) { const float l = lb[h * 128 + v]; sf[v] = l + (1.f - l) * sigmoidf_(bf2f(pr[PC_HF + h * 128 + v])); sq[v] = siluf_(bf2f(pr[PC_HQ + h * 128 + v])); }
        __syncthreads();
        float o = 0.f;
        if (act) { const float iv = bf2f(pr[PC_HI + h * 128 + v]);
#pragma unroll
            for (int k = 0; k < 128; ++k) { const float f = sf[k]; st[k] = f * st[k] + (1.f - f) * iv; o += sq[k] * st[k]; } }
        float ss = act ? o * o : 0.f; ss = wave_sum(ss);
        if (act && (tid & 63) == 0) red[tid >> 6] = ss;
        __syncthreads();
        if (act) { const float r = 1.f / sqrtf((red[0] + red[1]) * (1.f / 128.f) + EPS);
            ymix[(size_t)t * D_ + 1024 + h * 128 + v] = (bf16_t)f2bf(o * r * siluf_(bf2f(pr[PC_HG + h * 128 + v]))); }
    }
}

__device__ __forceinline__ void route_run(const Params& P, int wg, int nwg, int wv, LAS unsigned char* lds) {
    const int lane = TIDX & 63, wave = TIDX >> 6, gw = wg * 8 + wave, NGW = nwg * 8;
    const float* h1 = P.out; const float* Wr = WSP(float, WS_WR); const float* part1 = WSP(float, WS_PART1);
    LAS float* lg = (LAS float*)lds + wave * 96;
    int* cnt = WSP(int, WS_CTL); int* list = WSP(int, WS_LIST); int* eid = WSP(int, WS_EID); float* ew = WSP(float, WS_EW); float* rstd1 = WSP(float, WS_RSTD1);
    for (int t = gw; t < S_; t += NGW) {
        float ss = (lane < 32) ? part1[t * 32 + lane] : 0.f; ss = wave_sum(ss); const float r = 1.f / sqrtf(ss * (1.f / D_) + EPS);
        float a0 = 0.f, a1 = 0.f; const float* hr = h1 + (size_t)t * D_;
        for (int k = 0; k < D_; ++k) { const float hv = hr[k]; a0 = fmaf(hv, Wr[k * 80 + lane], a0); if (lane < 16) a1 = fmaf(hv, Wr[k * 80 + 64 + lane], a1); }
        lg[lane] = a0 * r; if (lane < 16) lg[64 + lane] = a1 * r;
        asm volatile("s_waitcnt lgkmcnt(0)" ::: "memory");
        if (lane == 0) {
            rstd1[t] = r;
            int g = 0; float gm = -INFINITY;
            for (int i = 0; i < 8; ++i) { const float v = lg[i] + P.b_rg[i]; if (v > gm) { gm = v; g = i; } }
            float gs = 0.f; for (int i = 0; i < 8; ++i) gs += expf(lg[i] + P.b_rg[i] - gm);
            const float gw_ = 1.f / gs;
            int i1 = 0, i2 = 0; float l1 = -INFINITY, l2 = -INFINITY;
            for (int i = 0; i < 8; ++i) { const float e = lg[8 + g * 8 + i] + P.b_re[g * 8 + i];
                if (e > l1) { l2 = l1; i2 = i1; l1 = e; i1 = i; } else if (e > l2) { l2 = e; i2 = i; } }
            const float p2 = expf(l2 - l1), w1 = gw_ / (1.f + p2), w2 = gw_ * p2 / (1.f + p2);
            const int e1 = g * 8 + i1, e2 = g * 8 + i2;
            eid[2 * t] = e1; eid[2 * t + 1] = e2; ew[2 * t] = w1; ew[2 * t + 1] = w2;
            const int p1 = atomicAdd(&cnt[e1], 1); list[e1 * LISTCAP + p1] = 2 * t;
            const int q2 = atomicAdd(&cnt[e2], 1); list[e2 * LISTCAP + q2] = 2 * t + 1;
        }
        asm volatile("s_waitcnt lgkmcnt(0)" ::: "memory");
    }
}

__device__ __forceinline__ void moe_up_naive_run(const Params& P, int wg, int nwg, int wv) {
    const int lane = TIDX & 63, gw = wg * 8 + (TIDX >> 6), NGW = nwg * 8;
    const int* cnt = WSP(int, WS_CTL); const int* list = WSP(int, WS_LIST); const float* rstd1 = WSP(float, WS_RSTD1);
    const bf16_t* h1b = WSP(bf16_t, WS_H1B); bf16_t* hmid = WSP(bf16_t, WS_HMID);
    int off = 0, tbase = 0;
    for (int e = 0; e < NE; ++e) {
        const int n = cnt[e], nrg = (n + 63) >> 6, nit = nrg * 16;
        for (int it = gw - off; it < nit; it += NGW) {
            if (it < 0) continue;
            const int rg = it >> 4, cg = it & 15, c0 = cg * 32;
            const int nrows = (n - rg * 64) < 64 ? (n - rg * 64) : 64;
            const int a = list[e * LISTCAP + rg * 64 + (lane < nrows ? lane : 0)]; const int tok = a >> 1;
            const bf16_t* ar = h1b + (size_t)tok * D_;
            const bf16_t* W = WSP(bf16_t, WS_WGU) + (size_t)e * 1024 * 2048;
            const int pn = c0 >> 7, rr = c0 & 127;
            float ag[32], au[32];
#pragma unroll
            for (int c = 0; c < 32; ++c) { ag[c] = 0.f; au[c] = 0.f; }
            for (int k = 0; k < D_; k += 8) {
                const u32x4 av = *(const u32x4*)(ar + k); float af[8];
                af[0] = bf2f(av.x & 0xffffu); af[1] = bf2f(av.x >> 16); af[2] = bf2f(av.y & 0xffffu); af[3] = bf2f(av.y >> 16);
                af[4] = bf2f(av.z & 0xffffu); af[5] = bf2f(av.z >> 16); af[6] = bf2f(av.w & 0xffffu); af[7] = bf2f(av.w >> 16);
#pragma unroll
                for (int c = 0; c < 32; ++c) {
                    const u32x4 bg = *(const u32x4*)(W + (size_t)(pn * 256 + rr + c) * 2048 + k); const u32x4 bu = *(const u32x4*)(W + (size_t)(pn * 256 + 128 + rr + c) * 2048 + k);
                    float s = ag[c], u = au[c];
                    s = fmaf(af[0], bf2f(bg.x & 0xffffu), s); s = fmaf(af[1], bf2f(bg.x >> 16), s); s = fmaf(af[2], bf2f(bg.y & 0xffffu), s); s = fmaf(af[3], bf2f(bg.y >> 16), s);
                    s = fmaf(af[4], bf2f(bg.z & 0xffffu), s); s = fmaf(af[5], bf2f(bg.z >> 16), s); s = fmaf(af[6], bf2f(bg.w & 0xffffu), s); s = fmaf(af[7], bf2f(bg.w >> 16), s);
                    u = fmaf(af[0], bf2f(bu.x & 0xffffu), u); u = fmaf(af[1], bf2f(bu.x >> 16), u); u = fmaf(af[2], bf2f(bu.y & 0xffffu), u); u = fmaf(af[3], bf2f(bu.y >> 16), u);
                    u = fmaf(af[4], bf2f(bu.z & 0xffffu), u); u = fmaf(af[5], bf2f(bu.z >> 16), u); u = fmaf(af[6], bf2f(bu.w & 0xffffu), u); u = fmaf(af[7], bf2f(bu.w >> 16), u);
                    ag[c] = s; au[c] = u;
                }
            }
            if (lane < nrows) { const float r = rstd1[tok]; const int slot = tbase * 256 + rg * 64 + lane;
#pragma unroll
                for (int c = 0; c < 32; c += 2) *(unsigned*)(hmid + (size_t)slot * DE + c0 + c) = pk2(siluf_(ag[c] * r) * (au[c] * r), siluf_(ag[c + 1] * r) * (au[c + 1] * r)); }
        }
        off = (off + nit) % NGW; tbase += (n + 255) >> 8;
    }
}
struct FDown { bf16_t* y; const int* lst; int slot0; const float* ew;
    __device__ __forceinline__ f32x4 operator()(int m, int c, f32x4 v) const { const int a = lst[m - slot0]; v = v * ew[a]; st_bf4(y + (size_t)a * D_ + c, v); return v; }
    __device__ __forceinline__ void partial(int, int, float) const {} };
__device__ __forceinline__ void moe_down_naive_run(const Params& P, int wg, int nwg, int wv) {
    const int lane = TIDX & 63, gw = wg * 8 + (TIDX >> 6), NGW = nwg * 8;
    const int* cnt = WSP(int, WS_CTL); const int* list = WSP(int, WS_LIST); const float* ew = WSP(float, WS_EW);
    const bf16_t* hmid = WSP(bf16_t, WS_HMID); bf16_t* y = WSP(bf16_t, WS_Y);
    int off = 0, tbase = 0;
    for (int e = 0; e < NE; ++e) {
        const int n = cnt[e], nrg = (n + 63) >> 6, nit = nrg * 32;
        for (int it = gw - off; it < nit; it += NGW) {
            if (it < 0) continue;
            const int rg = it >> 5, cg = it & 31; const int nrows = (n - rg * 64) < 64 ? (n - rg * 64) : 64;
            const int slot0 = tbase * 256 + rg * 64;
            FDown f{y, list + e * LISTCAP + rg * 64, slot0, ew};
            naive_gemm_item(hmid, DE, WSP(bf16_t, WS_WD) + (size_t)e * 2048 * DE, DE, DE, slot0, nrows, cg * 64, f, RowId{}, lane);
        }
        off = (off + nit) % NGW; tbase += (n + 255) >> 8;
    }
}
__device__ __forceinline__ void moe_combine_run(const Params& P, int wg, int nwg, int wv) {
    const int lane = TIDX & 63, gw = wg * 8 + (TIDX >> 6), NGW = nwg * 8;
    const bf16_t* y = WSP(bf16_t, WS_Y); bf16_t* h2b = WSP(bf16_t, WS_H2B); float* rstd2 = WSP(float, WS_RSTD2);
    for (int m = gw; m < S_; m += NGW) {
        f32x4* hr = (f32x4*)(P.out + (size_t)m * D_) + lane; const u32x2* y0 = (const u32x2*)(y + (size_t)(2 * m) * D_) + lane; const u32x2* y1 = (const u32x2*)(y + (size_t)(2 * m + 1) * D_) + lane;
        u32x2* ob = (u32x2*)(h2b + (size_t)m * D_) + lane; float ss = 0.f;
#pragma unroll
        for (int j = 0; j < 8; ++j) { f32x4 h = hr[64 * j]; const u32x2 a = y0[64 * j], b = y1[64 * j];
            h.x += bf2f(a.x & 0xffffu) + bf2f(b.x & 0xffffu); h.y += bf2f(a.x >> 16) + bf2f(b.x >> 16); h.z += bf2f(a.y & 0xffffu) + bf2f(b.y & 0xffffu); h.w += bf2f(a.y >> 16) + bf2f(b.y >> 16);
            hr[64 * j] = h; u32x2 w; w.x = pk2(h.x, h.y); w.y = pk2(h.z, h.w); ob[64 * j] = w; ss += (h.x * h.x + h.y * h.y) + (h.z * h.z + h.w * h.w); }
        ss = wave_sum(ss); if (lane == 0) rstd2[m] = 1.f / sqrtf(ss * (1.f / D_) + EPS);
    }
}
__device__ __forceinline__ void final_run(const Params& P, int wg, int nwg, int wv) {
    const int lane = TIDX & 63, gw = wg * 8 + (TIDX >> 6), NGW = nwg * 8; const float* part3 = WSP(float, WS_PART3);
    for (int m = gw; m < S_; m += NGW) {
        float ss = (lane < 32) ? part3[m * 32 + lane] : 0.f; ss = wave_sum(ss); const float r = 1.f / sqrtf(ss * (1.f / D_) + EPS);
        f32x4* hr = (f32x4*)(P.out + (size_t)m * D_) + lane; const f32x4* g = (const f32x4*)P.final_norm + lane;
#pragma unroll
        for (int j = 0; j < 8; ++j) hr[64 * j] = hr[64 * j] * r * g[64 * j];
    }
}

namespace pg8 {
typedef short bf16x8 __attribute__((ext_vector_type(8)));
constexpr int BM = 256, BK = 64, HALF = 128, HTB = HALF * BK * 2, STAGE_BYTES = 8 * HTB, NXCD = 8, WGM = 8;
__device__ __forceinline__ int lds_byte(int r, int c) { const int st = (r >> 4) * 2 + (c >> 5), rr = r & 15, cc = c & 31, ob = rr * 64 + cc * 2; return st * 1024 + (ob ^ (((ob >> 9) & 1) << 5)); }
__device__ __forceinline__ void stage_rc(int b, int& R, int& C) { const int st = b / 1024, sb = b % 1024, swz = sb ^ (((sb >> 9) & 1) << 5); R = (st >> 1) * 16 + swz / 64; C = (st & 1) * 32 + (swz % 64) / 2; }
struct Unit { int pm, pn; const char* a; const char* b; int x0, x1, x2; };
struct DenseOrder {
    const bf16_t* A; const bf16_t* Bt; int K, lda, nM, nN, nwg, G, c;
    __device__ __forceinline__ void init(const bf16_t* A_, int lda_, const bf16_t* Bt_, int M, int N, int K_, int G_, int c_) { A = A_; lda = lda_; Bt = Bt_; K = K_; nM = M / BM; nN = N / BM; nwg = nM * nN; G = G_; c = c_; }
    __device__ __forceinline__ bool next(int i, Unit& u) const {
        const long L = (long)i * G + c; if (L >= nwg) return false;
        int wgid = (int)L; { const int q = nwg / NXCD, r = nwg % NXCD, xcd = wgid % NXCD, off = wgid / NXCD; wgid = (xcd < r ? xcd * (q + 1) : r * (q + 1) + (xcd - r) * q) + off; }
        const int nig = WGM * nN, gid = wgid / nig, fm = gid * WGM, gsz = (nM - fm) < WGM ? (nM - fm) : WGM;
        u.pm = fm + ((wgid % nig) % gsz); u.pn = (wgid % nig) / gsz;
        u.a = (const char*)A + (size_t)u.pm * BM * lda * 2; u.b = (const char*)Bt + (size_t)u.pn * BM * K * 2; u.x0 = 0; u.x1 = 0; u.x2 = 0; return true;
    }
    __device__ __forceinline__ unsigned row_off(const Unit&, int) const { return 0u; }
};
template <class F> struct EpiF { F f;
    __device__ __forceinline__ void operator()(const f32x4 (&acc)[2][2][4][2], const Unit& u, int wr, int wc, int fr, int fq) const {
#pragma unroll
        for (int ai = 0; ai < 2; ++ai)
#pragma unroll
            for (int m = 0; m < 4; ++m) { const int r = ai * HALF + wr * 64 + m * 16 + fr; const auto ctx = f.row(u, r); float ss = 0.f;
#pragma unroll
                for (int bj = 0; bj < 2; ++bj)
#pragma unroll
                    for (int n = 0; n < 2; ++n) { const f32x4 v = f.elem(u, r, bj * HALF + wc * 32 + n * 16 + fq * 4, acc[ai][bj][m][n], ctx);
                        if (F::ROWSUM) ss += (v.x * v.x + v.y * v.y) + (v.z * v.z + v.w * v.w); }
                if (F::ROWSUM) { ss += __shfl_xor(ss, 16); ss += __shfl_xor(ss, 32); if (fq == 0) f.partial(u, r, wc, ss); }
                asm volatile("" ::: "memory"); }
    } };

template <class Epi, class Sched, bool GATHER>
__device__ __forceinline__ void gemm_phase(LAS unsigned char* lds, const int K, const int lda, const Sched& S, const Epi& E, const int wv) {
    const int wid = wv, lane = lane_id_(), tid = wid * 64 + lane, wr = wid >> 2, wc = wid & 3, fr = lane & 15, fq = lane >> 4;
    const int nt = K / BK;
    unsigned voffB[2], vA[2][2], vAn[2][2];
#pragma unroll
    for (int i = 0; i < 2; ++i) { int R, C; stage_rc(tid * 16 + i * 8192, R, C); voffB[i] = (unsigned)(R * K + C) * 2u;
        vA[0][i] = (unsigned)(R * lda + C) * 2u; vA[1][i] = vA[0][i]; vAn[0][i] = vA[0][i]; vAn[1][i] = vA[0][i]; }
    const size_t kstep = (size_t)(BK * 2);
    const size_t hstepB = (size_t)HALF * K * 2;
    const size_t hstepA = GATHER ? (size_t)0 : (size_t)HALF * lda * 2;
    const unsigned ldsw = (unsigned)wid * 1024u;
    const int aoff = lds_byte(wr * 64 + fr, fq * 8), boff = lds_byte(wc * 32 + fr, fq * 8);
#define PG8_SA(b, h) (((b) * 2 + (h)) * HTB)
#define PG8_SB(b, h) ((4 + (b) * 2 + (h)) * HTB)
#define PG8_STAGE(bufoff, gbase, voff) do { _Pragma("unroll") for (int _i = 0; _i < 2; ++_i) \
        __builtin_amdgcn_global_load_lds((const unsigned*)((const char*)(gbase) + (voff)[_i]), (LAS unsigned*)(lds + (bufoff) + ldsw + _i * 8192), 16, 0, 0); } while (0)
#define PG8_LDA(dst, b, h) do { _Pragma("unroll") for (int m = 0; m < 4; ++m) _Pragma("unroll") for (int k = 0; k < 2; ++k) dst[m][k] = *(const LAS bf16x8*)(lds + PG8_SA(b, h) + aoff + m * 2048 + k * 1024); } while (0)
#define PG8_LDB(dst, b, h) do { _Pragma("unroll") for (int n = 0; n < 2; ++n) _Pragma("unroll") for (int k = 0; k < 2; ++k) dst[n][k] = *(const LAS bf16x8*)(lds + PG8_SB(b, h) + boff + n * 2048 + k * 1024); } while (0)
#define PG8_MMA(ai, bj, At, Bt) do { __builtin_amdgcn_s_setprio(1); _Pragma("unroll") for (int m = 0; m < 4; ++m) _Pragma("unroll") for (int n = 0; n < 2; ++n) _Pragma("unroll") for (int k = 0; k < 2; ++k) \
        acc[ai][bj][m][n] = __builtin_amdgcn_mfma_f32_16x16x32_bf16(Bt[n][k], At[m][k], acc[ai][bj][m][n], 0, 0, 0); __builtin_amdgcn_s_setprio(0); } while (0)
#define PG8_WAIT_V(n) asm volatile("s_waitcnt vmcnt(" #n ")" ::: "memory")
#define PG8_WAIT_L(n) asm volatile("s_waitcnt lgkmcnt(" #n ")" ::: "memory")
#define PG8_BAR __builtin_amdgcn_s_barrier()
#define PG8_SCHED __builtin_amdgcn_sched_barrier(0)
#define PG8_GOFF(dst, uu) do { if constexpr (GATHER) { _Pragma("unroll") for (int _i = 0; _i < 2; ++_i) { int _R, _C; stage_rc((wid * 64 + lane_id_()) * 16 + _i * 8192, _R, _C); \
        _Pragma("unroll") for (int _h = 0; _h < 2; ++_h) dst[_h][_i] = S.row_off(uu, _R + _h * HALF) + (unsigned)_C * 2u; } } } while (0)
    Unit cur, nxt; int ui = 0;
    if (!S.next(0, cur)) return;
    PG8_GOFF(vA, cur);
    f32x4 acc[2][2][4][2];
#pragma unroll
    for (int a = 0; a < 2; ++a)
#pragma unroll
        for (int b = 0; b < 2; ++b)
#pragma unroll
            for (int m = 0; m < 4; ++m)
#pragma unroll
                for (int n = 0; n < 2; ++n) acc[a][b][m][n] = (f32x4){0.f, 0.f, 0.f, 0.f};
    bf16x8 At[4][2], B0[2][2], B1[2][2];
    const char* cA = cur.a; const char* cB = cur.b;
    PG8_STAGE(PG8_SB(0, 0), cB, voffB); PG8_STAGE(PG8_SB(0, 1), cB + hstepB, voffB); PG8_STAGE(PG8_SA(0, 0), cA, vA[0]); PG8_STAGE(PG8_SA(0, 1), cA + hstepA, vA[1]);
    if (wr == 1) PG8_BAR;
    PG8_WAIT_V(2); PG8_BAR;
    PG8_STAGE(PG8_SB(1, 0), cB + kstep, voffB); PG8_STAGE(PG8_SA(1, 0), cA + kstep, vA[0]); PG8_STAGE(PG8_SB(1, 1), cB + hstepB + kstep, voffB);
    PG8_WAIT_V(6); PG8_BAR;
    for (;;) {
        const bool has_next = S.next(ui + 1, nxt);
        const char* nA = has_next ? nxt.a : cA; const char* nB = has_next ? nxt.b : cB;
        if constexpr (GATHER) { if (has_next) { PG8_GOFF(vAn, nxt); } else {
#pragma unroll
            for (int h = 0; h < 2; ++h)
#pragma unroll
                for (int i = 0; i < 2; ++i) vAn[h][i] = vA[h][i]; } }
        for (int t = 0; t < nt; t += 2) {
            const bool last = (t == nt - 2);
            const char* a1 = cA + (size_t)(t + 1) * kstep;
            const char* a2 = last ? nA : cA + (size_t)(t + 2) * kstep; const char* b2 = last ? nB : cB + (size_t)(t + 2) * kstep;
            const char* a3 = a2 + kstep; const char* b3 = b2 + kstep;
            unsigned w0[2], w1[2];
#pragma unroll
            for (int i = 0; i < 2; ++i) { w0[i] = (GATHER && last) ? vAn[0][i] : vA[0][i]; w1[i] = (GATHER && last) ? vAn[1][i] : vA[1][i]; }
            PG8_LDB(B0, 0, 0); PG8_LDB(B1, 0, 1); PG8_SCHED; PG8_LDA(At, 0, 0); PG8_STAGE(PG8_SA(1, 1), a1 + hstepA, vA[1]);
            PG8_WAIT_V(8); PG8_WAIT_L(0); PG8_BAR; PG8_MMA(0, 0, At, B0); PG8_MMA(0, 1, At, B1); PG8_BAR; PG8_SCHED;
            PG8_LDA(At, 0, 1); PG8_STAGE(PG8_SB(0, 0), b2, voffB); PG8_STAGE(PG8_SB(0, 1), b2 + hstepB, voffB); PG8_STAGE(PG8_SA(0, 0), a2, w0);
            PG8_WAIT_V(8); PG8_WAIT_L(0); PG8_BAR; PG8_MMA(1, 0, At, B0); PG8_MMA(1, 1, At, B1); PG8_BAR; PG8_SCHED;
            PG8_LDB(B0, 1, 0); PG8_LDB(B1, 1, 1); PG8_SCHED; PG8_LDA(At, 1, 0); PG8_STAGE(PG8_SA(0, 1), a2 + hstepA, w1);
            PG8_WAIT_V(8); PG8_WAIT_L(0); PG8_BAR; PG8_MMA(0, 0, At, B0); PG8_MMA(0, 1, At, B1); PG8_BAR; PG8_SCHED;
            PG8_LDA(At, 1, 1); PG8_STAGE(PG8_SB(1, 0), b3, voffB); PG8_STAGE(PG8_SB(1, 1), b3 + hstepB, voffB); PG8_STAGE(PG8_SA(1, 0), a3, w0);
            PG8_WAIT_V(8); PG8_WAIT_L(0); PG8_BAR; PG8_MMA(1, 0, At, B0); PG8_MMA(1, 1, At, B1); PG8_BAR; PG8_SCHED;
        }
        if (wr == 0) PG8_BAR;
        E(acc, cur, wr, wc, fr, fq);
        if (!has_next) break;
#pragma unroll
        for (int a = 0; a < 2; ++a)
#pragma unroll
            for (int b = 0; b < 2; ++b)
#pragma unroll
                for (int m = 0; m < 4; ++m)
#pragma unroll
                    for (int n = 0; n < 2; ++n) acc[a][b][m][n] = (f32x4){0.f, 0.f, 0.f, 0.f};
        cur = nxt; cA = nA; cB = nB; ++ui;
        if constexpr (GATHER) {
#pragma unroll
            for (int h = 0; h < 2; ++h)
#pragma unroll
                for (int i = 0; i < 2; ++i) vA[h][i] = vAn[h][i]; }
        if (wr == 1) PG8_BAR;
    }
    PG8_WAIT_V(0);
    PG8_BAR;
#undef PG8_SA
#undef PG8_SB
#undef PG8_STAGE
#undef PG8_LDA
#undef PG8_LDB
#undef PG8_MMA
#undef PG8_WAIT_V
#undef PG8_WAIT_L
#undef PG8_BAR
#undef PG8_SCHED
#undef PG8_GOFF
}
}

struct PFProj { static constexpr bool ROWSUM = true; bf16_t* proj; const float* rstd; float* partq;
    __device__ __forceinline__ float row(const pg8::Unit& u, int r) const { return rstd[u.pm * 256 + r]; }
    __device__ __forceinline__ f32x4 elem(const pg8::Unit& u, int r, int c, f32x4 v, float rs) const { v = v * rs; st_bf4(proj + (size_t)(u.pm * 256 + r) * DINP + u.pn * 256 + c, v); return v; }
    __device__ __forceinline__ void partial(const pg8::Unit& u, int r, int wc, float ss) const { const int g = u.pn * 4 + wc; if (g < 12) partq[(u.pm * 256 + r) * 12 + g] = ss; } };
struct PFPP { static constexpr bool ROWSUM = false; bf16_t* pp;
    __device__ __forceinline__ int row(const pg8::Unit&, int) const { return 0; }
    __device__ __forceinline__ f32x4 elem(const pg8::Unit& u, int r, int c, f32x4 v, int) const { st_bf4(pp + (size_t)(u.pm * 256 + r) * D_ + u.pn * 256 + c, v); return v; }
    __device__ __forceinline__ void partial(const pg8::Unit&, int, int, float) const {} };
struct PFQ { static constexpr bool ROWSUM = false; bf16_t* Qb; const float* partq; const float* cs; const float* sn;
    __device__ __forceinline__ float row(const pg8::Unit& u, int r) const { const f32x4* p = (const f32x4*)(partq + (size_t)(u.pm * 256 + r) * 12); const f32x4 a = p[0], b = p[1];
        const float ss = ((a.x + a.y) + (a.z + a.w)) + ((b.x + b.y) + (b.z + b.w)); return QSCALE / sqrtf(ss * (1.f / 512.f) + EPS); }
    __device__ __forceinline__ f32x4 elem(const pg8::Unit& u, int r, int cc, f32x4 v, float sc) const { const int m = u.pm * 256 + r, c = u.pn * 256 + cc; v = v * sc;
        if (u.pn < 4) { st_bf4(Qb + (size_t)m * 1536 + (c >> 7) * 192 + (c & 127), v); }
        else { const int q = c - 1024, h = q >> 6, j = q & 63, i0 = j >> 1;
            const float c0 = cs[m * 32 + i0], s0 = sn[m * 32 + i0], c1 = cs[m * 32 + i0 + 1], s1 = sn[m * 32 + i0 + 1];
            const f32x4 o = {v.x * c0 - v.y * s0, v.y * c0 + v.x * s0, v.z * c1 - v.w * s1, v.w * c1 + v.z * s1};
            st_bf4(Qb + (size_t)m * 1536 + h * 192 + 128 + j, o); }
        return v; }
    __device__ __forceinline__ void partial(const pg8::Unit&, int, int, float) const {} };
struct PFKV { static constexpr bool ROWSUM = false; bf16_t* Kb; bf16_t* Vb; const float* partq;
    __device__ __forceinline__ float row(const pg8::Unit& u, int r) const { const f32x4 a = *(const f32x4*)(partq + (size_t)(u.pm * 256 + r) * 12 + 8);
        return 1.f / sqrtf(((a.x + a.y) + (a.z + a.w)) * (1.f / 256.f) + EPS); }
    __device__ __forceinline__ f32x4 elem(const pg8::Unit& u, int r, int cc, f32x4 v, float sc) const { const int m = u.pm * 256 + r, c = u.pn * 256 + cc; v = v * sc;
        if (u.pn < 4) st_bf4(Kb + (size_t)m * 1536 + (c >> 7) * 192 + (c & 127), v); else st_bf4(Vb + (size_t)m * 1024 + (c - 1024), v);
        return v; }
    __device__ __forceinline__ void partial(const pg8::Unit&, int, int, float) const {} };
struct PFOut { static constexpr bool ROWSUM = true; const float* x; float* out; bf16_t* hb; float* part;
    __device__ __forceinline__ int row(const pg8::Unit&, int) const { return 0; }
    __device__ __forceinline__ f32x4 elem(const pg8::Unit& u, int r, int cc, f32x4 v, int) const { const size_t o = (size_t)(u.pm * 256 + r) * D_ + u.pn * 256 + cc;
        const f32x4 h = *(const f32x4*)(x + o) + v; *(f32x4*)(out + o) = h; st_bf4(hb + o, h); return h; }
    __device__ __forceinline__ void partial(const pg8::Unit& u, int r, int wc, float ss) const { part[(u.pm * 256 + r) * 32 + u.pn * 4 + wc] = ss; } };
struct PFPle { static constexpr bool ROWSUM = true; float* out; const bf16_t* pp; const float* rstd; const float* bias; float* part;
    __device__ __forceinline__ float row(const pg8::Unit& u, int r) const { return rstd[u.pm * 256 + r]; }
    __device__ __forceinline__ f32x4 elem(const pg8::Unit& u, int r, int cc, f32x4 v, float rs) const { const int c = u.pn * 256 + cc; const size_t o = (size_t)(u.pm * 256 + r) * D_ + c;
        const f32x4 b = *(const f32x4*)(bias + c); const u32x2 pw = *(const u32x2*)(pp + o);
        const f32x4 pv = {bf2f(pw.x & 0xffffu), bf2f(pw.x >> 16), bf2f(pw.y & 0xffffu), bf2f(pw.y >> 16)};
        f32x4 h = *(const f32x4*)(out + o);
        h.x += sigmoidf_(v.x * rs + b.x) * pv.x; h.y += sigmoidf_(v.y * rs + b.y) * pv.y; h.z += sigmoidf_(v.z * rs + b.z) * pv.z; h.w += sigmoidf_(v.w * rs + b.w) * pv.w;
        *(f32x4*)(out + o) = h; return h; }
    __device__ __forceinline__ void partial(const pg8::Unit& u, int r, int wc, float ss) const { part[(u.pm * 256 + r) * 32 + u.pn * 4 + wc] = ss; } };
template <class F> __device__ __forceinline__ void dense_gemm(LAS unsigned char* lds, const bf16_t* A, int lda, const bf16_t* Bt, int M, int N, int K, const F& f, int wg, int nwg, int wv) {
    asm volatile("" : "+s"(K), "+s"(lda));
    pg8::DenseOrder S; S.init(A, lda, Bt, M, N, K, nwg, wg);
    pg8::EpiF<F> E{f};
    pg8::gemm_phase<pg8::EpiF<F>, pg8::DenseOrder, false>(lds, K, lda, S, E, wv);
}


namespace att {
typedef short bf16x8 __attribute__((ext_vector_type(8)));
typedef short s16x4 __attribute__((ext_vector_type(4)));
typedef float f32x16 __attribute__((ext_vector_type(16)));
constexpr int KVBLK = 64, QBLK = 32, QB = 256, KROW = 384  , SHM_V = 64 * 128 * 2, SHM_K = 64 * KROW;
constexpr int LDQ = 1536, LDK = 1536, LDV = 1024, LDO = 1024;
constexpr float THR = 8.f;
#define KSWZ(row, colB) ((row) * KROW + ((colB) ^ (((row) & 7) << 4)))
#define SBAR() __builtin_amdgcn_sched_barrier(0)
__device__ __forceinline__ int v_st(int k, int c) { const int kk = (k & ~0xC) | ((k & 4) << 1) | ((k & 8) >> 1); return ((kk >> 3) * 4 + (c >> 5)) * 512 + ((kk & 7) * 32 + (c & 31)) * 2; }
__device__ __forceinline__ int v_rd_base(int lane) { return ((lane & 3) << 3) | (((lane >> 2) & 3) << 6) | (((lane >> 4) & 1) << 5) | (((lane >> 5) & 1) << 8); }
constexpr int v_rd_off(int d0, int ks, int half) { return d0 * 512 + ks * 4096 + half * 2048; }
__device__ __forceinline__ int crow(int r, int hi) { return (r & 3) + 8 * (r >> 2) + 4 * hi; }
__device__ __forceinline__ unsigned cvtpk(float lo, float hi) { unsigned r; asm volatile("v_cvt_pk_bf16_f32 %0, %1, %2" : "=v"(r) : "v"(lo), "v"(hi)); return r; }
__device__ __forceinline__ void mask_tile(f32x16& p0, f32x16& p1, int dq) {
    const float NEG = -__builtin_inff();
#pragma unroll
    for (int r = 0; r < 16; ++r) { const int c = (r & 3) + 8 * (r >> 2); if (dq - c < 0) p0[r] = NEG; if (dq - c - 32 < 0) p1[r] = NEG; }
}
__device__ __forceinline__ void partialSM(f32x16& p0, f32x16& p1, float& m_reg, float& mn, float& alpha) {
    float pmax = p0[0];
#pragma unroll
    for (int r = 1; r < 16; ++r) pmax = fmaxf(pmax, p0[r]);
#pragma unroll
    for (int r = 0; r < 16; ++r) pmax = fmaxf(pmax, p1[r]);
    { auto rr = __builtin_amdgcn_permlane32_swap(__float_as_uint(pmax), __float_as_uint(pmax), false, false);
      pmax = fmaxf(__uint_as_float(rr[0]), __uint_as_float(rr[1])); }
    if (__builtin_expect(__all((pmax - m_reg) <= THR), 1)) { mn = m_reg; alpha = 1.f; }
    else { mn = fmaxf(m_reg, pmax); alpha = __builtin_amdgcn_exp2f(m_reg - mn); m_reg = mn; }
#pragma unroll
    for (int r = 0; r < 16; ++r) p0[r] = p0[r] - mn;
#pragma unroll
    for (int r = 0; r < 16; ++r) p1[r] = p1[r] - mn;
#pragma unroll
    for (int r = 0; r < 16; ++r) p0[r] = __builtin_amdgcn_exp2f(p0[r]);
}
__device__ __forceinline__ void finishSM(f32x16& p0, f32x16& p1, float alpha, float& l_reg, bf16x8& pa0, bf16x8& pa1, bf16x8& pa2, bf16x8& pa3) {
#pragma unroll
    for (int r = 0; r < 16; ++r) p1[r] = __builtin_amdgcn_exp2f(p1[r]);
    float ps = 0;
#pragma unroll
    for (int r = 0; r < 16; ++r) ps += p0[r];
#pragma unroll
    for (int r = 0; r < 16; ++r) ps += p1[r];
    { auto rr = __builtin_amdgcn_permlane32_swap(__float_as_uint(ps), __float_as_uint(ps), false, false);
      ps = __uint_as_float(rr[0]) + __uint_as_float(rr[1]); }
    l_reg = l_reg * alpha + ps;
#define PK4(P, B_, OUT) do { unsigned a0 = cvtpk(P[B_+0], P[B_+1]), a1 = cvtpk(P[B_+2], P[B_+3]);                          \
        unsigned b0 = cvtpk(P[B_+4], P[B_+5]), b1 = cvtpk(P[B_+6], P[B_+7]);                                             \
        auto r0 = __builtin_amdgcn_permlane32_swap(a0, b0, false, false); auto r1 = __builtin_amdgcn_permlane32_swap(a1, b1, false, false); \
        u32x4 w = {r0[0], r1[0], r0[1], r1[1]}; OUT = *reinterpret_cast<bf16x8*>(&w); } while (0)
    PK4(p0, 0, pa0); PK4(p0, 8, pa1); PK4(p1, 0, pa2); PK4(p1, 8, pa3);
#undef PK4
}
template <int KB>
__device__ __forceinline__ void qkt(f32x16& p0, f32x16& p1, const char* K_lds, int r32, int hi, const bf16x8* qr) {
    p0 = f32x16{}; p1 = f32x16{};
    const char* kb[4];
#pragma unroll
    for (int dd = 0; dd < 4; ++dd) kb[dd] = K_lds + KB * SHM_K + KSWZ(r32, (dd * 16 + hi * 8) * 2);
#pragma unroll
    for (int d0 = 0; d0 < 12; ++d0) { const char* a = kb[d0 & 3] + (d0 >> 2) * 128;
        bf16x8 b0 = *reinterpret_cast<const bf16x8*>(a);
        bf16x8 b1 = *reinterpret_cast<const bf16x8*>(a + 32 * KROW);
        p0 = __builtin_amdgcn_mfma_f32_32x32x16_bf16(b0, qr[d0], p0, 0, 0, 0);
        p1 = __builtin_amdgcn_mfma_f32_32x32x16_bf16(b1, qr[d0], p1, 0, 0, 0); }
}
template <int VB>
__device__ __forceinline__ void pv_tile(f32x16* o, int vb0, bf16x8 pa0, bf16x8 pa1, bf16x8 pa2, bf16x8 pa3) {
#define TRRD(dst, off) asm volatile("ds_read_b64_tr_b16 %0, %1 offset:%2" : "=&v"(dst) : "v"(vb0), "i"(off) : "memory")
#define PV_D0(d0) do { s16x4 l0, l1, l2, l3, h0, h1, h2, h3; constexpr int b_ = VB * SHM_V + v_rd_off(d0, 0, 0); \
        TRRD(l0, b_); TRRD(h0, b_ + 2048); TRRD(l1, b_ + 4096); TRRD(h1, b_ + 6144); TRRD(l2, b_ + 8192); TRRD(h2, b_ + 10240); TRRD(l3, b_ + 12288); TRRD(h3, b_ + 14336); \
        asm volatile("s_waitcnt lgkmcnt(0)" ::: "memory"); SBAR();   \
        o[d0] = __builtin_amdgcn_mfma_f32_32x32x16_bf16(pa0, (bf16x8){l0[0], l0[1], l0[2], l0[3], h0[0], h0[1], h0[2], h0[3]}, o[d0], 0, 0, 0);   \
        o[d0] = __builtin_amdgcn_mfma_f32_32x32x16_bf16(pa1, (bf16x8){l1[0], l1[1], l1[2], l1[3], h1[0], h1[1], h1[2], h1[3]}, o[d0], 0, 0, 0);   \
        o[d0] = __builtin_amdgcn_mfma_f32_32x32x16_bf16(pa2, (bf16x8){l2[0], l2[1], l2[2], l2[3], h2[0], h2[1], h2[2], h2[3]}, o[d0], 0, 0, 0);   \
        o[d0] = __builtin_amdgcn_mfma_f32_32x32x16_bf16(pa3, (bf16x8){l3[0], l3[1], l3[2], l3[3], h3[0], h3[1], h3[2], h3[3]}, o[d0], 0, 0, 0); } while (0)
    PV_D0(0); PV_D0(1); PV_D0(2); PV_D0(3);
#undef PV_D0
#undef TRRD
}
struct Ref { const bf16_t* Q; const bf16_t* K; const bf16_t* V; bf16_t* O; float* ml; int P0, j_lo, j_hi; };
#define VMW() asm volatile("s_waitcnt vmcnt(0)" ::: "memory")
#define LD8(p) (*reinterpret_cast<const bf16x8*>(p))
#define STG_IDX() int tl_ = tid; asm volatile("" : "+v"(tl_)); const int sr = tl_ >> 4, sc = (tl_ & 15) * 8; \
        const int kr0 = tl_ / 24, kc0 = (tl_ % 24) * 8, kr1 = (tl_ + 512) / 24, kc1 = ((tl_ + 512) % 24) * 8, kr2 = (tl_ + 1024) / 24, kc2 = ((tl_ + 1024) % 24) * 8
#define SLOAD_H(k0) do { STG_IDX(); st_v0 = LD8(Vh + (size_t)((k0) + sr) * LDV + sc); st_v1 = LD8(Vh + (size_t)((k0) + 32 + sr) * LDV + sc); \
        st_k0 = LD8(Kh + (size_t)((k0) + kr0) * LDK + kc0); st_k1 = LD8(Kh + (size_t)((k0) + kr1) * LDK + kc1); st_k2 = LD8(Kh + (size_t)((k0) + kr2) * LDK + kc2); } while (0)
#define SWRITE_H(bf) do { STG_IDX(); *(bf16x8*)(V_lds + (bf) * SHM_V + v_st(sr, sc)) = st_v0; *(bf16x8*)(V_lds + (bf) * SHM_V + v_st(32 + sr, sc)) = st_v1; \
        *(bf16x8*)(K_lds + (bf) * SHM_K + KSWZ(kr0, kc0 * 2)) = st_k0; *(bf16x8*)(K_lds + (bf) * SHM_K + KSWZ(kr1, kc1 * 2)) = st_k1; *(bf16x8*)(K_lds + (bf) * SHM_K + KSWZ(kr2, kc2 * 2)) = st_k2; } while (0)
__device__ __forceinline__ void unit(const Ref& cur, char* lds, int wid, int lane) {
    const int tid = wid * 64 + lane, r32 = lane & 31, hi = lane >> 5;
    const int j_lo = cur.j_lo, NT = cur.j_hi - cur.j_lo;
    const int qlo = cur.P0 + wid * QBLK, qm = qlo + r32 - 4 * hi;
    char* V_lds = lds; char* K_lds = lds + 2 * SHM_V;
    float* ws = (float*)(lds + 2 * SHM_V + 2 * SHM_K) + wid * 64; float* li_l = ws, * al_l = ws + 32;
    const int vb0 = (int)(uintptr_t)V_lds + v_rd_base(lane);
    const bf16_t* Kh = cur.K; const bf16_t* Vh = cur.V;
    bf16x8 qr[12], st_v0, st_v1, st_k0, st_k1, st_k2;
#pragma unroll
    for (int d0 = 0; d0 < 12; ++d0) qr[d0] = LD8(cur.Q + (size_t)(wid * QBLK + r32) * LDQ + d0 * 16 + hi * 8);
    SLOAD_H(j_lo * KVBLK); VMW(); SWRITE_H(0);
    __syncthreads();
    float m_reg = -1e30f, l_reg = 0; f32x16 o[4] = {};
    for (int t = 0; t < NT; ++t) {
        const int bf = t & 1, kb_ = (j_lo + t) * KVBLK;
        if (t + 1 < NT) SLOAD_H(kb_ + KVBLK);
        SBAR();
        f32x16 p0 = f32x16{}, p1 = f32x16{};
        { const char* kbase = K_lds + bf * SHM_K; const char* kb[4];
#pragma unroll
          for (int dd = 0; dd < 4; ++dd) kb[dd] = kbase + KSWZ(r32, (dd * 16 + hi * 8) * 2);
#pragma unroll
          for (int d0 = 0; d0 < 12; ++d0) { const char* a = kb[d0 & 3] + (d0 >> 2) * 128;
              const bf16x8 b0 = *reinterpret_cast<const bf16x8*>(a); const bf16x8 b1 = *reinterpret_cast<const bf16x8*>(a + 32 * KROW);
              p0 = __builtin_amdgcn_mfma_f32_32x32x16_bf16(b0, qr[d0], p0, 0, 0, 0);
              p1 = __builtin_amdgcn_mfma_f32_32x32x16_bf16(b1, qr[d0], p1, 0, 0, 0); } }
        if (kb_ + KVBLK - 1 > qlo) mask_tile(p0, p1, qm - kb_);
        float mn, alpha; bf16x8 pa0, pa1, pa2, pa3;
        partialSM(p0, p1, m_reg, mn, alpha);
        finishSM(p0, p1, alpha, l_reg, pa0, pa1, pa2, pa3);
        if (__any(alpha < 1.f)) { if (hi == 0) al_l[r32] = alpha; asm volatile("s_waitcnt lgkmcnt(0)" ::: "memory");
#pragma unroll
            for (int d_ = 0; d_ < 4; ++d_)
#pragma unroll
                for (int r = 0; r < 16; ++r) o[d_][r] *= al_l[crow(r, hi)]; }
        SBAR();
        pv_tile<0>(o, vb0 + bf * SHM_V, pa0, pa1, pa2, pa3);
        if (t + 1 < NT) { VMW(); SWRITE_H(bf ^ 1); }
        __syncthreads();
    }
    if (hi == 0) li_l[r32] = l_reg; asm volatile("s_waitcnt lgkmcnt(0)" ::: "memory");
    float rli[16];
#pragma unroll
    for (int r = 0; r < 16; ++r) { const float lv = li_l[crow(r, hi)]; rli[r] = lv > 0.f ? __builtin_amdgcn_rcpf(lv) : 0.f; }
    bf16_t* Ow = cur.O + (size_t)(wid * QBLK) * LDO;
#pragma unroll
    for (int r = 0; r < 16; ++r) { const int orow = crow(r, hi);
#pragma unroll
        for (int d0 = 0; d0 < 4; ++d0) { const float v = o[d0][r] * rli[r]; const float vn = __shfl_xor(v, 1);
            if ((r32 & 1) == 0) *(unsigned*)(Ow + (size_t)orow * LDO + d0 * 32 + r32) = cvtpk(v, vn); } }
    if (hi == 0) { float* mp = cur.ml + (size_t)(wid * QBLK + r32) * 16; mp[0] = m_reg; mp[1] = l_reg; }
    __syncthreads();
}
#undef VMW
#undef LD8
#undef SLOAD_H
#undef SWRITE_H
#undef STG_IDX
#undef KSWZ
#undef SBAR
}
__device__ __forceinline__ att::Ref attn_ref(const Params& P, int h, int qb, int sp) {
    att::Ref r; const int q0 = qb * 256;
    r.Q = WSP(bf16_t, WS_QB) + (size_t)q0 * 1536 + h * 192; r.K = WSP(bf16_t, WS_KB) + h * 192; r.V = WSP(bf16_t, WS_VB) + h * 128;
    r.O = WSP(bf16_t, WS_OPART) + (size_t)sp * S_ * 1024 + (size_t)q0 * 1024 + h * 128; r.ml = WSP(float, WS_ML) + (size_t)sp * S_ * 16 + ((size_t)q0 * 8 + h) * 2;
    r.P0 = q0; r.j_lo = sp ? 2 * (qb + 1) : 0; r.j_hi = sp ? 4 * (qb + 1) : 2 * (qb + 1); return r;
}
__device__ __forceinline__ void attn_run(const Params& P, int wg, int nwg, int wv, char* lds) {
    const int lane = lane_id_();
    for (int pi = wg; pi < 256; pi += nwg) {
        const int h = pi & 7, j = pi >> 3;
        for (int k = 0; k < 2; ++k) { const att::Ref u = attn_ref(P, h, k ? 31 - j : j, k); att::unit(u, lds, wv, lane); }
    }
}

namespace hg {
typedef short bf16x8 __attribute__((ext_vector_type(8)));
constexpr int RS64 = 144, RS128 = 272;
__device__ __forceinline__ void prep_f(const bf16_t* pr, int col, float lbk, float (&cs)[16], float (&kk)[16]) {
    float run = 0.f;
#pragma unroll
    for (int j = 0; j < 16; ++j) { const float hf = bf2f(pr[(size_t)j * DINP + col]); const float f = lbk + (1.f - lbk) * sigmoidf_(hf); kk[j] = 1.f - f; run += __logf(f); cs[j] = run; }
}
__device__ __forceinline__ void store_iT(const bf16_t* pr, int col, LAS unsigned char* iT, int k, int seg) {
    unsigned w[8];
#pragma unroll
    for (int j = 0; j < 8; ++j) w[j] = (unsigned)pr[(size_t)(2 * j) * DINP + col] | ((unsigned)pr[(size_t)(2 * j + 1) * DINP + col] << 16);
    *(LAS u32x4*)(iT + k * RS64 + seg * 32) = (u32x4){w[0], w[1], w[2], w[3]}; *(LAS u32x4*)(iT + k * RS64 + seg * 32 + 16) = (u32x4){w[4], w[5], w[6], w[7]};
}
__device__ __forceinline__ void h1_unit(const Params& P, int c, int h, LAS unsigned char* lds, int wv, int lane) {
    const int tid = wv * 64 + lane, k = tid & 127, seg = tid >> 7, fr = lane & 15, fq = lane >> 4;
    LAS unsigned char* kbT = lds; LAS unsigned char* iT = lds + 18432; LAS float* segtot = (LAS float*)(lds + 36864);
    const bf16_t* pr = WSP(bf16_t, WS_PROJ) + (size_t)(c * 64 + seg * 16) * DINP;
    float cs[16], kk[16];
    prep_f(pr, PC_HF + h * 128 + k, WSP(float, WS_LB)[h * 128 + k], cs, kk);
    segtot[seg * 128 + k] = cs[15];
    store_iT(pr, PC_HI + h * 128 + k, iT, k, seg);
    __syncthreads();
    float off = 0.f, tot = 0.f;
#pragma unroll
    for (int s2 = 0; s2 < 4; ++s2) { const float v = segtot[s2 * 128 + k]; tot += v; off += (s2 < seg) ? v : 0.f; }
    unsigned w[8];
#pragma unroll
    for (int j = 0; j < 8; ++j) w[j] = pk2(kk[2 * j] * __expf(tot - (off + cs[2 * j])), kk[2 * j + 1] * __expf(tot - (off + cs[2 * j + 1])));
    *(LAS u32x4*)(kbT + k * RS64 + seg * 32) = (u32x4){w[0], w[1], w[2], w[3]}; *(LAS u32x4*)(kbT + k * RS64 + seg * 32 + 16) = (u32x4){w[4], w[5], w[6], w[7]};
    if (seg == 0) WSP(float, WS_DVEC)[(c * 8 + h) * 128 + k] = __expf(tot);
    __syncthreads();
    f32x4 acc[8];
#pragma unroll
    for (int nt = 0; nt < 8; ++nt) acc[nt] = (f32x4){0.f, 0.f, 0.f, 0.f};
#pragma unroll
    for (int ks = 0; ks < 2; ++ks) { const bf16x8 a = *(const LAS bf16x8*)(kbT + (16 * wv + fr) * RS64 + ks * 64 + fq * 16);
#pragma unroll
        for (int nt = 0; nt < 8; ++nt) { const bf16x8 b = *(const LAS bf16x8*)(iT + (16 * nt + fr) * RS64 + ks * 64 + fq * 16);
            acc[nt] = __builtin_amdgcn_mfma_f32_16x16x32_bf16(a, b, acc[nt], 0, 0, 0); } }
    bf16_t* Lst = WSP(bf16_t, WS_LST) + (size_t)(c * 8 + h) * 16384;
#pragma unroll
    for (int nt = 0; nt < 8; ++nt) st_bf4(Lst + (16 * nt + fr) * 128 + 16 * wv + 4 * fq, acc[nt]);
    __syncthreads();
}
__device__ __forceinline__ void scan_run(const Params& P, int wg, int nwg, int wv) {
    const bf16_t* Lst = WSP(bf16_t, WS_LST); bf16_t* Sst = WSP(bf16_t, WS_SST); const float* dvec = WSP(float, WS_DVEC);
    for (int e = wg * 512 + wv * 64 + lane_id_(); e < 8 * 16384; e += nwg * 512) {
        const int h = e >> 14, k = e & 127; float S = 0.f;
#pragma unroll 8
        for (int c = 0; c < 128; ++c) { const float L = bf2f(Lst[(size_t)c * 131072 + e]); const float d = dvec[(c * 8 + h) * 128 + k];
            Sst[(size_t)c * 131072 + e] = (bf16_t)f2bf(S); S = d * S + L; }
    }
}
__device__ __forceinline__ void h3_unit(const Params& P, int c, int h, LAS unsigned char* lds, int wv, int lane) {
    const int tid = wv * 64 + lane, k = tid & 127, seg = tid >> 7, fr = lane & 15, fq = lane >> 4;
    LAS unsigned char* qbL = lds; LAS unsigned char* kiL = lds + 17408; LAS unsigned char* iT = lds + 34816; LAS unsigned char* Am = lds + 53248;
    LAS float* segtot = (LAS float*)(lds + 62464); LAS float* rowss = (LAS float*)(lds + 64512);
    const bf16_t* pr = WSP(bf16_t, WS_PROJ) + (size_t)(c * 64 + seg * 16) * DINP;
    float cs[16], kk[16];
    prep_f(pr, PC_HF + h * 128 + k, WSP(float, WS_LB)[h * 128 + k], cs, kk);
    segtot[seg * 128 + k] = cs[15];
    store_iT(pr, PC_HI + h * 128 + k, iT, k, seg);
    __syncthreads();
    float off = 0.f;
#pragma unroll
    for (int s2 = 0; s2 < 4; ++s2) { const float v = segtot[s2 * 128 + k]; off += (s2 < seg) ? v : 0.f; }
#pragma unroll
    for (int j = 0; j < 16; ++j) { const float b = off + cs[j]; const float q = siluf_(bf2f(pr[(size_t)j * DINP + PC_HQ + h * 128 + k]));
        *(LAS bf16_t*)(qbL + (seg * 16 + j) * RS128 + k * 2) = (bf16_t)f2bf(q * __expf(b));
        *(LAS bf16_t*)(kiL + (seg * 16 + j) * RS128 + k * 2) = (bf16_t)f2bf(kk[j] * __expf(fminf(-b, 80.f))); }
    __syncthreads();
    { const int mt = wv >> 1;
#pragma unroll
      for (int q = 0; q < 2; ++q) { const int nt = (wv & 1) * 2 + q; f32x4 acc = {0.f, 0.f, 0.f, 0.f};
          if (nt <= mt) {
#pragma unroll
              for (int ks = 0; ks < 4; ++ks) { const bf16x8 a = *(const LAS bf16x8*)(qbL + (16 * mt + fr) * RS128 + ks * 64 + fq * 16);
                  const bf16x8 b = *(const LAS bf16x8*)(kiL + (16 * nt + fr) * RS128 + ks * 64 + fq * 16);
                  acc = __builtin_amdgcn_mfma_f32_16x16x32_bf16(a, b, acc, 0, 0, 0); } }
          const int s_ = 16 * nt + fr;
#pragma unroll
          for (int r = 0; r < 4; ++r) { const int t_ = 16 * mt + 4 * fq + r; *(LAS bf16_t*)(Am + t_ * RS64 + s_ * 2) = (bf16_t)f2bf(s_ <= t_ ? acc[r] : 0.f); } } }
    __syncthreads();
    const int mt = wv & 3, ntb = (wv >> 2) * 4;
    f32x4 acc[4];
#pragma unroll
    for (int q = 0; q < 4; ++q) acc[q] = (f32x4){0.f, 0.f, 0.f, 0.f};
#pragma unroll
    for (int ks = 0; ks < 2; ++ks) { const bf16x8 a = *(const LAS bf16x8*)(Am + (16 * mt + fr) * RS64 + ks * 64 + fq * 16);
#pragma unroll
        for (int q = 0; q < 4; ++q) { const bf16x8 b = *(const LAS bf16x8*)(iT + (16 * (ntb + q) + fr) * RS64 + ks * 64 + fq * 16);
            acc[q] = __builtin_amdgcn_mfma_f32_16x16x32_bf16(a, b, acc[q], 0, 0, 0); } }
    const bf16_t* Sst = WSP(bf16_t, WS_SST) + (size_t)(c * 8 + h) * 16384;
#pragma unroll
    for (int ks = 0; ks < 4; ++ks) { const bf16x8 a = *(const LAS bf16x8*)(qbL + (16 * mt + fr) * RS128 + ks * 64 + fq * 16);
#pragma unroll
        for (int q = 0; q < 4; ++q) { const bf16x8 b = *(const bf16x8*)(Sst + (16 * (ntb + q) + fr) * 128 + ks * 32 + fq * 8);
            acc[q] = __builtin_amdgcn_mfma_f32_16x16x32_bf16(a, b, acc[q], 0, 0, 0); } }
    float ss[4];
#pragma unroll
    for (int r = 0; r < 4; ++r) { float v = 0.f;
#pragma unroll
        for (int q = 0; q < 4; ++q) v += acc[q][r] * acc[q][r];
        v += __shfl_xor(v, 1); v += __shfl_xor(v, 2); v += __shfl_xor(v, 4); v += __shfl_xor(v, 8); ss[r] = v; }
    if (fr == 0) {
#pragma unroll
        for (int r = 0; r < 4; ++r) rowss[(wv >> 2) * 64 + 16 * mt + 4 * fq + r] = ss[r]; }
    __syncthreads();
    bf16_t* ymix = WSP(bf16_t, WS_YMIX); const bf16_t* prow = WSP(bf16_t, WS_PROJ);
#pragma unroll
    for (int r = 0; r < 4; ++r) { const int t_ = 16 * mt + 4 * fq + r; const float rs = 1.f / sqrtf((rowss[t_] + rowss[64 + t_]) * (1.f / 128.f) + EPS);
        const size_t row = (size_t)(c * 64 + t_);
#pragma unroll
        for (int q = 0; q < 4; ++q) { const int v_ = 16 * (ntb + q) + fr; const float g = bf2f(prow[row * DINP + PC_HG + h * 128 + v_]);
            ymix[row * D_ + 1024 + h * 128 + v_] = (bf16_t)f2bf(acc[q][r] * rs * siluf_(g)); } }
    __syncthreads();
}
__device__ __forceinline__ void h1_run(const Params& P, int wg, int nwg, int wv, LAS unsigned char* lds) { const int lane = lane_id_(); for (int u = wg; u < 1024; u += nwg) h1_unit(P, u >> 3, u & 7, lds, wv, lane); }
__device__ __forceinline__ void h3_run(const Params& P, int wg, int nwg, int wv, LAS unsigned char* lds) { const int lane = lane_id_(); for (int u = wg; u < 1024; u += nwg) h3_unit(P, u >> 3, u & 7, lds, wv, lane); }
}

constexpr int LDS_TAB = 131072;
__device__ __forceinline__ int moe_build_tab(const int* cnt, LAS unsigned char* lds, int wv) {
    LAS int* tab = (LAS int*)(lds + LDS_TAB);
    if (wv == 0 && lane_id_() == 0) { int nt = 0;
        for (int e = 0; e < NE; ++e) { const int n = cnt[e]; for (int r = 0; r * 256 < n; ++r) { tab[1 + nt] = e; tab[129 + nt] = r; ++nt; } }
        tab[0] = nt; }
    __syncthreads();
    return __builtin_amdgcn_readfirstlane(tab[0]);
}
struct MoeOrder {
    const int* cnt; const int* list; LAS const int* tab; int ntiles, npn, G, c; const char* A; const char* B; size_t bexp, btile, atile; bool gather;
    __device__ __forceinline__ bool next(int i, pg8::Unit& u) const {
        const int L = i * G + c; if (L >= ntiles * npn) return false;
        const int tile = L / npn, pn = L - tile * npn;
        const int e = __builtin_amdgcn_readfirstlane(tab[1 + tile]), rt = __builtin_amdgcn_readfirstlane(tab[129 + tile]);
        u.pm = tile; u.pn = pn; u.x0 = e; u.x1 = rt * 256; u.x2 = __builtin_amdgcn_readfirstlane(cnt[e]);
        u.b = B + (size_t)e * bexp + (size_t)pn * btile; u.a = gather ? A : A + (size_t)tile * atile; return true;
    }
    __device__ __forceinline__ unsigned row_off(const pg8::Unit& u, int R) const { int idx = u.x1 + R; idx = idx < u.x2 ? idx : 0; return (unsigned)(list[u.x0 * LISTCAP + idx] >> 1) * (unsigned)(D_ * 2); }
};
struct MoeUpEpi { const int* list; const float* rstd1; bf16_t* hmid;
    __device__ __forceinline__ void operator()(const f32x4 (&acc)[2][2][4][2], const pg8::Unit& u, int wr, int wc, int fr, int fq) const {
#pragma unroll
        for (int ai = 0; ai < 2; ++ai)
#pragma unroll
            for (int m = 0; m < 4; ++m) { const int r = ai * 128 + wr * 64 + m * 16 + fr; int idx = u.x1 + r; idx = idx < u.x2 ? idx : 0;
                const float rs = rstd1[list[u.x0 * LISTCAP + idx] >> 1];
#pragma unroll
                for (int n = 0; n < 2; ++n) { const f32x4 g = acc[ai][0][m][n] * rs, up = acc[ai][1][m][n] * rs;
                    const f32x4 h = {siluf_(g.x) * up.x, siluf_(g.y) * up.y, siluf_(g.z) * up.z, siluf_(g.w) * up.w};
                    st_bf4(hmid + (size_t)(u.pm * 256 + r) * DE + u.pn * 128 + wc * 32 + n * 16 + fq * 4, h); }
                asm volatile("" ::: "memory"); }
    } };
struct MoeDownEpi { const int* list; const float* ew; bf16_t* y;
    __device__ __forceinline__ void operator()(const f32x4 (&acc)[2][2][4][2], const pg8::Unit& u, int wr, int wc, int fr, int fq) const {
#pragma unroll
        for (int ai = 0; ai < 2; ++ai)
#pragma unroll
            for (int m = 0; m < 4; ++m) { const int r = ai * 128 + wr * 64 + m * 16 + fr; const int idx = u.x1 + r; const bool valid = idx < u.x2;
                const int a = list[u.x0 * LISTCAP + (valid ? idx : 0)]; const float w = ew[a];
                if (valid) {
#pragma unroll
                    for (int bj = 0; bj < 2; ++bj)
#pragma unroll
                        for (int n = 0; n < 2; ++n) st_bf4(y + (size_t)a * D_ + u.pn * 256 + bj * 128 + wc * 32 + n * 16 + fq * 4, acc[ai][bj][m][n] * w); }
                asm volatile("" ::: "memory"); }
    } };
__device__ __forceinline__ void moe_up_run(const Params& P, int wg, int nwg, int wv, LAS unsigned char* lds) {
    const int nt = moe_build_tab(WSP(int, WS_CTL), lds, wv);
    MoeOrder S{WSP(int, WS_CTL), WSP(int, WS_LIST), (LAS const int*)(lds + LDS_TAB), nt, 4, nwg, wg, (const char*)WSP(bf16_t, WS_H1B), (const char*)WSP(bf16_t, WS_WGU), (size_t)1024 * 2048 * 2, (size_t)256 * 2048 * 2, 0, true};
    MoeUpEpi E{WSP(int, WS_LIST), WSP(float, WS_RSTD1), WSP(bf16_t, WS_HMID)};
    int K = D_, lda = D_; asm volatile("" : "+s"(K), "+s"(lda));
    pg8::gemm_phase<MoeUpEpi, MoeOrder, true>(lds, K, lda, S, E, wv);
}
__device__ __forceinline__ void moe_down_run(const Params& P, int wg, int nwg, int wv, LAS unsigned char* lds) {
    const int nt = moe_build_tab(WSP(int, WS_CTL), lds, wv);
    MoeOrder S{WSP(int, WS_CTL), WSP(int, WS_LIST), (LAS const int*)(lds + LDS_TAB), nt, 8, nwg, wg, (const char*)WSP(bf16_t, WS_HMID), (const char*)WSP(bf16_t, WS_WD), (size_t)2048 * DE * 2, (size_t)256 * DE * 2, (size_t)256 * DE * 2, false};
    MoeDownEpi E{WSP(int, WS_LIST), WSP(float, WS_EW), WSP(bf16_t, WS_Y)};
    int K = DE, lda = DE; asm volatile("" : "+s"(K), "+s"(lda));
    pg8::gemm_phase<MoeDownEpi, MoeOrder, false>(lds, K, lda, S, E, wv);
}

namespace cg = cooperative_groups;
constexpr int LDS_BYTES = 147456;
constexpr int NPHASE = 12;
#ifndef MK_MULTI
#define MK_MULTI 0
#endif
__global__ void __launch_bounds__(512, 2) mk_fwd(Params P, int ph_lo, int ph_hi) {
    extern __shared__ __attribute__((aligned(16))) unsigned char lds_raw[];
    LAS unsigned char* lds = (LAS unsigned char*)lds_raw;
    const int wg = blockIdx.x, nwg = gridDim.x, wv = __builtin_amdgcn_readfirstlane(threadIdx_x_raw() >> 6);
#define PH(k) if (ph_lo <= (k) && (k) < ph_hi)
#define SEAM(k) do { if ((k) + 1 < ph_hi) cg::this_grid().sync(); } while (0)
    PH(0) { p0_run(P, wg, nwg, wv, lds); SEAM(0); }
    PH(1) { dense_gemm(lds, WSP(bf16_t, WS_XB), D_, WSP(bf16_t, WS_WIN), S_, DINP, D_, PFProj{WSP(bf16_t, WS_PROJ), WSP(float, WS_RSTDX), WSP(float, WS_PARTQ)}, wg, nwg, wv);
            dense_gemm(lds, WSP(bf16_t, WS_PB), PLE, WSP(bf16_t, WS_WPP), S_, D_, PLE, PFPP{WSP(bf16_t, WS_PP)}, wg, nwg, wv); SEAM(1); }
    PH(2) { dense_gemm(lds, WSP(bf16_t, WS_PROJ) + PC_CQ, DINP, WSP(bf16_t, WS_WUQ), S_, 1536, 512, PFQ{WSP(bf16_t, WS_QB), WSP(float, WS_PARTQ), WSP(float, WS_COS), WSP(float, WS_SIN)}, wg, nwg, wv);
            dense_gemm(lds, WSP(bf16_t, WS_PROJ) + PC_CKV, DINP, WSP(bf16_t, WS_WUKV), S_, 2048, 256, PFKV{WSP(bf16_t, WS_KB), WSP(bf16_t, WS_VB), WSP(float, WS_PARTQ)}, wg, nwg, wv);
            kpe_run(P, wg, nwg, wv); hg::h1_run(P, wg, nwg, wv, lds); SEAM(2); }
    PH(3) { hg::scan_run(P, wg, nwg, wv); attn_run(P, wg, nwg, wv, (char*)lds_raw); SEAM(3); }
    PH(4) { combine_run(P, wg, nwg, wv); hg::h3_run(P, wg, nwg, wv, lds); SEAM(4); }
    PH(5) { dense_gemm(lds, WSP(bf16_t, WS_YMIX), D_, WSP(bf16_t, WS_WOUT), S_, D_, D_, PFOut{P.x, P.out, WSP(bf16_t, WS_H1B), WSP(float, WS_PART1)}, wg, nwg, wv); SEAM(5); }
    PH(6) { route_run(P, wg, nwg, wv, lds); SEAM(6); }
    PH(7) { moe_up_run(P, wg, nwg, wv, lds); SEAM(7); }
    PH(8) { moe_down_run(P, wg, nwg, wv, lds); SEAM(8); }
    PH(9) { moe_combine_run(P, wg, nwg, wv); SEAM(9); }
    PH(10) { dense_gemm(lds, WSP(bf16_t, WS_H2B), D_, WSP(bf16_t, WS_WPG), S_, D_, D_, PFPle{P.out, WSP(bf16_t, WS_PP), WSP(float, WS_RSTD2), P.b_pg, WSP(float, WS_PART3)}, wg, nwg, wv); SEAM(10); }
    PH(11) { final_run(P, wg, nwg, wv); }
#undef PH
#undef SEAM
}

extern "C" void kernel_launch(void* const* d_in, const int* in_sizes, int n_in, void* d_out, int out_size, void* d_ws, size_t ws_size, hipStream_t stream) {
    if (n_in != 26 || ws_size < WS_END) { fprintf(stderr, "kernel_launch: unexpected n_in %d or ws_size %zu (< %zu)\n", n_in, ws_size, (size_t)WS_END); return; }
    static int grid = 0;
    if (grid == 0) {
        int dev = 0, cus = 0, per_cu = 0;
        (void)hipGetDevice(&dev); (void)hipDeviceGetAttribute(&cus, hipDeviceAttributeMultiprocessorCount, dev);
        (void)hipFuncSetAttribute((const void*)mk_fwd, hipFuncAttributeMaxDynamicSharedMemorySize, LDS_BYTES);
        if (hipOccupancyMaxActiveBlocksPerMultiprocessor(&per_cu, (const void*)mk_fwd, 512, LDS_BYTES) != hipSuccess || per_cu < 1) { fprintf(stderr, "kernel_launch: occupancy query says %d blocks/CU\n", per_cu); per_cu = 1; }
        (void)hipGetLastError();
        grid = cus > 0 ? cus : 256;
    }
    Params P{};
    P.x = (const float*)d_in[0]; P.p = (const float*)d_in[1]; P.pos = (const int*)d_in[2];
    P.attn_norm = (const float*)d_in[3]; P.w_in = (const float*)d_in[4]; P.q_norm = (const float*)d_in[5]; P.w_uq = (const float*)d_in[6];
    P.kv_norm = (const float*)d_in[7]; P.w_ukv = (const float*)d_in[8]; P.mla_norm = (const float*)d_in[9]; P.lb_logits = (const float*)d_in[10];
    P.hg_norm = (const float*)d_in[11]; P.w_out = (const float*)d_in[12]; P.ffn_norm = (const float*)d_in[13];
    P.w_rg = (const float*)d_in[14]; P.b_rg = (const float*)d_in[15]; P.w_re = (const float*)d_in[16]; P.b_re = (const float*)d_in[17];
    P.w_eg = (const float*)d_in[18]; P.w_eu = (const float*)d_in[19]; P.w_ed = (const float*)d_in[20];
    P.ple_norm = (const float*)d_in[21]; P.w_pg = (const float*)d_in[22]; P.b_pg = (const float*)d_in[23]; P.w_pp = (const float*)d_in[24]; P.final_norm = (const float*)d_in[25];
    P.out = (float*)d_out; P.ws = (unsigned char*)d_ws;
    (void)hipMemsetAsync((char*)d_ws + WS_CTL, 0, 1 * MiB, stream);
#if MK_MULTI
    for (int ph = 0; ph < NPHASE; ++ph) hipLaunchKernelGGL(mk_fwd, dim3(grid), dim3(512), LDS_BYTES, stream, P, ph, ph + 1);
#else
    int lo = 0, hi = NPHASE; void* args[] = {&P, &lo, &hi};
    hipError_t e = hipLaunchCooperativeKernel((const void*)mk_fwd, dim3(grid), dim3(512), args, LDS_BYTES, stream);
    if (e != hipSuccess) fprintf(stderr, "kernel_launch: cooperative launch failed: %s (grid %d)\n", hipGetErrorString(e), grid);
#endif
}
```

```cpp
#include <hip/hip_runtime.h>
#include <hip/hip_cooperative_groups.h>
#include <cstdint>
#include <cstdio>

#define LAS __attribute__((address_space(3)))
typedef unsigned short bf16_t;
typedef float f32x4 __attribute__((ext_vector_type(4)));
typedef unsigned u32x4 __attribute__((ext_vector_type(4)));
typedef unsigned u32x2 __attribute__((ext_vector_type(2)));

constexpr int S_ = 8192, D_ = 2048, DIN = 4928, DINP = 5120;
constexpr int NH = 8, QKD = 192, VD = 128;
constexpr int NE = 64, DE = 512, PLE = 256;
constexpr float EPS = 1e-6f;
constexpr float QSCALE = 0.07216878364870323f * 1.4426950408889634f;
constexpr int PC_CQ = 0, PC_CKV = 512, PC_HQ = 768, PC_HF = 1792, PC_HI = 2816, PC_HG = 3840, PC_KPE = 4864;
constexpr int LISTCAP = 8192;

constexpr size_t MiB = 1u << 20;
constexpr size_t WS_CTL = 0;
constexpr size_t WS_RSTDX = 1 * MiB, WS_RSTD1 = WS_RSTDX + 32768, WS_RSTD2 = WS_RSTD1 + 32768, WS_LB = WS_RSTD2 + 32768, WS_TILEB = WS_LB + 4096;
constexpr size_t WS_COS = 2 * MiB, WS_SIN = 3 * MiB, WS_PARTQ = 4 * MiB, WS_PART1 = 5 * MiB, WS_PART3 = 6 * MiB, WS_WR = 7 * MiB;
constexpr size_t WS_ML = 8 * MiB, WS_DVEC = 9 * MiB, WS_EID = 10 * MiB, WS_EW = WS_EID + 65536, WS_LIST = 11 * MiB;
constexpr size_t WS_WUQ = 16 * MiB, WS_WUKV = 18 * MiB, WS_WPP = 19 * MiB, WS_WIN = 20 * MiB, WS_WOUT = 40 * MiB, WS_WPG = 48 * MiB;
constexpr size_t WS_PB = 56 * MiB, WS_XB = 64 * MiB, WS_PROJ = 96 * MiB, WS_PP = 176 * MiB, WS_QB = 208 * MiB, WS_KB = 232 * MiB, WS_VB = 256 * MiB;
constexpr size_t WS_LST = 272 * MiB, WS_SST = 304 * MiB, WS_OPART = 336 * MiB, WS_YMIX = 368 * MiB, WS_H1B = 400 * MiB, WS_H2B = 432 * MiB;
constexpr size_t WS_HMID = 464 * MiB, WS_Y = 496 * MiB, WS_WGU = 560 * MiB, WS_WD = 816 * MiB, WS_END = 944 * MiB;

struct Params {
    const float *x, *p; const int* pos;
    const float *attn_norm, *w_in, *q_norm, *w_uq, *kv_norm, *w_ukv, *mla_norm, *lb_logits, *hg_norm, *w_out, *ffn_norm;
    const float *w_rg, *b_rg, *w_re, *b_re, *w_eg, *w_eu, *w_ed, *ple_norm, *w_pg, *b_pg, *w_pp, *final_norm;
    float* out; unsigned char* ws;
};
#define WSP(T, off) ((T*)(P.ws + (off)))

__device__ __forceinline__ unsigned f2bf(float f) { unsigned u = __builtin_bit_cast(unsigned, f); return (u + 0x7fffu + ((u >> 16) & 1u)) >> 16; }
__device__ __forceinline__ float bf2f(unsigned h) { return __builtin_bit_cast(float, h << 16); }
__device__ __forceinline__ unsigned pk2(float lo, float hi) { return f2bf(lo) | (f2bf(hi) << 16); }
__device__ __forceinline__ float wave_sum(float v) {
#pragma unroll
    for (int o = 1; o < 64; o <<= 1) v += __shfl_xor(v, o);
    return v;
}
__device__ __forceinline__ int lane_id_() { return (int)__builtin_amdgcn_mbcnt_hi(~0u, __builtin_amdgcn_mbcnt_lo(~0u, 0u)); }
__device__ __forceinline__ int threadIdx_x_raw() { return (int)__builtin_amdgcn_workitem_id_x(); }
#define TIDX (wv * 64 + lane_id_())
__device__ __forceinline__ float sigmoidf_(float x) { return 1.f / (1.f + __expf(-x)); }
__device__ __forceinline__ float siluf_(float x) { return x / (1.f + __expf(-x)); }

struct SrcWin { const float* W; const float* g;
    __device__ __forceinline__ float operator()(int k, int n) const {
        int src;
        if (n < 768) src = n;
        else if (n < 4864) src = n + 64;
        else if (n < 4928) { const int j = n - 4864; src = 768 + ((j & 1) ? 32 + (j >> 1) : (j >> 1)); }
        else return 0.f;
        return W[(size_t)k * DIN + src] * g[k];
    } };
struct SrcWuq { const float* W; const float* g;
    __device__ __forceinline__ float operator()(int k, int n) const {
        int src;
        if (n < 1024) src = (n >> 7) * 192 + (n & 127);
        else { const int r = n - 1024, h = r >> 6, j = r & 63; src = h * 192 + 128 + ((j & 1) ? 32 + (j >> 1) : (j >> 1)); }
        return W[(size_t)k * 1536 + src] * g[k];
    } };
struct SrcWukv { const float* W; const float* g;
    __device__ __forceinline__ float operator()(int k, int n) const {
        int src;
        if (n < 1024) src = (n >> 7) * 256 + (n & 127);
        else { const int r = n - 1024; src = (r >> 7) * 256 + 128 + (r & 127); }
        return W[(size_t)k * 2048 + src] * g[k];
    } };
struct SrcWout { const float* W; const float* g0; const float* g1;
    __device__ __forceinline__ float operator()(int k, int n) const { return W[(size_t)k * 2048 + n] * (k < 1024 ? g0[k] : g1[k - 1024]); } };
struct SrcPlain { const float* W; const float* g; int N;
    __device__ __forceinline__ float operator()(int k, int n) const { const float w = W[(size_t)k * N + n]; return g ? w * g[k] : w; } };
struct SrcGU { const float* W; const float* g;
    __device__ __forceinline__ float operator()(int k, int n) const { return W[(size_t)k * DE + 128 * (n >> 8) + (n & 127)] * g[k]; } };

template <class Src>
__device__ __forceinline__ void tconv_item(const Src& src, int K, int nblk, bf16_t* WT, LAS float* scr, int item, int lane) {
    const int kb = item / nblk, nb = item % nblk, k0 = 64 * kb, n0 = 32 * nb;
#pragma unroll 8
    for (int i = 0; i < 32; ++i) { const int kk = 2 * i + (lane >> 5); scr[kk * 33 + (lane & 31)] = src(k0 + kk, n0 + (lane & 31)); }
    asm volatile("s_waitcnt lgkmcnt(0)" ::: "memory");
    const int c = lane & 7;
#pragma unroll
    for (int j = 0; j < 4; ++j) { const int n = (lane >> 3) + 8 * j; const LAS float* s = scr + (8 * c) * 33 + n;
        u32x4 o; o.x = pk2(s[0 * 33], s[1 * 33]); o.y = pk2(s[2 * 33], s[3 * 33]); o.z = pk2(s[4 * 33], s[5 * 33]); o.w = pk2(s[6 * 33], s[7 * 33]);
        *(u32x4*)(WT + (size_t)(n0 + n) * K + k0 + 8 * c) = o; }
    asm volatile("s_waitcnt lgkmcnt(0)" ::: "memory");
}

__device__ __forceinline__ void p0_run(const Params& P, int wg, int nwg, int wv, LAS unsigned char* lds) {
    const int tid = TIDX, lane = tid & 63, wave = tid >> 6;
    const int gw = wg * 8 + wave, NGW = nwg * 8;
    LAS float* scr = (LAS float*)(lds + wave * 8704);
    constexpr int I_WIN = 32 * 160, I_WUQ = 8 * 48, I_WUKV = 4 * 64, I_WOUT = 32 * 64, I_WPG = 32 * 64, I_WPP = 4 * 64, I_GU = 32 * 32, I_DN = 8 * 64;
    constexpr int NITEMS = I_WIN + I_WUQ + I_WUKV + I_WOUT + I_WPG + I_WPP + NE * I_GU + NE * I_DN;
    for (int it = gw; it < NITEMS; it += NGW) {
        int r = it;
        if (r < I_WIN) { tconv_item(SrcWin{P.w_in, P.attn_norm}, 2048, 160, WSP(bf16_t, WS_WIN), scr, r, lane); continue; } r -= I_WIN;
        if (r < I_WUQ) { tconv_item(SrcWuq{P.w_uq, P.q_norm}, 512, 48, WSP(bf16_t, WS_WUQ), scr, r, lane); continue; } r -= I_WUQ;
        if (r < I_WUKV) { tconv_item(SrcWukv{P.w_ukv, P.kv_norm}, 256, 64, WSP(bf16_t, WS_WUKV), scr, r, lane); continue; } r -= I_WUKV;
        if (r < I_WOUT) { tconv_item(SrcWout{P.w_out, P.mla_norm, P.hg_norm}, 2048, 64, WSP(bf16_t, WS_WOUT), scr, r, lane); continue; } r -= I_WOUT;
        if (r < I_WPG) { tconv_item(SrcPlain{P.w_pg, P.ple_norm, 2048}, 2048, 64, WSP(bf16_t, WS_WPG), scr, r, lane); continue; } r -= I_WPG;
        if (r < I_WPP) { tconv_item(SrcPlain{P.w_pp, nullptr, 2048}, 256, 64, WSP(bf16_t, WS_WPP), scr, r, lane); continue; } r -= I_WPP;
        if (r < NE * I_GU) { const int e = r / I_GU; r -= e * I_GU;
            const bool isup = (((r % 32) * 32) & 255) >= 128;
            const float* Wsel = isup ? P.w_eu : P.w_eg;
            tconv_item(SrcGU{Wsel + (size_t)e * 2048 * DE, P.ffn_norm}, 2048, 32, WSP(bf16_t, WS_WGU) + (size_t)e * 1024 * 2048, scr, r, lane); continue; }
        r -= NE * I_GU;
        { const int e = r / I_DN; r -= e * I_DN;
          tconv_item(SrcPlain{P.w_ed + (size_t)e * DE * 2048, nullptr, 2048}, DE, 64, WSP(bf16_t, WS_WD) + (size_t)e * 2048 * DE, scr, r, lane); }
    }
    for (int m = gw; m < S_; m += NGW) {
        const f32x4* xr = (const f32x4*)(P.x + (size_t)m * D_) + lane; f32x4 v[8]; float s = 0.f;
#pragma unroll
        for (int j = 0; j < 8; ++j) { v[j] = xr[64 * j]; s += (v[j].x * v[j].x + v[j].y * v[j].y) + (v[j].z * v[j].z + v[j].w * v[j].w); }
        s = wave_sum(s);
        if (lane == 0) WSP(float, WS_RSTDX)[m] = 1.f / sqrtf(s * (1.f / D_) + EPS);
        u32x2* o = (u32x2*)(WSP(bf16_t, WS_XB) + (size_t)m * D_) + lane;
#pragma unroll
        for (int j = 0; j < 8; ++j) { u32x2 w; w.x = pk2(v[j].x, v[j].y); w.y = pk2(v[j].z, v[j].w); o[64 * j] = w; }
    }
    const int gt = wg * 512 + tid, NGT = nwg * 512;
    for (int i = gt; i < S_ * PLE / 4; i += NGT) { const f32x4 v = ((const f32x4*)P.p)[i]; u32x2 w; w.x = pk2(v.x, v.y); w.y = pk2(v.z, v.w); WSP(u32x2, WS_PB)[i] = w; }
    for (int i = gt; i < S_ * 32; i += NGT) { const int s = i >> 5, j = i & 31;
        const float invf = exp2f(-(float)j * (13.287712379549449f / 32.0f));
        const double tr = (double)P.pos[s] * (double)invf * 0.15915494309189535;
        const float fr = (float)(tr - floor(tr));
        WSP(float, WS_COS)[i] = __builtin_amdgcn_cosf(fr); WSP(float, WS_SIN)[i] = __builtin_amdgcn_sinf(fr); }
    for (int i = gt; i < 1024; i += NGT) WSP(float, WS_LB)[i] = 1.f / (1.f + expf(P.lb_logits[1024 + i] - P.lb_logits[i]));
    for (int i = gt; i < 2048 * 80; i += NGT) {
        const int s4 = i & 3, ln = (i >> 2) & 63, tl = (i >> 8) % 5, k16 = (i >> 8) / 5; const int k = 16 * k16 + 4 * (ln >> 4) + s4, c = 16 * tl + (ln & 15);
        float w = 0.f; if (c < 8) w = P.w_rg[k * 8 + c]; else if (c < 72) w = P.w_re[k * 64 + (c - 8)];
        WSP(float, WS_WR)[i] = w * P.ffn_norm[k]; }
}

struct RowId { __device__ __forceinline__ int operator()(int m) const { return m; } };
template <class F, class RowMap>
__device__ __forceinline__ void naive_gemm_item(const bf16_t* A, int lda, const bf16_t* Bt, int ldb, int K, int m0, int nrows, int n0, const F& f, const RowMap& rm, int lane) {
    const int m = m0 + lane; const bool valid = lane < nrows;
    const bf16_t* ar = A + (size_t)rm(valid ? m : m0) * lda;
    float acc[64];
#pragma unroll
    for (int c = 0; c < 64; ++c) acc[c] = 0.f;
    for (int k = 0; k < K; k += 8) {
        const u32x4 a = *(const u32x4*)(ar + k);
        float af[8];
        af[0] = bf2f(a.x & 0xffffu); af[1] = bf2f(a.x >> 16); af[2] = bf2f(a.y & 0xffffu); af[3] = bf2f(a.y >> 16);
        af[4] = bf2f(a.z & 0xffffu); af[5] = bf2f(a.z >> 16); af[6] = bf2f(a.w & 0xffffu); af[7] = bf2f(a.w >> 16);
#pragma unroll
        for (int c = 0; c < 64; ++c) {
            const u32x4 b = *(const u32x4*)(Bt + (size_t)(n0 + c) * ldb + k);
            float s = acc[c];
            s = fmaf(af[0], bf2f(b.x & 0xffffu), s); s = fmaf(af[1], bf2f(b.x >> 16), s); s = fmaf(af[2], bf2f(b.y & 0xffffu), s); s = fmaf(af[3], bf2f(b.y >> 16), s);
            s = fmaf(af[4], bf2f(b.z & 0xffffu), s); s = fmaf(af[5], bf2f(b.z >> 16), s); s = fmaf(af[6], bf2f(b.w & 0xffffu), s); s = fmaf(af[7], bf2f(b.w >> 16), s);
            acc[c] = s;
        }
    }
    if (valid) {
        float ss = 0.f;
#pragma unroll
        for (int q = 0; q < 16; ++q) { const f32x4 v = f(m, n0 + 4 * q, (f32x4){acc[4 * q], acc[4 * q + 1], acc[4 * q + 2], acc[4 * q + 3]});
            ss += (v.x * v.x + v.y * v.y) + (v.z * v.z + v.w * v.w); }
        f.partial(m, n0 >> 6, ss);
    }
}
template <class F>
__device__ __forceinline__ void naive_gemm(const bf16_t* A, int lda, const bf16_t* Bt, int ldb, int M, int N, int K, const F& f, int wg, int nwg, int wv) {
    const int lane = TIDX & 63, gw = wg * 8 + (TIDX >> 6), NGW = nwg * 8;
    const int nmt = M / 64, nnt = N / 64;
    for (int it = gw; it < nmt * nnt; it += NGW) { const int mt = it % nmt, nt = it / nmt;
        naive_gemm_item(A, lda, Bt, ldb, K, mt * 64, 64, nt * 64, f, RowId{}, lane); }
}

__device__ __forceinline__ void st_bf4(bf16_t* p, f32x4 v) { u32x2 w; w.x = pk2(v.x, v.y); w.y = pk2(v.z, v.w); *(u32x2*)p = w; }
struct FProj { bf16_t* proj; const float* rstd; float* partq;
    __device__ __forceinline__ f32x4 operator()(int m, int c, f32x4 v) const { v = v * rstd[m]; st_bf4(proj + (size_t)m * DINP + c, v); return v; }
    __device__ __forceinline__ void partial(int m, int g, float ss) const { if (g < 12) partq[m * 12 + g] = ss; } };
struct FPP { bf16_t* pp;
    __device__ __forceinline__ f32x4 operator()(int m, int c, f32x4 v) const { st_bf4(pp + (size_t)m * D_ + c, v); return v; }
    __device__ __forceinline__ void partial(int, int, float) const {} };
struct FQ { bf16_t* Qb; const float* partq; const float* cs; const float* sn;
    __device__ __forceinline__ f32x4 operator()(int m, int c, f32x4 v) const {
        float ss = 0.f;
#pragma unroll
        for (int i = 0; i < 8; ++i) ss += partq[m * 12 + i];
        v = v * (QSCALE / sqrtf(ss * (1.f / 512.f) + EPS));
        if (c < 1024) { st_bf4(Qb + (size_t)m * 1536 + (c >> 7) * 192 + (c & 127), v); }
        else { const int r = c - 1024, h = r >> 6, j = r & 63, i0 = j >> 1;
            const float c0 = cs[m * 32 + i0], s0 = sn[m * 32 + i0], c1 = cs[m * 32 + i0 + 1], s1 = sn[m * 32 + i0 + 1];
            const f32x4 o = {v.x * c0 - v.y * s0, v.y * c0 + v.x * s0, v.z * c1 - v.w * s1, v.w * c1 + v.z * s1};
            st_bf4(Qb + (size_t)m * 1536 + h * 192 + 128 + j, o); }
        return v; }
    __device__ __forceinline__ void partial(int, int, float) const {} };
struct FKV { bf16_t* Kb; bf16_t* Vb; const float* partq;
    __device__ __forceinline__ f32x4 operator()(int m, int c, f32x4 v) const {
        const float ss = (partq[m * 12 + 8] + partq[m * 12 + 9]) + (partq[m * 12 + 10] + partq[m * 12 + 11]);
        v = v * (1.f / sqrtf(ss * (1.f / 256.f) + EPS));
        if (c < 1024) st_bf4(Kb + (size_t)m * 1536 + (c >> 7) * 192 + (c & 127), v); else st_bf4(Vb + (size_t)m * 1024 + (c - 1024), v);
        return v; }
    __device__ __forceinline__ void partial(int, int, float) const {} };
struct FOut { const float* x; float* out; bf16_t* hb; float* part;
    __device__ __forceinline__ f32x4 operator()(int m, int c, f32x4 v) const { const f32x4 h = *(const f32x4*)(x + (size_t)m * D_ + c) + v;
        *(f32x4*)(out + (size_t)m * D_ + c) = h; st_bf4(hb + (size_t)m * D_ + c, h); return h; }
    __device__ __forceinline__ void partial(int m, int g, float ss) const { part[m * 32 + g] = ss; } };
struct FPle { float* out; const bf16_t* pp; const float* rstd; const float* bias; float* part;
    __device__ __forceinline__ f32x4 operator()(int m, int c, f32x4 v) const {
        const float r = rstd[m]; const f32x4 b = *(const f32x4*)(bias + c); const u32x2 pw = *(const u32x2*)(pp + (size_t)m * D_ + c);
        const f32x4 pv = {bf2f(pw.x & 0xffffu), bf2f(pw.x >> 16), bf2f(pw.y & 0xffffu), bf2f(pw.y >> 16)};
        f32x4 h = *(const f32x4*)(out + (size_t)m * D_ + c);
        h.x += sigmoidf_(v.x * r + b.x) * pv.x; h.y += sigmoidf_(v.y * r + b.y) * pv.y; h.z += sigmoidf_(v.z * r + b.z) * pv.z; h.w += sigmoidf_(v.w * r + b.w) * pv.w;
        *(f32x4*)(out + (size_t)m * D_ + c) = h; return h; }
    __device__ __forceinline__ void partial(int m, int g, float ss) const { part[m * 32 + g] = ss; } };

__device__ __forceinline__ void kpe_run(const Params& P, int wg, int nwg, int wv) {
    const int gt = wg * 512 + TIDX, NGT = nwg * 512;
    const bf16_t* proj = WSP(bf16_t, WS_PROJ); bf16_t* Kb = WSP(bf16_t, WS_KB); const float* cs = WSP(float, WS_COS); const float* sn = WSP(float, WS_SIN);
    for (int i = gt; i < S_ * 32; i += NGT) { const int m = i >> 5, j = i & 31;
        const unsigned w = *(const unsigned*)(proj + (size_t)m * DINP + PC_KPE + 2 * j);
        const float a = bf2f(w & 0xffffu), b = bf2f(w >> 16), c = cs[i], s = sn[i];
        const unsigned o = pk2(a * c - b * s, b * c + a * s);
#pragma unroll
        for (int h = 0; h < NH; ++h) *(unsigned*)(Kb + (size_t)m * 1536 + h * 192 + 128 + 2 * j) = o; }
}

__device__ __forceinline__ void attn_naive_run(const Params& P, int wg, int nwg, int wv) {
    const int lane = TIDX & 63, gw = wg * 8 + (TIDX >> 6), NGW = nwg * 8;
    const bf16_t* Qb = WSP(bf16_t, WS_QB); const bf16_t* Kb = WSP(bf16_t, WS_KB); const bf16_t* Vb = WSP(bf16_t, WS_VB);
    bf16_t* Op = WSP(bf16_t, WS_OPART); float* ml = WSP(float, WS_ML);
    for (int it = gw; it < S_ * NH; it += NGW) {
        const int h = it & 7, m = S_ - 1 - (it >> 3);
        const bf16_t* q = Qb + (size_t)m * 1536 + h * 192 + 3 * lane;
        const float q0 = bf2f(q[0]), q1 = bf2f(q[1]), q2 = bf2f(q[2]);
        float mx = -1e30f, l = 0.f, o0 = 0.f, o1 = 0.f;
        for (int key = 0; key <= m; ++key) {
            const bf16_t* kr = Kb + (size_t)key * 1536 + h * 192 + 3 * lane;
            float s = q0 * bf2f(kr[0]) + q1 * bf2f(kr[1]) + q2 * bf2f(kr[2]);
            s = wave_sum(s);
            const float mn = fmaxf(mx, s), al = exp2f(mx - mn), p = exp2f(s - mn);
            const unsigned vw = *(const unsigned*)(Vb + (size_t)key * 1024 + h * 128 + 2 * lane);
            l = l * al + p; o0 = o0 * al + p * bf2f(vw & 0xffffu); o1 = o1 * al + p * bf2f(vw >> 16); mx = mn;
        }
        const float rl = 1.f / l;
        *(unsigned*)(Op + (size_t)m * 1024 + h * 128 + 2 * lane) = pk2(o0 * rl, o1 * rl);
        *(unsigned*)(Op + (size_t)S_ * 1024 + (size_t)m * 1024 + h * 128 + 2 * lane) = 0u;
        if (lane == 0) { float* a = ml + ((size_t)m * 8 + h) * 2; a[0] = 0.f; a[1] = 1.f; float* b = ml + (size_t)S_ * 16 + ((size_t)m * 8 + h) * 2; b[0] = -1e30f; b[1] = 0.f; }
    }
}
__device__ __forceinline__ void combine_run(const Params& P, int wg, int nwg, int wv) {
    const int lane = TIDX & 63, gw = wg * 8 + (TIDX >> 6), NGW = nwg * 8;
    const bf16_t* Op = WSP(bf16_t, WS_OPART); const float* ml = WSP(float, WS_ML); bf16_t* ymix = WSP(bf16_t, WS_YMIX);
    for (int m = gw; m < S_; m += NGW) {
        const int h = lane >> 3;
        const float m0 = ml[((size_t)m * 8 + h) * 2], l0 = ml[((size_t)m * 8 + h) * 2 + 1];
        const float m1 = ml[(size_t)S_ * 16 + ((size_t)m * 8 + h) * 2], l1 = ml[(size_t)S_ * 16 + ((size_t)m * 8 + h) * 2 + 1];
        const float mm = fmaxf(m0, m1); float w0 = l0 * exp2f(m0 - mm), w1 = l1 * exp2f(m1 - mm); const float rs = 1.f / (w0 + w1); w0 *= rs; w1 *= rs;
        const u32x4* a = (const u32x4*)(Op + (size_t)m * 1024 + 16 * lane); const u32x4* b = (const u32x4*)(Op + (size_t)S_ * 1024 + (size_t)m * 1024 + 16 * lane);
        float o[16]; float ss = 0.f;
#pragma unroll
        for (int j = 0; j < 2; ++j) { const u32x4 ua = a[j], ub = b[j]; const unsigned wa[4] = {ua.x, ua.y, ua.z, ua.w}, wb[4] = {ub.x, ub.y, ub.z, ub.w};
#pragma unroll
            for (int i = 0; i < 4; ++i) { o[8 * j + 2 * i] = w0 * bf2f(wa[i] & 0xffffu) + w1 * bf2f(wb[i] & 0xffffu); o[8 * j + 2 * i + 1] = w0 * bf2f(wa[i] >> 16) + w1 * bf2f(wb[i] >> 16); } }
#pragma unroll
        for (int i = 0; i < 16; ++i) ss += o[i] * o[i];
        ss = wave_sum(ss); const float r = 1.f / sqrtf(ss * (1.f / 1024.f) + EPS);
        u32x4 w0v, w1v;
        w0v.x = pk2(o[0] * r, o[1] * r); w0v.y = pk2(o[2] * r, o[3] * r); w0v.z = pk2(o[4] * r, o[5] * r); w0v.w = pk2(o[6] * r, o[7] * r);
        w1v.x = pk2(o[8] * r, o[9] * r); w1v.y = pk2(o[10] * r, o[11] * r); w1v.z = pk2(o[12] * r, o[13] * r); w1v.w = pk2(o[14] * r, o[15] * r);
        u32x4* y = (u32x4*)(ymix + (size_t)m * D_ + 16 * lane); y[0] = w0v; y[1] = w1v;
    }
}

__device__ __forceinline__ void hgrn_naive_run(const Params& P, int wg, int wv, LAS unsigned char* lds) {
    if (wg >= NH) return;
    const int h = wg, tid = TIDX; const bool act = tid < 128; const int v = tid & 127;
    const bf16_t* proj = WSP(bf16_t, WS_PROJ); const float* lb = WSP(float, WS_LB); bf16_t* ymix = WSP(bf16_t, WS_YMIX);
    LAS float* sf = (LAS float*)lds; LAS float* sq = sf + 128; LAS float* red = sq + 128;
    float st[128];
#pragma unroll
    for (int k = 0; k < 128; ++k) st[k] = 0.f;
    for (int t = 0; t < S_; ++t) {
        const bf16_t* pr = proj + (size_t)t * DINP;
        if (act) { const float l = lb[h * 128 + v]; sf[v] = l + (1.f - l) * sigmoidf_(bf2f(pr[PC_HF + h * 128 + v])); sq[v] = siluf_(bf2f(pr[PC_HQ + h * 128 + v])); }
        __syncthreads();
        float o = 0.f;
        if (act) { const float iv = bf2f(pr[PC_HI + h * 128 + v]);
#pragma unroll
            for (int k = 0; k < 128; ++k) { const float f = sf[k]; st[k] = f * st[k] + (1.f - f) * iv; o += sq[k] * st[k]; } }
        float ss = act ? o * o : 0.f; ss = wave_sum(ss);
        if (act && (tid & 63) == 0) red[tid >> 6] = ss;
        __syncthreads();
        if (act) { const float r = 1.f / sqrtf((red[0] + red[1]) * (1.f / 128.f) + EPS);
            ymix[(size_t)t * D_ + 1024 + h * 128 + v] = (bf16_t)f2bf(o * r * siluf_(bf2f(pr[PC_HG + h * 128 + v]))); }
    }
}

__device__ __forceinline__ void route_run(const Params& P, int wg, int nwg, int wv, LAS unsigned char* lds) {
    const int lane = TIDX & 63, wave = TIDX >> 6, gw = wg * 8 + wave, NGW = nwg * 8;
    const float* h1 = P.out; const float* Wr = WSP(float, WS_WR); const float* part1 = WSP(float, WS_PART1);
    LAS float* lg = (LAS float*)lds + wave * 96;
    int* cnt = WSP(int, WS_CTL); int* list = WSP(int, WS_LIST); int* eid = WSP(int, WS_EID); float* ew = WSP(float, WS_EW); float* rstd1 = WSP(float, WS_RSTD1);
    for (int t = gw; t < S_; t += NGW) {
        float ss = (lane < 32) ? part1[t * 32 + lane] : 0.f; ss = wave_sum(ss); const float r = 1.f / sqrtf(ss * (1.f / D_) + EPS);
        float a0 = 0.f, a1 = 0.f; const float* hr = h1 + (size_t)t * D_;
        for (int k = 0; k < D_; ++k) { const float hv = hr[k]; a0 = fmaf(hv, Wr[k * 80 + lane], a0); if (lane < 16) a1 = fmaf(hv, Wr[k * 80 + 64 + lane], a1); }
        lg[lane] = a0 * r; if (lane < 16) lg[64 + lane] = a1 * r;
        asm volatile("s_waitcnt lgkmcnt(0)" ::: "memory");
        if (lane == 0) {
            rstd1[t] = r;
            int g = 0; float gm = -INFINITY;
            for (int i = 0; i < 8; ++i) { const float v = lg[i] + P.b_rg[i]; if (v > gm) { gm = v; g = i; } }
            float gs = 0.f; for (int i = 0; i < 8; ++i) gs += expf(lg[i] + P.b_rg[i] - gm);
            const float gw_ = 1.f / gs;
            int i1 = 0, i2 = 0; float l1 = -INFINITY, l2 = -INFINITY;
            for (int i = 0; i < 8; ++i) { const float e = lg[8 + g * 8 + i] + P.b_re[g * 8 + i];
                if (e > l1) { l2 = l1; i2 = i1; l1 = e; i1 = i; } else if (e > l2) { l2 = e; i2 = i; } }
            const float p2 = expf(l2 - l1), w1 = gw_ / (1.f + p2), w2 = gw_ * p2 / (1.f + p2);
            const int e1 = g * 8 + i1, e2 = g * 8 + i2;
            eid[2 * t] = e1; eid[2 * t + 1] = e2; ew[2 * t] = w1; ew[2 * t + 1] = w2;
            const int p1 = atomicAdd(&cnt[e1], 1); list[e1 * LISTCAP + p1] = 2 * t;
            const int q2 = atomicAdd(&cnt[e2], 1); list[e2 * LISTCAP + q2] = 2 * t + 1;
        }
        asm volatile("s_waitcnt lgkmcnt(0)" ::: "memory");
    }
}

__device__ __forceinline__ void moe_up_naive_run(const Params& P, int wg, int nwg, int wv) {
    const int lane = TIDX & 63, gw = wg * 8 + (TIDX >> 6), NGW = nwg * 8;
    const int* cnt = WSP(int, WS_CTL); const int* list = WSP(int, WS_LIST); const float* rstd1 = WSP(float, WS_RSTD1);
    const bf16_t* h1b = WSP(bf16_t, WS_H1B); bf16_t* hmid = WSP(bf16_t, WS_HMID);
    int off = 0, tbase = 0;
    for (int e = 0; e < NE; ++e) {
        const int n = cnt[e], nrg = (n + 63) >> 6, nit = nrg * 16;
        for (int it = gw - off; it < nit; it += NGW) {
            if (it < 0) continue;
            const int rg = it >> 4, cg = it & 15, c0 = cg * 32;
            const int nrows = (n - rg * 64) < 64 ? (n - rg * 64) : 64;
            const int a = list[e * LISTCAP + rg * 64 + (lane < nrows ? lane : 0)]; const int tok = a >> 1;
            const bf16_t* ar = h1b + (size_t)tok * D_;
            const bf16_t* W = WSP(bf16_t, WS_WGU) + (size_t)e * 1024 * 2048;
            const int pn = c0 >> 7, rr = c0 & 127;
            float ag[32], au[32];
#pragma unroll
            for (int c = 0; c < 32; ++c) { ag[c] = 0.f; au[c] = 0.f; }
            for (int k = 0; k < D_; k += 8) {
                const u32x4 av = *(const u32x4*)(ar + k); float af[8];
                af[0] = bf2f(av.x & 0xffffu); af[1] = bf2f(av.x >> 16); af[2] = bf2f(av.y & 0xffffu); af[3] = bf2f(av.y >> 16);
                af[4] = bf2f(av.z & 0xffffu); af[5] = bf2f(av.z >> 16); af[6] = bf2f(av.w & 0xffffu); af[7] = bf2f(av.w >> 16);
#pragma unroll
                for (int c = 0; c < 32; ++c) {
                    const u32x4 bg = *(const u32x4*)(W + (size_t)(pn * 256 + rr + c) * 2048 + k); const u32x4 bu = *(const u32x4*)(W + (size_t)(pn * 256 + 128 + rr + c) * 2048 + k);
                    float s = ag[c], u = au[c];
                    s = fmaf(af[0], bf2f(bg.x & 0xffffu), s); s = fmaf(af[1], bf2f(bg.x >> 16), s); s = fmaf(af[2], bf2f(bg.y & 0xffffu), s); s = fmaf(af[3], bf2f(bg.y >> 16), s);
                    s = fmaf(af[4], bf2f(bg.z & 0xffffu), s); s = fmaf(af[5], bf2f(bg.z >> 16), s); s = fmaf(af[6], bf2f(bg.w & 0xffffu), s); s = fmaf(af[7], bf2f(bg.w >> 16), s);
                    u = fmaf(af[0], bf2f(bu.x & 0xffffu), u); u = fmaf(af[1], bf2f(bu.x >> 16), u); u = fmaf(af[2], bf2f(bu.y & 0xffffu), u); u = fmaf(af[3], bf2f(bu.y >> 16), u);
                    u = fmaf(af[4], bf2f(bu.z & 0xffffu), u); u = fmaf(af[5], bf2f(bu.z >> 16), u); u = fmaf(af[6], bf2f(bu.w & 0xffffu), u); u = fmaf(af[7], bf2f(bu.w >> 16), u);
                    ag[c] = s; au[c] = u;
                }
            }
            if (lane < nrows) { const float r = rstd1[tok]; const int slot = tbase * 256 + rg * 64 + lane;
#pragma unroll
                for (int c = 0; c < 32; c += 2) *(unsigned*)(hmid + (size_t)slot * DE + c0 + c) = pk2(siluf_(ag[c] * r) * (au[c] * r), siluf_(ag[c + 1] * r) * (au[c + 1] * r)); }
        }
        off = (off + nit) % NGW; tbase += (n + 255) >> 8;
    }
}
struct FDown { bf16_t* y; const int* lst; int slot0; const float* ew;
    __device__ __forceinline__ f32x4 operator()(int m, int c, f32x4 v) const { const int a = lst[m - slot0]; v = v * ew[a]; st_bf4(y + (size_t)a * D_ + c, v); return v; }
    __device__ __forceinline__ void partial(int, int, float) const {} };
__device__ __forceinline__ void moe_down_naive_run(const Params& P, int wg, int nwg, int wv) {
    const int lane = TIDX & 63, gw = wg * 8 + (TIDX >> 6), NGW = nwg * 8;
    const int* cnt = WSP(int, WS_CTL); const int* list = WSP(int, WS_LIST); const float* ew = WSP(float, WS_EW);
    const bf16_t* hmid = WSP(bf16_t, WS_HMID); bf16_t* y = WSP(bf16_t, WS_Y);
    int off = 0, tbase = 0;
    for (int e = 0; e < NE; ++e) {
        const int n = cnt[e], nrg = (n + 63) >> 6, nit = nrg * 32;
        for (int it = gw - off; it < nit; it += NGW) {
            if (it < 0) continue;
            const int rg = it >> 5, cg = it & 31; const int nrows = (n - rg * 64) < 64 ? (n - rg * 64) : 64;
            const int slot0 = tbase * 256 + rg * 64;
            FDown f{y, list + e * LISTCAP + rg * 64, slot0, ew};
            naive_gemm_item(hmid, DE, WSP(bf16_t, WS_WD) + (size_t)e * 2048 * DE, DE, DE, slot0, nrows, cg * 64, f, RowId{}, lane);
        }
        off = (off + nit) % NGW; tbase += (n + 255) >> 8;
    }
}
__device__ __forceinline__ void moe_combine_run(const Params& P, int wg, int nwg, int wv) {
    const int lane = TIDX & 63, gw = wg * 8 + (TIDX >> 6), NGW = nwg * 8;
    const bf16_t* y = WSP(bf16_t, WS_Y); bf16_t* h2b = WSP(bf16_t, WS_H2B); float* rstd2 = WSP(float, WS_RSTD2);
    for (int m = gw; m < S_; m += NGW) {
        f32x4* hr = (f32x4*)(P.out + (size_t)m * D_) + lane; const u32x2* y0 = (const u32x2*)(y + (size_t)(2 * m) * D_) + lane; const u32x2* y1 = (const u32x2*)(y + (size_t)(2 * m + 1) * D_) + lane;
        u32x2* ob = (u32x2*)(h2b + (size_t)m * D_) + lane; float ss = 0.f;
#pragma unroll
        for (int j = 0; j < 8; ++j) { f32x4 h = hr[64 * j]; const u32x2 a = y0[64 * j], b = y1[64 * j];
            h.x += bf2f(a.x & 0xffffu) + bf2f(b.x & 0xffffu); h.y += bf2f(a.x >> 16) + bf2f(b.x >> 16); h.z += bf2f(a.y & 0xffffu) + bf2f(b.y & 0xffffu); h.w += bf2f(a.y >> 16) + bf2f(b.y >> 16);
            hr[64 * j] = h; u32x2 w; w.x = pk2(h.x, h.y); w.y = pk2(h.z, h.w); ob[64 * j] = w; ss += (h.x * h.x + h.y * h.y) + (h.z * h.z + h.w * h.w); }
        ss = wave_sum(ss); if (lane == 0) rstd2[m] = 1.f / sqrtf(ss * (1.f / D_) + EPS);
    }
}
__device__ __forceinline__ void final_run(const Params& P, int wg, int nwg, int wv) {
    const int lane = TIDX & 63, gw = wg * 8 + (TIDX >> 6), NGW = nwg * 8; const float* part3 = WSP(float, WS_PART3);
    for (int m = gw; m < S_; m += NGW) {
        float ss = (lane < 32) ? part3[m * 32 + lane] : 0.f; ss = wave_sum(ss); const float r = 1.f / sqrtf(ss * (1.f / D_) + EPS);
        f32x4* hr = (f32x4*)(P.out + (size_t)m * D_) + lane; const f32x4* g = (const f32x4*)P.final_norm + lane;
#pragma unroll
        for (int j = 0; j < 8; ++j) hr[64 * j] = hr[64 * j] * r * g[64 * j];
    }
}

namespace pg8 {
typedef short bf16x8 __attribute__((ext_vector_type(8)));
constexpr int BM = 256, BK = 64, HALF = 128, HTB = HALF * BK * 2, STAGE_BYTES = 8 * HTB, NXCD = 8, WGM = 8;
__device__ __forceinline__ int lds_byte(int r, int c) { const int st = (r >> 4) * 2 + (c >> 5), rr = r & 15, cc = c & 31, ob = rr * 64 + cc * 2; return st * 1024 + (ob ^ (((ob >> 9) & 1) << 5)); }
__device__ __forceinline__ void stage_rc(int b, int& R, int& C) { const int st = b / 1024, sb = b % 1024, swz = sb ^ (((sb >> 9) & 1) << 5); R = (st >> 1) * 16 + swz / 64; C = (st & 1) * 32 + (swz % 64) / 2; }
struct Unit { int pm, pn; const char* a; const char* b; int x0, x1, x2; };
struct DenseOrder {
    const bf16_t* A; const bf16_t* Bt; int K, lda, nM, nN, nwg, G, c;
    __device__ __forceinline__ void init(const bf16_t* A_, int lda_, const bf16_t* Bt_, int M, int N, int K_, int G_, int c_) { A = A_; lda = lda_; Bt = Bt_; K = K_; nM = M / BM; nN = N / BM; nwg = nM * nN; G = G_; c = c_; }
    __device__ __forceinline__ bool next(int i, Unit& u) const {
        const long L = (long)i * G + c; if (L >= nwg) return false;
        int wgid = (int)L; { const int q = nwg / NXCD, r = nwg % NXCD, xcd = wgid % NXCD, off = wgid / NXCD; wgid = (xcd < r ? xcd * (q + 1) : r * (q + 1) + (xcd - r) * q) + off; }
        const int nig = WGM * nN, gid = wgid / nig, fm = gid * WGM, gsz = (nM - fm) < WGM ? (nM - fm) : WGM;
        u.pm = fm + ((wgid % nig) % gsz); u.pn = (wgid % nig) / gsz;
        u.a = (const char*)A + (size_t)u.pm * BM * lda * 2; u.b = (const char*)Bt + (size_t)u.pn * BM * K * 2; u.x0 = 0; u.x1 = 0; u.x2 = 0; return true;
    }
    __device__ __forceinline__ unsigned row_off(const Unit&, int) const { return 0u; }
};
template <class F> struct EpiF { F f;
    __device__ __forceinline__ void operator()(const f32x4 (&acc)[2][2][4][2], const Unit& u, int wr, int wc, int fr, int fq) const {
#pragma unroll
        for (int ai = 0; ai < 2; ++ai)
#pragma unroll
            for (int m = 0; m < 4; ++m) { const int r = ai * HALF + wr * 64 + m * 16 + fr; const auto ctx = f.row(u, r); float ss = 0.f;
#pragma unroll
                for (int bj = 0; bj < 2; ++bj)
#pragma unroll
                    for (int n = 0; n < 2; ++n) { const f32x4 v = f.elem(u, r, bj * HALF + wc * 32 + n * 16 + fq * 4, acc[ai][bj][m][n], ctx);
                        if (F::ROWSUM) ss += (v.x * v.x + v.y * v.y) + (v.z * v.z + v.w * v.w); }
                if (F::ROWSUM) { ss += __shfl_xor(ss, 16); ss += __shfl_xor(ss, 32); if (fq == 0) f.partial(u, r, wc, ss); }
                asm volatile("" ::: "memory"); }
    } };

template <class Epi, class Sched, bool GATHER>
__device__ __forceinline__ void gemm_phase(LAS unsigned char* lds, const int K, const int lda, const Sched& S, const Epi& E, const int wv) {
    const int wid = wv, lane = lane_id_(), tid = wid * 64 + lane, wr = wid >> 2, wc = wid & 3, fr = lane & 15, fq = lane >> 4;
    const int nt = K / BK;
    unsigned voffB[2], vA[2][2], vAn[2][2];
#pragma unroll
    for (int i = 0; i < 2; ++i) { int R, C; stage_rc(tid * 16 + i * 8192, R, C); voffB[i] = (unsigned)(R * K + C) * 2u;
        vA[0][i] = (unsigned)(R * lda + C) * 2u; vA[1][i] = vA[0][i]; vAn[0][i] = vA[0][i]; vAn[1][i] = vA[0][i]; }
    const size_t kstep = (size_t)(BK * 2);
    const size_t hstepB = (size_t)HALF * K * 2;
    const size_t hstepA = GATHER ? (size_t)0 : (size_t)HALF * lda * 2;
    const unsigned ldsw = (unsigned)wid * 1024u;
    const int aoff = lds_byte(wr * 64 + fr, fq * 8), boff = lds_byte(wc * 32 + fr, fq * 8);
#define PG8_SA(b, h) (((b) * 2 + (h)) * HTB)
#define PG8_SB(b, h) ((4 + (b) * 2 + (h)) * HTB)
#define PG8_STAGE(bufoff, gbase, voff) do { _Pragma("unroll") for (int _i = 0; _i < 2; ++_i) \
        __builtin_amdgcn_global_load_lds((const unsigned*)((const char*)(gbase) + (voff)[_i]), (LAS unsigned*)(lds + (bufoff) + ldsw + _i * 8192), 16, 0, 0); } while (0)
#define PG8_LDA(dst, b, h) do { _Pragma("unroll") for (int m = 0; m < 4; ++m) _Pragma("unroll") for (int k = 0; k < 2; ++k) dst[m][k] = *(const LAS bf16x8*)(lds + PG8_SA(b, h) + aoff + m * 2048 + k * 1024); } while (0)
#define PG8_LDB(dst, b, h) do { _Pragma("unroll") for (int n = 0; n < 2; ++n) _Pragma("unroll") for (int k = 0; k < 2; ++k) dst[n][k] = *(const LAS bf16x8*)(lds + PG8_SB(b, h) + boff + n * 2048 + k * 1024); } while (0)
#define PG8_MMA(ai, bj, At, Bt) do { __builtin_amdgcn_s_setprio(1); _Pragma("unroll") for (int m = 0; m < 4; ++m) _Pragma("unroll") for (int n = 0; n < 2; ++n) _Pragma("unroll") for (int k = 0; k < 2; ++k) \
        acc[ai][bj][m][n] = __builtin_amdgcn_mfma_f32_16x16x32_bf16(Bt[n][k], At[m][k], acc[ai][bj][m][n], 0, 0, 0); __builtin_amdgcn_s_setprio(0); } while (0)
#define PG8_WAIT_V(n) asm volatile("s_waitcnt vmcnt(" #n ")" ::: "memory")
#define PG8_WAIT_L(n) asm volatile("s_waitcnt lgkmcnt(" #n ")" ::: "memory")
#define PG8_BAR __builtin_amdgcn_s_barrier()
#define PG8_SCHED __builtin_amdgcn_sched_barrier(0)
#define PG8_GOFF(dst, uu) do { if constexpr (GATHER) { _Pragma("unroll") for (int _i = 0; _i < 2; ++_i) { int _R, _C; stage_rc((wid * 64 + lane_id_()) * 16 + _i * 8192, _R, _C); \
        _Pragma("unroll") for (int _h = 0; _h < 2; ++_h) dst[_h][_i] = S.row_off(uu, _R + _h * HALF) + (unsigned)_C * 2u; } } } while (0)
    Unit cur, nxt; int ui = 0;
    if (!S.next(0, cur)) return;
    PG8_GOFF(vA, cur);
    f32x4 acc[2][2][4][2];
#pragma unroll
    for (int a = 0; a < 2; ++a)
#pragma unroll
        for (int b = 0; b < 2; ++b)
#pragma unroll
            for (int m = 0; m < 4; ++m)
#pragma unroll
                for (int n = 0; n < 2; ++n) acc[a][b][m][n] = (f32x4){0.f, 0.f, 0.f, 0.f};
    bf16x8 At[4][2], B0[2][2], B1[2][2];
    const char* cA = cur.a; const char* cB = cur.b;
    PG8_STAGE(PG8_SB(0, 0), cB, voffB); PG8_STAGE(PG8_SB(0, 1), cB + hstepB, voffB); PG8_STAGE(PG8_SA(0, 0), cA, vA[0]); PG8_STAGE(PG8_SA(0, 1), cA + hstepA, vA[1]);
    if (wr == 1) PG8_BAR;
    PG8_WAIT_V(2); PG8_BAR;
    PG8_STAGE(PG8_SB(1, 0), cB + kstep, voffB); PG8_STAGE(PG8_SA(1, 0), cA + kstep, vA[0]); PG8_STAGE(PG8_SB(1, 1), cB + hstepB + kstep, voffB);
    PG8_WAIT_V(6); PG8_BAR;
    for (;;) {
        const bool has_next = S.next(ui + 1, nxt);
        const char* nA = has_next ? nxt.a : cA; const char* nB = has_next ? nxt.b : cB;
        if constexpr (GATHER) { if (has_next) { PG8_GOFF(vAn, nxt); } else {
#pragma unroll
            for (int h = 0; h < 2; ++h)
#pragma unroll
                for (int i = 0; i < 2; ++i) vAn[h][i] = vA[h][i]; } }
        for (int t = 0; t < nt; t += 2) {
            const bool last = (t == nt - 2);
            const char* a1 = cA + (size_t)(t + 1) * kstep;
            const char* a2 = last ? nA : cA + (size_t)(t + 2) * kstep; const char* b2 = last ? nB : cB + (size_t)(t + 2) * kstep;
            const char* a3 = a2 + kstep; const char* b3 = b2 + kstep;
            unsigned w0[2], w1[2];
#pragma unroll
            for (int i = 0; i < 2; ++i) { w0[i] = (GATHER && last) ? vAn[0][i] : vA[0][i]; w1[i] = (GATHER && last) ? vAn[1][i] : vA[1][i]; }
            PG8_LDB(B0, 0, 0); PG8_LDB(B1, 0, 1); PG8_SCHED; PG8_LDA(At, 0, 0); PG8_STAGE(PG8_SA(1, 1), a1 + hstepA, vA[1]);
            PG8_WAIT_V(8); PG8_WAIT_L(0); PG8_BAR; PG8_MMA(0, 0, At, B0); PG8_MMA(0, 1, At, B1); PG8_BAR; PG8_SCHED;
            PG8_LDA(At, 0, 1); PG8_STAGE(PG8_SB(0, 0), b2, voffB); PG8_STAGE(PG8_SB(0, 1), b2 + hstepB, voffB); PG8_STAGE(PG8_SA(0, 0), a2, w0);
            PG8_WAIT_V(8); PG8_WAIT_L(0); PG8_BAR; PG8_MMA(1, 0, At, B0); PG8_MMA(1, 1, At, B1); PG8_BAR; PG8_SCHED;
            PG8_LDB(B0, 1, 0); PG8_LDB(B1, 1, 1); PG8_SCHED; PG8_LDA(At, 1, 0); PG8_STAGE(PG8_SA(0, 1), a2 + hstepA, w1);
            PG8_WAIT_V(8); PG8_WAIT_L(0); PG8_BAR; PG8_MMA(0, 0, At, B0); PG8_MMA(0, 1, At, B1); PG8_BAR; PG8_SCHED;
            PG8_LDA(At, 1, 1); PG8_STAGE(PG8_SB(1, 0), b3, voffB); PG8_STAGE(PG8_SB(1, 1), b3 + hstepB, voffB); PG8_STAGE(PG8_SA(1, 0), a3, w0);
            PG8_WAIT_V(8); PG8_WAIT_L(0); PG8_BAR; PG8_MMA(1, 0, At, B0); PG8_MMA(1, 1, At, B1); PG8_BAR; PG8_SCHED;
        }
        if (wr == 0) PG8_BAR;
        E(acc, cur, wr, wc, fr, fq);
        if (!has_next) break;
#pragma unroll
        for (int a = 0; a < 2; ++a)
#pragma unroll
            for (int b = 0; b < 2; ++b)
#pragma unroll
                for (int m = 0; m < 4; ++m)
#pragma unroll
                    for (int n = 0; n < 2; ++n) acc[a][b][m][n] = (f32x4){0.f, 0.f, 0.f, 0.f};
        cur = nxt; cA = nA; cB = nB; ++ui;
        if constexpr (GATHER) {
#pragma unroll
            for (int h = 0; h < 2; ++h)
#pragma unroll
                for (int i = 0; i < 2; ++i) vA[h][i] = vAn[h][i]; }
        if (wr == 1) PG8_BAR;
    }
    PG8_WAIT_V(0);
    PG8_BAR;
#undef PG8_SA
#undef PG8_SB
#undef PG8_STAGE
#undef PG8_LDA
#undef PG8_LDB
#undef PG8_MMA
#undef PG8_WAIT_V
#undef PG8_WAIT_L
#undef PG8_BAR
#undef PG8_SCHED
#undef PG8_GOFF
}
}

struct PFProj { static constexpr bool ROWSUM = true; bf16_t* proj; const float* rstd; float* partq;
    __device__ __forceinline__ float row(const pg8::Unit& u, int r) const { return rstd[u.pm * 256 + r]; }
    __device__ __forceinline__ f32x4 elem(const pg8::Unit& u, int r, int c, f32x4 v, float rs) const { v = v * rs; st_bf4(proj + (size_t)(u.pm * 256 + r) * DINP + u.pn * 256 + c, v); return v; }
    __device__ __forceinline__ void partial(const pg8::Unit& u, int r, int wc, float ss) const { const int g = u.pn * 4 + wc; if (g < 12) partq[(u.pm * 256 + r) * 12 + g] = ss; } };
struct PFPP { static constexpr bool ROWSUM = false; bf16_t* pp;
    __device__ __forceinline__ int row(const pg8::Unit&, int) const { return 0; }
    __device__ __forceinline__ f32x4 elem(const pg8::Unit& u, int r, int c, f32x4 v, int) const { st_bf4(pp + (size_t)(u.pm * 256 + r) * D_ + u.pn * 256 + c, v); return v; }
    __device__ __forceinline__ void partial(const pg8::Unit&, int, int, float) const {} };
struct PFQ { static constexpr bool ROWSUM = false; bf16_t* Qb; const float* partq; const float* cs; const float* sn;
    __device__ __forceinline__ float row(const pg8::Unit& u, int r) const { const f32x4* p = (const f32x4*)(partq + (size_t)(u.pm * 256 + r) * 12); const f32x4 a = p[0], b = p[1];
        const float ss = ((a.x + a.y) + (a.z + a.w)) + ((b.x + b.y) + (b.z + b.w)); return QSCALE / sqrtf(ss * (1.f / 512.f) + EPS); }
    __device__ __forceinline__ f32x4 elem(const pg8::Unit& u, int r, int cc, f32x4 v, float sc) const { const int m = u.pm * 256 + r, c = u.pn * 256 + cc; v = v * sc;
        if (u.pn < 4) { st_bf4(Qb + (size_t)m * 1536 + (c >> 7) * 192 + (c & 127), v); }
        else { const int q = c - 1024, h = q >> 6, j = q & 63, i0 = j >> 1;
            const float c0 = cs[m * 32 + i0], s0 = sn[m * 32 + i0], c1 = cs[m * 32 + i0 + 1], s1 = sn[m * 32 + i0 + 1];
            const f32x4 o = {v.x * c0 - v.y * s0, v.y * c0 + v.x * s0, v.z * c1 - v.w * s1, v.w * c1 + v.z * s1};
            st_bf4(Qb + (size_t)m * 1536 + h * 192 + 128 + j, o); }
        return v; }
    __device__ __forceinline__ void partial(const pg8::Unit&, int, int, float) const {} };
struct PFKV { static constexpr bool ROWSUM = false; bf16_t* Kb; bf16_t* Vb; const float* partq;
    __device__ __forceinline__ float row(const pg8::Unit& u, int r) const { const f32x4 a = *(const f32x4*)(partq + (size_t)(u.pm * 256 + r) * 12 + 8);
        return 1.f / sqrtf(((a.x + a.y) + (a.z + a.w)) * (1.f / 256.f) + EPS); }
    __device__ __forceinline__ f32x4 elem(const pg8::Unit& u, int r, int cc, f32x4 v, float sc) const { const int m = u.pm * 256 + r, c = u.pn * 256 + cc; v = v * sc;
        if (u.pn < 4) st_bf4(Kb + (size_t)m * 1536 + (c >> 7) * 192 + (c & 127), v); else st_bf4(Vb + (size_t)m * 1024 + (c - 1024), v);
        return v; }
    __device__ __forceinline__ void partial(const pg8::Unit&, int, int, float) const {} };
struct PFOut { static constexpr bool ROWSUM = true; const float* x; float* out; bf16_t* hb; float* part;
    __device__ __forceinline__ int row(const pg8::Unit&, int) const { return 0; }
    __device__ __forceinline__ f32x4 elem(const pg8::Unit& u, int r, int cc, f32x4 v, int) const { const size_t o = (size_t)(u.pm * 256 + r) * D_ + u.pn * 256 + cc;
        const f32x4 h = *(const f32x4*)(x + o) + v; *(f32x4*)(out + o) = h; st_bf4(hb + o, h); return h; }
    __device__ __forceinline__ void partial(const pg8::Unit& u, int r, int wc, float ss) const { part[(u.pm * 256 + r) * 32 + u.pn * 4 + wc] = ss; } };
struct PFPle { static constexpr bool ROWSUM = true; float* out; const bf16_t* pp; const float* rstd; const float* bias; float* part;
    __device__ __forceinline__ float row(const pg8::Unit& u, int r) const { return rstd[u.pm * 256 + r]; }
    __device__ __forceinline__ f32x4 elem(const pg8::Unit& u, int r, int cc, f32x4 v, float rs) const { const int c = u.pn * 256 + cc; const size_t o = (size_t)(u.pm * 256 + r) * D_ + c;
        const f32x4 b = *(const f32x4*)(bias + c); const u32x2 pw = *(const u32x2*)(pp + o);
        const f32x4 pv = {bf2f(pw.x & 0xffffu), bf2f(pw.x >> 16), bf2f(pw.y & 0xffffu), bf2f(pw.y >> 16)};
        f32x4 h = *(const f32x4*)(out + o);
        h.x += sigmoidf_(v.x * rs + b.x) * pv.x; h.y += sigmoidf_(v.y * rs + b.y) * pv.y; h.z += sigmoidf_(v.z * rs + b.z) * pv.z; h.w += sigmoidf_(v.w * rs + b.w) * pv.w;
        *(f32x4*)(out + o) = h; return h; }
    __device__ __forceinline__ void partial(const pg8::Unit& u, int r, int wc, float ss) const { part[(u.pm * 256 + r) * 32 + u.pn * 4 + wc] = ss; } };
template <class F> __device__ __forceinline__ void dense_gemm(LAS unsigned char* lds, const bf16_t* A, int lda, const bf16_t* Bt, int M, int N, int K, const F& f, int wg, int nwg, int wv) {
    asm volatile("" : "+s"(K), "+s"(lda));
    pg8::DenseOrder S; S.init(A, lda, Bt, M, N, K, nwg, wg);
    pg8::EpiF<F> E{f};
    pg8::gemm_phase<pg8::EpiF<F>, pg8::DenseOrder, false>(lds, K, lda, S, E, wv);
}


namespace att {
typedef short bf16x8 __attribute__((ext_vector_type(8)));
typedef short s16x4 __attribute__((ext_vector_type(4)));
typedef float f32x16 __attribute__((ext_vector_type(16)));
constexpr int KVBLK = 64, QBLK = 32, QB = 256, KROW = 384  , SHM_V = 64 * 128 * 2, SHM_K = 64 * KROW;
constexpr int LDQ = 1536, LDK = 1536, LDV = 1024, LDO = 1024;
constexpr float THR = 8.f;
#define KSWZ(row, colB) ((row) * KROW + ((colB) ^ (((row) & 7) << 4)))
#define SBAR() __builtin_amdgcn_sched_barrier(0)
__device__ __forceinline__ int v_st(int k, int c) { const int kk = (k & ~0xC) | ((k & 4) << 1) | ((k & 8) >> 1); return ((kk >> 3) * 4 + (c >> 5)) * 512 + ((kk & 7) * 32 + (c & 31)) * 2; }
__device__ __forceinline__ int v_rd_base(int lane) { return ((lane & 3) << 3) | (((lane >> 2) & 3) << 6) | (((lane >> 4) & 1) << 5) | (((lane >> 5) & 1) << 8); }
constexpr int v_rd_off(int d0, int ks, int half) { return d0 * 512 + ks * 4096 + half * 2048; }
__device__ __forceinline__ int crow(int r, int hi) { return (r & 3) + 8 * (r >> 2) + 4 * hi; }
__device__ __forceinline__ unsigned cvtpk(float lo, float hi) { unsigned r; asm volatile("v_cvt_pk_bf16_f32 %0, %1, %2" : "=v"(r) : "v"(lo), "v"(hi)); return r; }
__device__ __forceinline__ void mask_tile(f32x16& p0, f32x16& p1, int dq) {
    const float NEG = -__builtin_inff();
#pragma unroll
    for (int r = 0; r < 16; ++r) { const int c = (r & 3) + 8 * (r >> 2); if (dq - c < 0) p0[r] = NEG; if (dq - c - 32 < 0) p1[r] = NEG; }
}
__device__ __forceinline__ void partialSM(f32x16& p0, f32x16& p1, float& m_reg, float& mn, float& alpha) {
    float pmax = p0[0];
#pragma unroll
    for (int r = 1; r < 16; ++r) pmax = fmaxf(pmax, p0[r]);
#pragma unroll
    for (int r = 0; r < 16; ++r) pmax = fmaxf(pmax, p1[r]);
    { auto rr = __builtin_amdgcn_permlane32_swap(__float_as_uint(pmax), __float_as_uint(pmax), false, false);
      pmax = fmaxf(__uint_as_float(rr[0]), __uint_as_float(rr[1])); }
    if (__builtin_expect(__all((pmax - m_reg) <= THR), 1)) { mn = m_reg; alpha = 1.f; }
    else { mn = fmaxf(m_reg, pmax); alpha = __builtin_amdgcn_exp2f(m_reg - mn); m_reg = mn; }
#pragma unroll
    for (int r = 0; r < 16; ++r) p0[r] = p0[r] - mn;
#pragma unroll
    for (int r = 0; r < 16; ++r) p1[r] = p1[r] - mn;
#pragma unroll
    for (int r = 0; r < 16; ++r) p0[r] = __builtin_amdgcn_exp2f(p0[r]);
}
__device__ __forceinline__ void finishSM(f32x16& p0, f32x16& p1, float alpha, float& l_reg, bf16x8& pa0, bf16x8& pa1, bf16x8& pa2, bf16x8& pa3) {
#pragma unroll
    for (int r = 0; r < 16; ++r) p1[r] = __builtin_amdgcn_exp2f(p1[r]);
    float ps = 0;
#pragma unroll
    for (int r = 0; r < 16; ++r) ps += p0[r];
#pragma unroll
    for (int r = 0; r < 16; ++r) ps += p1[r];
    { auto rr = __builtin_amdgcn_permlane32_swap(__float_as_uint(ps), __float_as_uint(ps), false, false);
      ps = __uint_as_float(rr[0]) + __uint_as_float(rr[1]); }
    l_reg = l_reg * alpha + ps;
#define PK4(P, B_, OUT) do { unsigned a0 = cvtpk(P[B_+0], P[B_+1]), a1 = cvtpk(P[B_+2], P[B_+3]);                          \
        unsigned b0 = cvtpk(P[B_+4], P[B_+5]), b1 = cvtpk(P[B_+6], P[B_+7]);                                             \
        auto r0 = __builtin_amdgcn_permlane32_swap(a0, b0, false, false); auto r1 = __builtin_amdgcn_permlane32_swap(a1, b1, false, false); \
        u32x4 w = {r0[0], r1[0], r0[1], r1[1]}; OUT = *reinterpret_cast<bf16x8*>(&w); } while (0)
    PK4(p0, 0, pa0); PK4(p0, 8, pa1); PK4(p1, 0, pa2); PK4(p1, 8, pa3);
#undef PK4
}
template <int KB>
__device__ __forceinline__ void qkt(f32x16& p0, f32x16& p1, const char* K_lds, int r32, int hi, const bf16x8* qr) {
    p0 = f32x16{}; p1 = f32x16{};
    const char* kb[4];
#pragma unroll
    for (int dd = 0; dd < 4; ++dd) kb[dd] = K_lds + KB * SHM_K + KSWZ(r32, (dd * 16 + hi * 8) * 2);
#pragma unroll
    for (int d0 = 0; d0 < 12; ++d0) { const char* a = kb[d0 & 3] + (d0 >> 2) * 128;
        bf16x8 b0 = *reinterpret_cast<const bf16x8*>(a);
        bf16x8 b1 = *reinterpret_cast<const bf16x8*>(a + 32 * KROW);
        p0 = __builtin_amdgcn_mfma_f32_32x32x16_bf16(b0, qr[d0], p0, 0, 0, 0);
        p1 = __builtin_amdgcn_mfma_f32_32x32x16_bf16(b1, qr[d0], p1, 0, 0, 0); }
}
template <int VB>
__device__ __forceinline__ void pv_tile(f32x16* o, int vb0, bf16x8 pa0, bf16x8 pa1, bf16x8 pa2, bf16x8 pa3) {
#define TRRD(dst, off) asm volatile("ds_read_b64_tr_b16 %0, %1 offset:%2" : "=&v"(dst) : "v"(vb0), "i"(off) : "memory")
#define PV_D0(d0) do { s16x4 l0, l1, l2, l3, h0, h1, h2, h3; constexpr int b_ = VB * SHM_V + v_rd_off(d0, 0, 0); \
        TRRD(l0, b_); TRRD(h0, b_ + 2048); TRRD(l1, b_ + 4096); TRRD(h1, b_ + 6144); TRRD(l2, b_ + 8192); TRRD(h2, b_ + 10240); TRRD(l3, b_ + 12288); TRRD(h3, b_ + 14336); \
        asm volatile("s_waitcnt lgkmcnt(0)" ::: "memory"); SBAR();   \
        o[d0] = __builtin_amdgcn_mfma_f32_32x32x16_bf16(pa0, (bf16x8){l0[0], l0[1], l0[2], l0[3], h0[0], h0[1], h0[2], h0[3]}, o[d0], 0, 0, 0);   \
        o[d0] = __builtin_amdgcn_mfma_f32_32x32x16_bf16(pa1, (bf16x8){l1[0], l1[1], l1[2], l1[3], h1[0], h1[1], h1[2], h1[3]}, o[d0], 0, 0, 0);   \
        o[d0] = __builtin_amdgcn_mfma_f32_32x32x16_bf16(pa2, (bf16x8){l2[0], l2[1], l2[2], l2[3], h2[0], h2[1], h2[2], h2[3]}, o[d0], 0, 0, 0);   \
        o[d0] = __builtin_amdgcn_mfma_f32_32x32x16_bf16(pa3, (bf16x8){l3[0], l3[1], l3[2], l3[3], h3[0], h3[1], h3[2], h3[3]}, o[d0], 0, 0, 0); } while (0)
    PV_D0(0); PV_D0(1); PV_D0(2); PV_D0(3);
#undef PV_D0
#undef TRRD
}
struct Ref { const bf16_t* Q; const bf16_t* K; const bf16_t* V; bf16_t* O; float* ml; int P0, j_lo, j_hi; };
#define VMW() asm volatile("s_waitcnt vmcnt(0)" ::: "memory")
#define LD8(p) (*reinterpret_cast<const bf16x8*>(p))
#define STG_IDX() int tl_ = tid; asm volatile("" : "+v"(tl_)); const int sr = tl_ >> 4, sc = (tl_ & 15) * 8; \
        const int kr0 = tl_ / 24, kc0 = (tl_ % 24) * 8, kr1 = (tl_ + 512) / 24, kc1 = ((tl_ + 512) % 24) * 8, kr2 = (tl_ + 1024) / 24, kc2 = ((tl_ + 1024) % 24) * 8
#define SLOAD_H(k0) do { STG_IDX(); st_v0 = LD8(Vh + (size_t)((k0) + sr) * LDV + sc); st_v1 = LD8(Vh + (size_t)((k0) + 32 + sr) * LDV + sc); \
        st_k0 = LD8(Kh + (size_t)((k0) + kr0) * LDK + kc0); st_k1 = LD8(Kh + (size_t)((k0) + kr1) * LDK + kc1); st_k2 = LD8(Kh + (size_t)((k0) + kr2) * LDK + kc2); } while (0)
#define SWRITE_H(bf) do { STG_IDX(); *(bf16x8*)(V_lds + (bf) * SHM_V + v_st(sr, sc)) = st_v0; *(bf16x8*)(V_lds + (bf) * SHM_V + v_st(32 + sr, sc)) = st_v1; \
        *(bf16x8*)(K_lds + (bf) * SHM_K + KSWZ(kr0, kc0 * 2)) = st_k0; *(bf16x8*)(K_lds + (bf) * SHM_K + KSWZ(kr1, kc1 * 2)) = st_k1; *(bf16x8*)(K_lds + (bf) * SHM_K + KSWZ(kr2, kc2 * 2)) = st_k2; } while (0)
__device__ __forceinline__ void unit(const Ref& cur, char* lds, int wid, int lane) {
    const int tid = wid * 64 + lane, r32 = lane & 31, hi = lane >> 5;
    const int j_lo = cur.j_lo, NT = cur.j_hi - cur.j_lo;
    const int qlo = cur.P0 + wid * QBLK, qm = qlo + r32 - 4 * hi;
    char* V_lds = lds; char* K_lds = lds + 2 * SHM_V;
    float* ws = (float*)(lds + 2 * SHM_V + 2 * SHM_K) + wid * 64; float* li_l = ws, * al_l = ws + 32;
    const int vb0 = (int)(uintptr_t)V_lds + v_rd_base(lane);
    const bf16_t* Kh = cur.K; const bf16_t* Vh = cur.V;
    bf16x8 qr[12], st_v0, st_v1, st_k0, st_k1, st_k2;
#pragma unroll
    for (int d0 = 0; d0 < 12; ++d0) qr[d0] = LD8(cur.Q + (size_t)(wid * QBLK + r32) * LDQ + d0 * 16 + hi * 8);
    SLOAD_H(j_lo * KVBLK); VMW(); SWRITE_H(0);
    __syncthreads();
    float m_reg = -1e30f, l_reg = 0; f32x16 o[4] = {};
    for (int t = 0; t < NT; ++t) {
        const int bf = t & 1, kb_ = (j_lo + t) * KVBLK;
        if (t + 1 < NT) SLOAD_H(kb_ + KVBLK);
        SBAR();
        f32x16 p0 = f32x16{}, p1 = f32x16{};
        { const char* kbase = K_lds + bf * SHM_K; const char* kb[4];
#pragma unroll
          for (int dd = 0; dd < 4; ++dd) kb[dd] = kbase + KSWZ(r32, (dd * 16 + hi * 8) * 2);
#pragma unroll
          for (int d0 = 0; d0 < 12; ++d0) { const char* a = kb[d0 & 3] + (d0 >> 2) * 128;
              const bf16x8 b0 = *reinterpret_cast<const bf16x8*>(a); const bf16x8 b1 = *reinterpret_cast<const bf16x8*>(a + 32 * KROW);
              p0 = __builtin_amdgcn_mfma_f32_32x32x16_bf16(b0, qr[d0], p0, 0, 0, 0);
              p1 = __builtin_amdgcn_mfma_f32_32x32x16_bf16(b1, qr[d0], p1, 0, 0, 0); } }
        if (kb_ + KVBLK - 1 > qlo) mask_tile(p0, p1, qm - kb_);
        float mn, alpha; bf16x8 pa0, pa1, pa2, pa3;
        partialSM(p0, p1, m_reg, mn, alpha);
        finishSM(p0, p1, alpha, l_reg, pa0, pa1, pa2, pa3);
        if (__any(alpha < 1.f)) { if (hi == 0) al_l[r32] = alpha; asm volatile("s_waitcnt lgkmcnt(0)" ::: "memory");
#pragma unroll
            for (int d_ = 0; d_ < 4; ++d_)
#pragma unroll
                for (int r = 0; r < 16; ++r) o[d_][r] *= al_l[crow(r, hi)]; }
        SBAR();
        pv_tile<0>(o, vb0 + bf * SHM_V, pa0, pa1, pa2, pa3);
        if (t + 1 < NT) { VMW(); SWRITE_H(bf ^ 1); }
        __syncthreads();
    }
    if (hi == 0) li_l[r32] = l_reg; asm volatile("s_waitcnt lgkmcnt(0)" ::: "memory");
    float rli[16];
#pragma unroll
    for (int r = 0; r < 16; ++r) { const float lv = li_l[crow(r, hi)]; rli[r] = lv > 0.f ? __builtin_amdgcn_rcpf(lv) : 0.f; }
    bf16_t* Ow = cur.O + (size_t)(wid * QBLK) * LDO;
#pragma unroll
    for (int r = 0; r < 16; ++r) { const int orow = crow(r, hi);
#pragma unroll
        for (int d0 = 0; d0 < 4; ++d0) { const float v = o[d0][r] * rli[r]; const float vn = __shfl_xor(v, 1);
            if ((r32 & 1) == 0) *(unsigned*)(Ow + (size_t)orow * LDO + d0 * 32 + r32) = cvtpk(v, vn); } }
    if (hi == 0) { float* mp = cur.ml + (size_t)(wid * QBLK + r32) * 16; mp[0] = m_reg; mp[1] = l_reg; }
    __syncthreads();
}
#undef VMW
#undef LD8
#undef SLOAD_H
#undef SWRITE_H
#undef STG_IDX
#undef KSWZ
#undef SBAR
}
__device__ __forceinline__ att::Ref attn_ref(const Params& P, int h, int qb, int sp) {
    att::Ref r; const int q0 = qb * 256;
    r.Q = WSP(bf16_t, WS_QB) + (size_t)q0 * 1536 + h * 192; r.K = WSP(bf16_t, WS_KB) + h * 192; r.V = WSP(bf16_t, WS_VB) + h * 128;
    r.O = WSP(bf16_t, WS_OPART) + (size_t)sp * S_ * 1024 + (size_t)q0 * 1024 + h * 128; r.ml = WSP(float, WS_ML) + (size_t)sp * S_ * 16 + ((size_t)q0 * 8 + h) * 2;
    r.P0 = q0; r.j_lo = sp ? 2 * (qb + 1) : 0; r.j_hi = sp ? 4 * (qb + 1) : 2 * (qb + 1); return r;
}
__device__ __forceinline__ void attn_run(const Params& P, int wg, int nwg, int wv, char* lds) {
    const int lane = lane_id_();
    for (int pi = wg; pi < 256; pi += nwg) {
        const int h = pi & 7, j = pi >> 3;
        for (int k = 0; k < 2; ++k) { const att::Ref u = attn_ref(P, h, k ? 31 - j : j, k); att::unit(u, lds, wv, lane); }
    }
}

namespace hg {
typedef short bf16x8 __attribute__((ext_vector_type(8)));
constexpr int RS64 = 144, RS128 = 272;
__device__ __forceinline__ void prep_f(const bf16_t* pr, int col, float lbk, float (&cs)[16], float (&kk)[16]) {
    float run = 0.f;
#pragma unroll
    for (int j = 0; j < 16; ++j) { const float hf = bf2f(pr[(size_t)j * DINP + col]); const float f = lbk + (1.f - lbk) * sigmoidf_(hf); kk[j] = 1.f - f; run += __logf(f); cs[j] = run; }
}
__device__ __forceinline__ void store_iT(const bf16_t* pr, int col, LAS unsigned char* iT, int k, int seg) {
    unsigned w[8];
#pragma unroll
    for (int j = 0; j < 8; ++j) w[j] = (unsigned)pr[(size_t)(2 * j) * DINP + col] | ((unsigned)pr[(size_t)(2 * j + 1) * DINP + col] << 16);
    *(LAS u32x4*)(iT + k * RS64 + seg * 32) = (u32x4){w[0], w[1], w[2], w[3]}; *(LAS u32x4*)(iT + k * RS64 + seg * 32 + 16) = (u32x4){w[4], w[5], w[6], w[7]};
}
__device__ __forceinline__ void h1_unit(const Params& P, int c, int h, LAS unsigned char* lds, int wv, int lane) {
    const int tid = wv * 64 + lane, k = tid & 127, seg = tid >> 7, fr = lane & 15, fq = lane >> 4;
    LAS unsigned char* kbT = lds; LAS unsigned char* iT = lds + 18432; LAS float* segtot = (LAS float*)(lds + 36864);
    const bf16_t* pr = WSP(bf16_t, WS_PROJ) + (size_t)(c * 64 + seg * 16) * DINP;
    float cs[16], kk[16];
    prep_f(pr, PC_HF + h * 128 + k, WSP(float, WS_LB)[h * 128 + k], cs, kk);
    segtot[seg * 128 + k] = cs[15];
    store_iT(pr, PC_HI + h * 128 + k, iT, k, seg);
    __syncthreads();
    float off = 0.f, tot = 0.f;
#pragma unroll
    for (int s2 = 0; s2 < 4; ++s2) { const float v = segtot[s2 * 128 + k]; tot += v; off += (s2 < seg) ? v : 0.f; }
    unsigned w[8];
#pragma unroll
    for (int j = 0; j < 8; ++j) w[j] = pk2(kk[2 * j] * __expf(tot - (off + cs[2 * j])), kk[2 * j + 1] * __expf(tot - (off + cs[2 * j + 1])));
    *(LAS u32x4*)(kbT + k * RS64 + seg * 32) = (u32x4){w[0], w[1], w[2], w[3]}; *(LAS u32x4*)(kbT + k * RS64 + seg * 32 + 16) = (u32x4){w[4], w[5], w[6], w[7]};
    if (seg == 0) WSP(float, WS_DVEC)[(c * 8 + h) * 128 + k] = __expf(tot);
    __syncthreads();
    f32x4 acc[8];
#pragma unroll
    for (int nt = 0; nt < 8; ++nt) acc[nt] = (f32x4){0.f, 0.f, 0.f, 0.f};
#pragma unroll
    for (int ks = 0; ks < 2; ++ks) { const bf16x8 a = *(const LAS bf16x8*)(kbT + (16 * wv + fr) * RS64 + ks * 64 + fq * 16);
#pragma unroll
        for (int nt = 0; nt < 8; ++nt) { const bf16x8 b = *(const LAS bf16x8*)(iT + (16 * nt + fr) * RS64 + ks * 64 + fq * 16);
            acc[nt] = __builtin_amdgcn_mfma_f32_16x16x32_bf16(a, b, acc[nt], 0, 0, 0); } }
    bf16_t* Lst = WSP(bf16_t, WS_LST) + (size_t)(c * 8 + h) * 16384;
#pragma unroll
    for (int nt = 0; nt < 8; ++nt) st_bf4(Lst + (16 * nt + fr) * 128 + 16 * wv + 4 * fq, acc[nt]);
    __syncthreads();
}
__device__ __forceinline__ void scan_run(const Params& P, int wg, int nwg, int wv) {
    const bf16_t* Lst = WSP(bf16_t, WS_LST); bf16_t* Sst = WSP(bf16_t, WS_SST); const float* dvec = WSP(float, WS_DVEC);
    for (int e = wg * 512 + wv * 64 + lane_id_(); e < 8 * 16384; e += nwg * 512) {
        const int h = e >> 14, k = e & 127; float S = 0.f;
#pragma unroll 8
        for (int c = 0; c < 128; ++c) { const float L = bf2f(Lst[(size_t)c * 131072 + e]); const float d = dvec[(c * 8 + h) * 128 + k];
            Sst[(size_t)c * 131072 + e] = (bf16_t)f2bf(S); S = d * S + L; }
    }
}
__device__ __forceinline__ void h3_unit(const Params& P, int c, int h, LAS unsigned char* lds, int wv, int lane) {
    const int tid = wv * 64 + lane, k = tid & 127, seg = tid >> 7, fr = lane & 15, fq = lane >> 4;
    LAS unsigned char* qbL = lds; LAS unsigned char* kiL = lds + 17408; LAS unsigned char* iT = lds + 34816; LAS unsigned char* Am = lds + 53248;
    LAS float* segtot = (LAS float*)(lds + 62464); LAS float* rowss = (LAS float*)(lds + 64512);
    const bf16_t* pr = WSP(bf16_t, WS_PROJ) + (size_t)(c * 64 + seg * 16) * DINP;
    float cs[16], kk[16];
    prep_f(pr, PC_HF + h * 128 + k, WSP(float, WS_LB)[h * 128 + k], cs, kk);
    segtot[seg * 128 + k] = cs[15];
    store_iT(pr, PC_HI + h * 128 + k, iT, k, seg);
    __syncthreads();
    float off = 0.f;
#pragma unroll
    for (int s2 = 0; s2 < 4; ++s2) { const float v = segtot[s2 * 128 + k]; off += (s2 < seg) ? v : 0.f; }
#pragma unroll
    for (int j = 0; j < 16; ++j) { const float b = off + cs[j]; const float q = siluf_(bf2f(pr[(size_t)j * DINP + PC_HQ + h * 128 + k]));
        *(LAS bf16_t*)(qbL + (seg * 16 + j) * RS128 + k * 2) = (bf16_t)f2bf(q * __expf(b));
        *(LAS bf16_t*)(kiL + (seg * 16 + j) * RS128 + k * 2) = (bf16_t)f2bf(kk[j] * __expf(fminf(-b, 80.f))); }
    __syncthreads();
    { const int mt = wv >> 1;
#pragma unroll
      for (int q = 0; q < 2; ++q) { const int nt = (wv & 1) * 2 + q; f32x4 acc = {0.f, 0.f, 0.f, 0.f};
          if (nt <= mt) {
#pragma unroll
              for (int ks = 0; ks < 4; ++ks) { const bf16x8 a = *(const LAS bf16x8*)(qbL + (16 * mt + fr) * RS128 + ks * 64 + fq * 16);
                  const bf16x8 b = *(const LAS bf16x8*)(kiL + (16 * nt + fr) * RS128 + ks * 64 + fq * 16);
                  acc = __builtin_amdgcn_mfma_f32_16x16x32_bf16(a, b, acc, 0, 0, 0); } }
          const int s_ = 16 * nt + fr;
#pragma unroll
          for (int r = 0; r < 4; ++r) { const int t_ = 16 * mt + 4 * fq + r; *(LAS bf16_t*)(Am + t_ * RS64 + s_ * 2) = (bf16_t)f2bf(s_ <= t_ ? acc[r] : 0.f); } } }
    __syncthreads();
    const int mt = wv & 3, ntb = (wv >> 2) * 4;
    f32x4 acc[4];
#pragma unroll
    for (int q = 0; q < 4; ++q) acc[q] = (f32x4){0.f, 0.f, 0.f, 0.f};
#pragma unroll
    for (int ks = 0; ks < 2; ++ks) { const bf16x8 a = *(const LAS bf16x8*)(Am + (16 * mt + fr) * RS64 + ks * 64 + fq * 16);
#pragma unroll
        for (int q = 0; q < 4; ++q) { const bf16x8 b = *(const LAS bf16x8*)(iT + (16 * (ntb + q) + fr) * RS64 + ks * 64 + fq * 16);
            acc[q] = __builtin_amdgcn_mfma_f32_16x16x32_bf16(a, b, acc[q], 0, 0, 0); } }
    const bf16_t* Sst = WSP(bf16_t, WS_SST) + (size_t)(c * 8 + h) * 16384;
#pragma unroll
    for (int ks = 0; ks < 4; ++ks) { const bf16x8 a = *(const LAS bf16x8*)(qbL + (16 * mt + fr) * RS128 + ks * 64 + fq * 16);
#pragma unroll
        for (int q = 0; q < 4; ++q) { const bf16x8 b = *(const bf16x8*)(Sst + (16 * (ntb + q) + fr) * 128 + ks * 32 + fq * 8);
            acc[q] = __builtin_amdgcn_mfma_f32_16x16x32_bf16(a, b, acc[q], 0, 0, 0); } }
    float ss[4];
#pragma unroll
    for (int r = 0; r < 4; ++r) { float v = 0.f;
#pragma unroll
        for (int q = 0; q < 4; ++q) v += acc[q][r] * acc[q][r];
        v += __shfl_xor(v, 1); v += __shfl_xor(v, 2); v += __shfl_xor(v, 4); v += __shfl_xor(v, 8); ss[r] = v; }
    if (fr == 0) {
#pragma unroll
        for (int r = 0; r < 4; ++r) rowss[(wv >> 2) * 64 + 16 * mt + 4 * fq + r] = ss[r]; }
    __syncthreads();
    bf16_t* ymix = WSP(bf16_t, WS_YMIX); const bf16_t* prow = WSP(bf16_t, WS_PROJ);
#pragma unroll
    for (int r = 0; r < 4; ++r) { const int t_ = 16 * mt + 4 * fq + r; const float rs = 1.f / sqrtf((rowss[t_] + rowss[64 + t_]) * (1.f / 128.f) + EPS);
        const size_t row = (size_t)(c * 64 + t_);
#pragma unroll
        for (int q = 0; q < 4; ++q) { const int v_ = 16 * (ntb + q) + fr; const float g = bf2f(prow[row * DINP + PC_HG + h * 128 + v_]);
            ymix[row * D_ + 1024 + h * 128 + v_] = (bf16_t)f2bf(acc[q][r] * rs * siluf_(g)); } }
    __syncthreads();
}
__device__ __forceinline__ void h1_run(const Params& P, int wg, int nwg, int wv, LAS unsigned char* lds) { const int lane = lane_id_(); for (int u = wg; u < 1024; u += nwg) h1_unit(P, u >> 3, u & 7, lds, wv, lane); }
__device__ __forceinline__ void h3_run(const Params& P, int wg, int nwg, int wv, LAS unsigned char* lds) { const int lane = lane_id_(); for (int u = wg; u < 1024; u += nwg) h3_unit(P, u >> 3, u & 7, lds, wv, lane); }
}

__device__ __forceinline__ void route_mfma_run(const Params& P, int wg, int nwg, int wv, LAS unsigned char* lds) {
    const int lane = lane_id_(), r = lane & 15, g = lane >> 4, tt = wv & 1, kq = wv >> 1;
    LAS float* part = (LAS float*)lds;
    const float* h1 = P.out; const f32x4* WrF = WSP(f32x4, WS_WR); const float* part1 = WSP(float, WS_PART1);
    int* cnt = WSP(int, WS_CTL); int* list = WSP(int, WS_LIST); int* eid = WSP(int, WS_EID); float* ew = WSP(float, WS_EW); float* rstd1 = WSP(float, WS_RSTD1);
    for (int tb = wg; tb < S_ / 32; tb += nwg) {
        const float* arow = h1 + (size_t)(tb * 32 + tt * 16 + r) * D_ + kq * 512 + 4 * g;
        const f32x4* wf = WrF + (size_t)(kq * 32) * 5 * 64 + lane;
        f32x4 acc[5];
#pragma unroll
        for (int t5 = 0; t5 < 5; ++t5) acc[t5] = (f32x4){0.f, 0.f, 0.f, 0.f};
#pragma unroll 2
        for (int kb = 0; kb < 32; ++kb) { const f32x4 a = *(const f32x4*)(arow + kb * 16);
#pragma unroll
            for (int t5 = 0; t5 < 5; ++t5) { const f32x4 b = wf[(kb * 5 + t5) * 64];
                acc[t5] = __builtin_amdgcn_mfma_f32_16x16x4f32(a.x, b.x, acc[t5], 0, 0, 0); acc[t5] = __builtin_amdgcn_mfma_f32_16x16x4f32(a.y, b.y, acc[t5], 0, 0, 0);
                acc[t5] = __builtin_amdgcn_mfma_f32_16x16x4f32(a.z, b.z, acc[t5], 0, 0, 0); acc[t5] = __builtin_amdgcn_mfma_f32_16x16x4f32(a.w, b.w, acc[t5], 0, 0, 0); } }
#pragma unroll
        for (int t5 = 0; t5 < 5; ++t5)
#pragma unroll
            for (int q = 0; q < 4; ++q) part[wv * 1280 + (4 * g + q) * 80 + 16 * t5 + r] = acc[t5][q];
        __syncthreads();
        if (wv == 0 && lane < 32) {
            const int t = tb * 32 + lane, t2 = lane >> 4, tr = lane & 15; const LAS float* pp = part + t2 * 1280 + tr * 80;
#define LG(j) ((pp[(j)] + pp[2560 + (j)]) + (pp[5120 + (j)] + pp[7680 + (j)]))
            float ss = 0.f; { const f32x4* p4 = (const f32x4*)(part1 + (size_t)t * 32);
#pragma unroll
                for (int i = 0; i < 8; ++i) { const f32x4 v = p4[i]; ss += (v.x + v.y) + (v.z + v.w); } }
            const float rs = 1.f / sqrtf(ss * (1.f / D_) + EPS);
            rstd1[t] = rs;
            int gi = 0; float gm = -INFINITY;
            for (int i = 0; i < 8; ++i) { const float v = LG(i) * rs + P.b_rg[i]; if (v > gm) { gm = v; gi = i; } }
            float gs = 0.f; for (int i = 0; i < 8; ++i) gs += expf(LG(i) * rs + P.b_rg[i] - gm);
            const float gw_ = 1.f / gs;
            int i1 = 0, i2 = 0; float l1 = -INFINITY, l2 = -INFINITY;
            for (int i = 0; i < 8; ++i) { const float e = LG(8 + gi * 8 + i) * rs + P.b_re[gi * 8 + i];
                if (e > l1) { l2 = l1; i2 = i1; l1 = e; i1 = i; } else if (e > l2) { l2 = e; i2 = i; } }
#undef LG
            const float p2 = expf(l2 - l1), w1 = gw_ / (1.f + p2), w2 = gw_ * p2 / (1.f + p2);
            const int e1 = gi * 8 + i1, e2 = gi * 8 + i2;
            eid[2 * t] = e1; eid[2 * t + 1] = e2; ew[2 * t] = w1; ew[2 * t + 1] = w2;
            const int p1 = atomicAdd(&cnt[e1], 1); list[e1 * LISTCAP + p1] = 2 * t;
            const int q2 = atomicAdd(&cnt[e2], 1); list[e2 * LISTCAP + q2] = 2 * t + 1;
        }
        __syncthreads();
    }
}

constexpr int LDS_TAB = 131072;
__device__ __forceinline__ int moe_build_tab(const int* cnt, LAS unsigned char* lds, int wv) {
    LAS int* tab = (LAS int*)(lds + LDS_TAB);
    if (wv == 0 && lane_id_() == 0) { int nt = 0;
        for (int e = 0; e < NE; ++e) { const int n = cnt[e]; for (int r = 0; r * 256 < n; ++r) { tab[1 + nt] = e; tab[129 + nt] = r; ++nt; } }
        tab[0] = nt; }
    __syncthreads();
    return __builtin_amdgcn_readfirstlane(tab[0]);
}
struct MoeOrder {
    const int* cnt; const int* list; LAS const int* tab; int ntiles, npn, G, c; const char* A; const char* B; size_t bexp, btile, atile; bool gather;
    __device__ __forceinline__ bool next(int i, pg8::Unit& u) const {
        const int L = i * G + c; if (L >= ntiles * npn) return false;
        const int tile = L / npn, pn = L - tile * npn;
        const int e = __builtin_amdgcn_readfirstlane(tab[1 + tile]), rt = __builtin_amdgcn_readfirstlane(tab[129 + tile]);
        u.pm = tile; u.pn = pn; u.x0 = e; u.x1 = rt * 256; u.x2 = __builtin_amdgcn_readfirstlane(cnt[e]);
        u.b = B + (size_t)e * bexp + (size_t)pn * btile; u.a = gather ? A : A + (size_t)tile * atile; return true;
    }
    __device__ __forceinline__ unsigned row_off(const pg8::Unit& u, int R) const { int idx = u.x1 + R; idx = idx < u.x2 ? idx : 0; return (unsigned)(list[u.x0 * LISTCAP + idx] >> 1) * (unsigned)(D_ * 2); }
};
struct MoeUpEpi { const int* list; const float* rstd1; bf16_t* hmid;
    __device__ __forceinline__ void operator()(const f32x4 (&acc)[2][2][4][2], const pg8::Unit& u, int wr, int wc, int fr, int fq) const {
#pragma unroll
        for (int ai = 0; ai < 2; ++ai)
#pragma unroll
            for (int m = 0; m < 4; ++m) { const int r = ai * 128 + wr * 64 + m * 16 + fr; int idx = u.x1 + r; idx = idx < u.x2 ? idx : 0;
                const float rs = rstd1[list[u.x0 * LISTCAP + idx] >> 1];
#pragma unroll
                for (int n = 0; n < 2; ++n) { const f32x4 g = acc[ai][0][m][n] * rs, up = acc[ai][1][m][n] * rs;
                    const f32x4 h = {siluf_(g.x) * up.x, siluf_(g.y) * up.y, siluf_(g.z) * up.z, siluf_(g.w) * up.w};
                    st_bf4(hmid + (size_t)(u.pm * 256 + r) * DE + u.pn * 128 + wc * 32 + n * 16 + fq * 4, h); }
                asm volatile("" ::: "memory"); }
    } };
struct MoeDownEpi { const int* list; const float* ew; bf16_t* y;
    __device__ __forceinline__ void operator()(const f32x4 (&acc)[2][2][4][2], const pg8::Unit& u, int wr, int wc, int fr, int fq) const {
#pragma unroll
        for (int ai = 0; ai < 2; ++ai)
#pragma unroll
            for (int m = 0; m < 4; ++m) { const int r = ai * 128 + wr * 64 + m * 16 + fr; const int idx = u.x1 + r; const bool valid = idx < u.x2;
                const int a = list[u.x0 * LISTCAP + (valid ? idx : 0)]; const float w = ew[a];
                if (valid) {
#pragma unroll
                    for (int bj = 0; bj < 2; ++bj)
#pragma unroll
                        for (int n = 0; n < 2; ++n) st_bf4(y + (size_t)a * D_ + u.pn * 256 + bj * 128 + wc * 32 + n * 16 + fq * 4, acc[ai][bj][m][n] * w); }
                asm volatile("" ::: "memory"); }
    } };
__device__ __forceinline__ void moe_up_run(const Params& P, int wg, int nwg, int wv, LAS unsigned char* lds) {
    const int nt = moe_build_tab(WSP(int, WS_CTL), lds, wv);
    MoeOrder S{WSP(int, WS_CTL), WSP(int, WS_LIST), (LAS const int*)(lds + LDS_TAB), nt, 4, nwg, wg, (const char*)WSP(bf16_t, WS_H1B), (const char*)WSP(bf16_t, WS_WGU), (size_t)1024 * 2048 * 2, (size_t)256 * 2048 * 2, 0, true};
    MoeUpEpi E{WSP(int, WS_LIST), WSP(float, WS_RSTD1), WSP(bf16_t, WS_HMID)};
    int K = D_, lda = D_; asm volatile("" : "+s"(K), "+s"(lda));
    pg8::gemm_phase<MoeUpEpi, MoeOrder, true>(lds, K, lda, S, E, wv);
}
__device__ __forceinline__ void moe_down_run(const Params& P, int wg, int nwg, int wv, LAS unsigned char* lds) {
    const int nt = moe_build_tab(WSP(int, WS_CTL), lds, wv);
    MoeOrder S{WSP(int, WS_CTL), WSP(int, WS_LIST), (LAS const int*)(lds + LDS_TAB), nt, 8, nwg, wg, (const char*)WSP(bf16_t, WS_HMID), (const char*)WSP(bf16_t, WS_WD), (size_t)2048 * DE * 2, (size_t)256 * DE * 2, (size_t)256 * DE * 2, false};
    MoeDownEpi E{WSP(int, WS_LIST), WSP(float, WS_EW), WSP(bf16_t, WS_Y)};
    int K = DE, lda = DE; asm volatile("" : "+s"(K), "+s"(lda));
    pg8::gemm_phase<MoeDownEpi, MoeOrder, false>(lds, K, lda, S, E, wv);
}

namespace cg = cooperative_groups;
constexpr int LDS_BYTES = 147456;
constexpr int NPHASE = 12;
#ifndef DUP_PHASE
#define DUP_PHASE -1
#endif
#ifndef MK_MULTI
#define MK_MULTI 0
#endif
__global__ void __launch_bounds__(512, 2) mk_fwd(Params P, int ph_lo, int ph_hi) {
    extern __shared__ __attribute__((aligned(16))) unsigned char lds_raw[];
    LAS unsigned char* lds = (LAS unsigned char*)lds_raw;
    const int wg = blockIdx.x, nwg = gridDim.x, wv = __builtin_amdgcn_readfirstlane(threadIdx_x_raw() >> 6);
#define PH(k) if (ph_lo <= (k) && (k) < ph_hi) for (int rep_ = 0; rep_ < ((k) == DUP_PHASE ? 2 : 1); ++rep_)
#define SEAM(k) do { if ((k) + 1 < ph_hi) cg::this_grid().sync(); } while (0)
    PH(0) { p0_run(P, wg, nwg, wv, lds); SEAM(0); }
    PH(1) { dense_gemm(lds, WSP(bf16_t, WS_XB), D_, WSP(bf16_t, WS_WIN), S_, DINP, D_, PFProj{WSP(bf16_t, WS_PROJ), WSP(float, WS_RSTDX), WSP(float, WS_PARTQ)}, wg, nwg, wv);
            dense_gemm(lds, WSP(bf16_t, WS_PB), PLE, WSP(bf16_t, WS_WPP), S_, D_, PLE, PFPP{WSP(bf16_t, WS_PP)}, wg, nwg, wv); SEAM(1); }
    PH(2) { dense_gemm(lds, WSP(bf16_t, WS_PROJ) + PC_CQ, DINP, WSP(bf16_t, WS_WUQ), S_, 1536, 512, PFQ{WSP(bf16_t, WS_QB), WSP(float, WS_PARTQ), WSP(float, WS_COS), WSP(float, WS_SIN)}, wg, nwg, wv);
            dense_gemm(lds, WSP(bf16_t, WS_PROJ) + PC_CKV, DINP, WSP(bf16_t, WS_WUKV), S_, 2048, 256, PFKV{WSP(bf16_t, WS_KB), WSP(bf16_t, WS_VB), WSP(float, WS_PARTQ)}, wg, nwg, wv);
            kpe_run(P, wg, nwg, wv); hg::h1_run(P, wg, nwg, wv, lds); SEAM(2); }
    PH(3) { hg::scan_run(P, wg, nwg, wv); attn_run(P, wg, nwg, wv, (char*)lds_raw); SEAM(3); }
    PH(4) { combine_run(P, wg, nwg, wv); hg::h3_run(P, wg, nwg, wv, lds); SEAM(4); }
    PH(5) { dense_gemm(lds, WSP(bf16_t, WS_YMIX), D_, WSP(bf16_t, WS_WOUT), S_, D_, D_, PFOut{P.x, P.out, WSP(bf16_t, WS_H1B), WSP(float, WS_PART1)}, wg, nwg, wv); SEAM(5); }
    PH(6) { route_mfma_run(P, wg, nwg, wv, lds); SEAM(6); }
    PH(7) { moe_up_run(P, wg, nwg, wv, lds); SEAM(7); }
    PH(8) { moe_down_run(P, wg, nwg, wv, lds); SEAM(8); }
    PH(9) { moe_combine_run(P, wg, nwg, wv); SEAM(9); }
    PH(10) { dense_gemm(lds, WSP(bf16_t, WS_H2B), D_, WSP(bf16_t, WS_WPG), S_, D_, D_, PFPle{P.out, WSP(bf16_t, WS_PP), WSP(float, WS_RSTD2), P.b_pg, WSP(float, WS_PART3)}, wg, nwg, wv); SEAM(10); }
    PH(11) { final_run(P, wg, nwg, wv); }
#undef PH
#undef SEAM
}

extern "C" void kernel_launch(void* const* d_in, const int* in_sizes, int n_in, void* d_out, int out_size, void* d_ws, size_t ws_size, hipStream_t stream) {
    if (n_in != 26 || ws_size < WS_END) { fprintf(stderr, "kernel_launch: unexpected n_in %d or ws_size %zu (< %zu)\n", n_in, ws_size, (size_t)WS_END); return; }
    static int grid = 0;
    if (grid == 0) {
        int dev = 0, cus = 0, per_cu = 0;
        (void)hipGetDevice(&dev); (void)hipDeviceGetAttribute(&cus, hipDeviceAttributeMultiprocessorCount, dev);
        (void)hipFuncSetAttribute((const void*)mk_fwd, hipFuncAttributeMaxDynamicSharedMemorySize, LDS_BYTES);
        if (hipOccupancyMaxActiveBlocksPerMultiprocessor(&per_cu, (const void*)mk_fwd, 512, LDS_BYTES) != hipSuccess || per_cu < 1) { fprintf(stderr, "kernel_launch: occupancy query says %d blocks/CU\n", per_cu); per_cu = 1; }
        (void)hipGetLastError();
        grid = cus > 0 ? cus : 256;
    }
    Params P{};
    P.x = (const float*)d_in[0]; P.p = (const float*)d_in[1]; P.pos = (const int*)d_in[2];
    P.attn_norm = (const float*)d_in[3]; P.w_in = (const float*)d_in[4]; P.q_norm = (const float*)d_in[5]; P.w_uq = (const float*)d_in[6];
    P.kv_norm = (const float*)d_in[7]; P.w_ukv = (const float*)d_in[8]; P.mla_norm = (const float*)d_in[9]; P.lb_logits = (const float*)d_in[10];
    P.hg_norm = (const float*)d_in[11]; P.w_out = (const float*)d_in[12]; P.ffn_norm = (const float*)d_in[13];
    P.w_rg = (const float*)d_in[14]; P.b_rg = (const float*)d_in[15]; P.w_re = (const float*)d_in[16]; P.b_re = (const float*)d_in[17];
    P.w_eg = (const float*)d_in[18]; P.w_eu = (const float*)d_in[19]; P.w_ed = (const float*)d_in[20];
    P.ple_norm = (const float*)d_in[21]; P.w_pg = (const float*)d_in[22]; P.b_pg = (const float*)d_in[23]; P.w_pp = (const float*)d_in[24]; P.final_norm = (const float*)d_in[25];
    P.out = (float*)d_out; P.ws = (unsigned char*)d_ws;
    (void)hipMemsetAsync((char*)d_ws + WS_CTL, 0, 1 * MiB, stream);
#if MK_MULTI
    for (int ph = 0; ph < NPHASE; ++ph) hipLaunchKernelGGL(mk_fwd, dim3(grid), dim3(512), LDS_BYTES, stream, P, ph, ph + 1);
#else
    int lo = 0, hi = NPHASE; void* args[] = {&P, &lo, &hi};
    hipError_t e = hipLaunchCooperativeKernel((const void*)mk_fwd, dim3(grid), dim3(512), args, LDS_BYTES, stream);
    if (e != hipSuccess) fprintf(stderr, "kernel_launch: cooperative launch failed: %s (grid %d)\n", hipGetErrorString(e), grid);
#endif
}
```

```cpp
#include <hip/hip_runtime.h>
#include <hip/hip_cooperative_groups.h>
#include <cstdint>
#include <cstdio>

#define LAS __attribute__((address_space(3)))
typedef unsigned short bf16_t;
typedef float f32x4 __attribute__((ext_vector_type(4)));
typedef unsigned u32x4 __attribute__((ext_vector_type(4)));
typedef unsigned u32x2 __attribute__((ext_vector_type(2)));

constexpr int S_ = 8192, D_ = 2048, DIN = 4928, DINP = 5120;
constexpr int NH = 8, QKD = 192, VD = 128;
constexpr int NE = 64, DE = 512, PLE = 256;
constexpr float EPS = 1e-6f;
constexpr float QSCALE = 0.07216878364870323f * 1.4426950408889634f;
constexpr int PC_CQ = 0, PC_CKV = 512, PC_HQ = 768, PC_HF = 1792, PC_HI = 2816, PC_HG = 3840, PC_KPE = 4864;
constexpr int LISTCAP = 8192;

constexpr size_t MiB = 1u << 20;
constexpr size_t WS_CTL = 0;
constexpr size_t WS_RSTDX = 1 * MiB, WS_RSTD1 = WS_RSTDX + 32768, WS_RSTD2 = WS_RSTD1 + 32768, WS_LB = WS_RSTD2 + 32768, WS_TILEB = WS_LB + 4096;
constexpr size_t WS_COS = 2 * MiB, WS_SIN = 3 * MiB, WS_PARTQ = 4 * MiB, WS_PART1 = 5 * MiB, WS_PART3 = 6 * MiB, WS_WR = 7 * MiB;
constexpr size_t WS_ML = 8 * MiB, WS_DVEC = 9 * MiB, WS_EID = 10 * MiB, WS_EW = WS_EID + 65536, WS_LIST = 11 * MiB;
constexpr size_t WS_WUQ = 16 * MiB, WS_WUKV = 18 * MiB, WS_WPP = 19 * MiB, WS_WIN = 20 * MiB, WS_WOUT = 40 * MiB, WS_WPG = 48 * MiB;
constexpr size_t WS_PB = 56 * MiB, WS_XB = 64 * MiB, WS_PROJ = 96 * MiB, WS_PP = 176 * MiB, WS_QB = 208 * MiB, WS_KB = 232 * MiB, WS_VB = 256 * MiB;
constexpr size_t WS_LST = 272 * MiB, WS_SST = 304 * MiB, WS_OPART = 336 * MiB, WS_YMIX = 368 * MiB, WS_H1B = 400 * MiB, WS_H2B = 432 * MiB;
constexpr size_t WS_HMID = 464 * MiB, WS_Y = 496 * MiB, WS_WGU = 560 * MiB, WS_WD = 816 * MiB, WS_END = 944 * MiB;

struct Params {
    const float *x, *p; const int* pos;
    const float *attn_norm, *w_in, *q_norm, *w_uq, *kv_norm, *w_ukv, *mla_norm, *lb_logits, *hg_norm, *w_out, *ffn_norm;
    const float *w_rg, *b_rg, *w_re, *b_re, *w_eg, *w_eu, *w_ed, *ple_norm, *w_pg, *b_pg, *w_pp, *final_norm;
    float* out; unsigned char* ws;
};
#define WSP(T, off) ((T*)(P.ws + (off)))

__device__ __forceinline__ unsigned f2bf(float f) { unsigned u = __builtin_bit_cast(unsigned, f); return (u + 0x7fffu + ((u >> 16) & 1u)) >> 16; }
__device__ __forceinline__ float bf2f(unsigned h) { return __builtin_bit_cast(float, h << 16); }
typedef float f32x2_t __attribute__((ext_vector_type(2))); typedef __bf16 bf16x2_t __attribute__((ext_vector_type(2)));
__device__ __forceinline__ unsigned pk2(float lo, float hi) { f32x2_t v = {lo, hi}; bf16x2_t b = __builtin_convertvector(v, bf16x2_t); return __builtin_bit_cast(unsigned, b); }
__device__ __forceinline__ float wave_sum(float v) {
#pragma unroll
    for (int o = 1; o < 64; o <<= 1) v += __shfl_xor(v, o);
    return v;
}
__device__ __forceinline__ int lane_id_() { return (int)__builtin_amdgcn_mbcnt_hi(~0u, __builtin_amdgcn_mbcnt_lo(~0u, 0u)); }
__device__ __forceinline__ int threadIdx_x_raw() { return (int)__builtin_amdgcn_workitem_id_x(); }
#define TIDX (wv * 64 + lane_id_())
__device__ __forceinline__ float sigmoidf_(float x) { return 1.f / (1.f + __expf(-x)); }
__device__ __forceinline__ float siluf_(float x) { return x / (1.f + __expf(-x)); }

#ifndef XPROBE
#define XPROBE 0
#endif
#ifndef P0_EXPERTS
#define P0_EXPERTS 0
#endif
#ifndef DUP_P0
#define DUP_P0 0
#endif
struct SrcWin { const float* W; const float* g;
    __device__ __forceinline__ float operator()(int k, int n) const {
        int src;
        if (n < 768) src = n;
        else if (n < 4864) src = n + 64;
        else if (n < 4928) { const int j = n - 4864; src = 768 + ((j & 1) ? 32 + (j >> 1) : (j >> 1)); }
        else return 0.f;
        return W[(size_t)k * DIN + src] * g[k];
    } };
struct SrcWuq { const float* W; const float* g;
    __device__ __forceinline__ float operator()(int k, int n) const {
        int src;
        if (n < 1024) src = (n >> 7) * 192 + (n & 127);
        else { const int r = n - 1024, h = r >> 6, j = r & 63; src = h * 192 + 128 + ((j & 1) ? 32 + (j >> 1) : (j >> 1)); }
        return W[(size_t)k * 1536 + src] * g[k];
    } };
struct SrcWukv { const float* W; const float* g;
    __device__ __forceinline__ float operator()(int k, int n) const {
        int src;
        if (n < 1024) src = (n >> 7) * 256 + (n & 127);
        else { const int r = n - 1024; src = (r >> 7) * 256 + 128 + (r & 127); }
        return W[(size_t)k * 2048 + src] * g[k];
    } };
struct SrcWout { const float* W; const float* g0; const float* g1;
    __device__ __forceinline__ float operator()(int k, int n) const { return W[(size_t)k * 2048 + n] * (k < 1024 ? g0[k] : g1[k - 1024]); } };
struct SrcPlain { const float* W; const float* g; int N;
    __device__ __forceinline__ float operator()(int k, int n) const { const float w = W[(size_t)k * N + n]; return g ? w * g[k] : w; } };
struct SrcGU { const float* W; const float* g;
    __device__ __forceinline__ float operator()(int k, int n) const { return W[(size_t)k * DE + 128 * (n >> 8) + (n & 127)] * g[k]; } };

template <class Src>
__device__ __forceinline__ void tconv_item(const Src& src, int K, int nblk, bf16_t* WT, LAS unsigned char* scr, int item, int lane) {
    const int kb = item / nblk, nb = item % nblk, k0 = 64 * kb, n0 = 64 * nb;
    float v[64];
#pragma unroll
    for (int i = 0; i < 64; ++i) v[i] = src(k0 + i, n0 + lane);
#pragma unroll
    for (int j = 0; j < 8; ++j) { u32x4 w; w.x = pk2(v[8 * j], v[8 * j + 1]); w.y = pk2(v[8 * j + 2], v[8 * j + 3]); w.z = pk2(v[8 * j + 4], v[8 * j + 5]); w.w = pk2(v[8 * j + 6], v[8 * j + 7]);
        *(LAS u32x4*)(scr + lane * 144 + j * 16) = w; }
    asm volatile("s_waitcnt lgkmcnt(0)" ::: "memory");
#pragma unroll
    for (int i = 0; i < 8; ++i) { const int n = 8 * i + (lane >> 3), c = lane & 7;
        *(u32x4*)(WT + (size_t)(n0 + n) * K + k0 + 8 * c) = *(const LAS u32x4*)(scr + n * 144 + c * 16); }
    asm volatile("s_waitcnt lgkmcnt(0)" ::: "memory");
}

__device__ __forceinline__ void p0_run(const Params& P, int wg, int nwg, int wv, LAS unsigned char* lds) {
    const int tid = TIDX, lane = tid & 63, wave = tid >> 6;
    const int gw = wg * 8 + wave, NGW = nwg * 8;
    LAS unsigned char* scr = lds + wave * 9216;
    constexpr int I_WIN = 32 * 80, I_WUQ = 8 * 24, I_WUKV = 4 * 32, I_WOUT = 32 * 32, I_WPG = 32 * 32, I_WPP = 4 * 32, I_GU = 32 * 16, I_DN = 8 * 32;
    constexpr int NITEMS = I_WIN + I_WUQ + I_WUKV + I_WOUT + I_WPG + I_WPP + (P0_EXPERTS ? NE * I_GU + NE * I_DN : 0);
    for (int rp_ = 0; rp_ < (DUP_P0 == 1 ? 2 : 1); ++rp_)
    for (int it = gw; it < NITEMS; it += NGW) {
        int r = it;
        if (r < I_WIN) { tconv_item(SrcWin{P.w_in, P.attn_norm}, 2048, 80, WSP(bf16_t, WS_WIN), scr, r, lane); continue; } r -= I_WIN;
        if (r < I_WUQ) { tconv_item(SrcWuq{P.w_uq, P.q_norm}, 512, 24, WSP(bf16_t, WS_WUQ), scr, r, lane); continue; } r -= I_WUQ;
        if (r < I_WUKV) { tconv_item(SrcWukv{P.w_ukv, P.kv_norm}, 256, 32, WSP(bf16_t, WS_WUKV), scr, r, lane); continue; } r -= I_WUKV;
        if (r < I_WOUT) { if (nwg != 256) tconv_item(SrcWout{P.w_out, P.mla_norm, P.hg_norm}, 2048, 32, WSP(bf16_t, WS_WOUT), scr, r, lane); continue; } r -= I_WOUT;
        if (r < I_WPG) { if (nwg != 256) tconv_item(SrcPlain{P.w_pg, P.ple_norm, 2048}, 2048, 32, WSP(bf16_t, WS_WPG), scr, r, lane); continue; } r -= I_WPG;
        if (r < I_WPP) { tconv_item(SrcPlain{P.w_pp, nullptr, 2048}, 256, 32, WSP(bf16_t, WS_WPP), scr, r, lane); continue; } r -= I_WPP;
        if (r < NE * I_GU) { const int e = r / I_GU; r -= e * I_GU;
            const bool isup = (((r % 16) * 64) & 255) >= 128;
            const float* Wsel = isup ? P.w_eu : P.w_eg;
            tconv_item(SrcGU{Wsel + (size_t)e * 2048 * DE, P.ffn_norm}, 2048, 16, WSP(bf16_t, WS_WGU) + (size_t)e * 1024 * 2048, scr, r, lane); continue; }
        r -= NE * I_GU;
        { const int e = r / I_DN; r -= e * I_DN;
          tconv_item(SrcPlain{P.w_ed + (size_t)e * DE * 2048, nullptr, 2048}, DE, 32, WSP(bf16_t, WS_WD) + (size_t)e * 2048 * DE, scr, r, lane); }
    }
    for (int rp_ = 0; rp_ < (DUP_P0 == 2 ? 2 : 1); ++rp_)
    for (int m = gw; m < S_; m += NGW) {
        const f32x4* xr = (const f32x4*)(P.x + (size_t)m * D_) + lane; f32x4 v[8]; float s = 0.f;
#pragma unroll
        for (int j = 0; j < 8; ++j) { v[j] = xr[64 * j]; s += (v[j].x * v[j].x + v[j].y * v[j].y) + (v[j].z * v[j].z + v[j].w * v[j].w); }
        s = wave_sum(s);
        if (lane == 0) WSP(float, WS_RSTDX)[m] = 1.f / sqrtf(s * (1.f / D_) + EPS);
        u32x2* o = (u32x2*)(WSP(bf16_t, WS_XB) + (size_t)m * D_) + lane;
#pragma unroll
        for (int j = 0; j < 8; ++j) { u32x2 w; w.x = pk2(v[j].x, v[j].y); w.y = pk2(v[j].z, v[j].w); o[64 * j] = w; }
    }
    const int gt = wg * 512 + tid, NGT = nwg * 512;
    for (int i = gt; i < S_ * PLE / 4; i += NGT) { const f32x4 v = ((const f32x4*)P.p)[i]; u32x2 w; w.x = pk2(v.x, v.y); w.y = pk2(v.z, v.w); WSP(u32x2, WS_PB)[i] = w; }
    for (int i = gt; i < S_ * 32; i += NGT) { const int s = i >> 5, j = i & 31;
        const float invf = exp2f(-(float)j * (13.287712379549449f / 32.0f));
        const double tr = (double)P.pos[s] * (double)invf * 0.15915494309189535;
        const float fr = (float)(tr - floor(tr));
        WSP(float, WS_COS)[i] = __builtin_amdgcn_cosf(fr); WSP(float, WS_SIN)[i] = __builtin_amdgcn_sinf(fr); }
    for (int i = gt; i < 1024; i += NGT) WSP(float, WS_LB)[i] = 1.f / (1.f + expf(P.lb_logits[1024 + i] - P.lb_logits[i]));
    for (int i = gt; i < 2048 * 80; i += NGT) {
        const int s4 = i & 3, ln = (i >> 2) & 63, tl = (i >> 8) % 5, k16 = (i >> 8) / 5; const int k = 16 * k16 + 4 * (ln >> 4) + s4, c = 16 * tl + (ln & 15);
        float w = 0.f; if (c < 8) w = P.w_rg[k * 8 + c]; else if (c < 72) w = P.w_re[k * 64 + (c - 8)];
        WSP(float, WS_WR)[i] = w * P.ffn_norm[k]; }
}

__device__ __forceinline__ void p1_late_conv(const Params& P, int gw, int NGW, int wv, LAS unsigned char* lds) {
    const int lane = lane_id_(); LAS unsigned char* scr = lds + wv * 9216;
    for (int it = gw; it < 2 * 32 * 32; it += NGW) {
        if (it < 1024) tconv_item(SrcWout{P.w_out, P.mla_norm, P.hg_norm}, 2048, 32, WSP(bf16_t, WS_WOUT), scr, it, lane);
        else tconv_item(SrcPlain{P.w_pg, P.ple_norm, 2048}, 2048, 32, WSP(bf16_t, WS_WPG), scr, it - 1024, lane);
    }
}
struct RowId { __device__ __forceinline__ int operator()(int m) const { return m; } };
template <class F, class RowMap>
__device__ __forceinline__ void naive_gemm_item(const bf16_t* A, int lda, const bf16_t* Bt, int ldb, int K, int m0, int nrows, int n0, const F& f, const RowMap& rm, int lane) {
    const int m = m0 + lane; const bool valid = lane < nrows;
    const bf16_t* ar = A + (size_t)rm(valid ? m : m0) * lda;
    float acc[64];
#pragma unroll
    for (int c = 0; c < 64; ++c) acc[c] = 0.f;
    for (int k = 0; k < K; k += 8) {
        const u32x4 a = *(const u32x4*)(ar + k);
        float af[8];
        af[0] = bf2f(a.x & 0xffffu); af[1] = bf2f(a.x >> 16); af[2] = bf2f(a.y & 0xffffu); af[3] = bf2f(a.y >> 16);
        af[4] = bf2f(a.z & 0xffffu); af[5] = bf2f(a.z >> 16); af[6] = bf2f(a.w & 0xffffu); af[7] = bf2f(a.w >> 16);
#pragma unroll
        for (int c = 0; c < 64; ++c) {
            const u32x4 b = *(const u32x4*)(Bt + (size_t)(n0 + c) * ldb + k);
            float s = acc[c];
            s = fmaf(af[0], bf2f(b.x & 0xffffu), s); s = fmaf(af[1], bf2f(b.x >> 16), s); s = fmaf(af[2], bf2f(b.y & 0xffffu), s); s = fmaf(af[3], bf2f(b.y >> 16), s);
            s = fmaf(af[4], bf2f(b.z & 0xffffu), s); s = fmaf(af[5], bf2f(b.z >> 16), s); s = fmaf(af[6], bf2f(b.w & 0xffffu), s); s = fmaf(af[7], bf2f(b.w >> 16), s);
            acc[c] = s;
        }
    }
    if (valid) {
        float ss = 0.f;
#pragma unroll
        for (int q = 0; q < 16; ++q) { const f32x4 v = f(m, n0 + 4 * q, (f32x4){acc[4 * q], acc[4 * q + 1], acc[4 * q + 2], acc[4 * q + 3]});
            ss += (v.x * v.x + v.y * v.y) + (v.z * v.z + v.w * v.w); }
        f.partial(m, n0 >> 6, ss);
    }
}
template <class F>
__device__ __forceinline__ void naive_gemm(const bf16_t* A, int lda, const bf16_t* Bt, int ldb, int M, int N, int K, const F& f, int wg, int nwg, int wv) {
    const int lane = TIDX & 63, gw = wg * 8 + (TIDX >> 6), NGW = nwg * 8;
    const int nmt = M / 64, nnt = N / 64;
    for (int it = gw; it < nmt * nnt; it += NGW) { const int mt = it % nmt, nt = it / nmt;
        naive_gemm_item(A, lda, Bt, ldb, K, mt * 64, 64, nt * 64, f, RowId{}, lane); }
}

__device__ __forceinline__ void st_bf4(bf16_t* p, f32x4 v) { u32x2 w; w.x = pk2(v.x, v.y); w.y = pk2(v.z, v.w); *(u32x2*)p = w; }
struct FProj { bf16_t* proj; const float* rstd; float* partq;
    __device__ __forceinline__ f32x4 operator()(int m, int c, f32x4 v) const { v = v * rstd[m]; st_bf4(proj + (size_t)m * DINP + c, v); return v; }
    __device__ __forceinline__ void partial(int m, int g, float ss) const { if (g < 12) partq[m * 12 + g] = ss; } };
struct FPP { bf16_t* pp;
    __device__ __forceinline__ f32x4 operator()(int m, int c, f32x4 v) const { st_bf4(pp + (size_t)m * D_ + c, v); return v; }
    __device__ __forceinline__ void partial(int, int, float) const {} };
struct FQ { bf16_t* Qb; const float* partq; const float* cs; const float* sn;
    __device__ __forceinline__ f32x4 operator()(int m, int c, f32x4 v) const {
        float ss = 0.f;
#pragma unroll
        for (int i = 0; i < 8; ++i) ss += partq[m * 12 + i];
        v = v * (QSCALE / sqrtf(ss * (1.f / 512.f) + EPS));
        if (c < 1024) { st_bf4(Qb + (size_t)m * 1536 + (c >> 7) * 192 + (c & 127), v); }
        else { const int r = c - 1024, h = r >> 6, j = r & 63, i0 = j >> 1;
            const float c0 = cs[m * 32 + i0], s0 = sn[m * 32 + i0], c1 = cs[m * 32 + i0 + 1], s1 = sn[m * 32 + i0 + 1];
            const f32x4 o = {v.x * c0 - v.y * s0, v.y * c0 + v.x * s0, v.z * c1 - v.w * s1, v.w * c1 + v.z * s1};
            st_bf4(Qb + (size_t)m * 1536 + h * 192 + 128 + j, o); }
        return v; }
    __device__ __forceinline__ void partial(int, int, float) const {} };
struct FKV { bf16_t* Kb; bf16_t* Vb; const float* partq;
    __device__ __forceinline__ f32x4 operator()(int m, int c, f32x4 v) const {
        const float ss = (partq[m * 12 + 8] + partq[m * 12 + 9]) + (partq[m * 12 + 10] + partq[m * 12 + 11]);
        v = v * (1.f / sqrtf(ss * (1.f / 256.f) + EPS));
        if (c < 1024) st_bf4(Kb + (size_t)m * 1536 + (c >> 7) * 192 + (c & 127), v); else st_bf4(Vb + (size_t)m * 1024 + (c - 1024), v);
        return v; }
    __device__ __forceinline__ void partial(int, int, float) const {} };
struct FOut { const float* x; float* out; bf16_t* hb; float* part;
    __device__ __forceinline__ f32x4 operator()(int m, int c, f32x4 v) const { const f32x4 h = *(const f32x4*)(x + (size_t)m * D_ + c) + v;
        *(f32x4*)(out + (size_t)m * D_ + c) = h; st_bf4(hb + (size_t)m * D_ + c, h); return h; }
    __device__ __forceinline__ void partial(int m, int g, float ss) const { part[m * 32 + g] = ss; } };
struct FPle { float* out; const bf16_t* pp; const float* rstd; const float* bias; float* part;
    __device__ __forceinline__ f32x4 operator()(int m, int c, f32x4 v) const {
        const float r = rstd[m]; const f32x4 b = *(const f32x4*)(bias + c); const u32x2 pw = *(const u32x2*)(pp + (size_t)m * D_ + c);
        const f32x4 pv = {bf2f(pw.x & 0xffffu), bf2f(pw.x >> 16), bf2f(pw.y & 0xffffu), bf2f(pw.y >> 16)};
        f32x4 h = *(const f32x4*)(out + (size_t)m * D_ + c);
        h.x += sigmoidf_(v.x * r + b.x) * pv.x; h.y += sigmoidf_(v.y * r + b.y) * pv.y; h.z += sigmoidf_(v.z * r + b.z) * pv.z; h.w += sigmoidf_(v.w * r + b.w) * pv.w;
        *(f32x4*)(out + (size_t)m * D_ + c) = h; return h; }
    __device__ __forceinline__ void partial(int m, int g, float ss) const { part[m * 32 + g] = ss; } };

__device__ __forceinline__ void kpe_run(const Params& P, int wg, int nwg, int wv) {
    const int gt = wg * 512 + TIDX, NGT = nwg * 512;
    const bf16_t* proj = WSP(bf16_t, WS_PROJ); bf16_t* Kb = WSP(bf16_t, WS_KB); const float* cs = WSP(float, WS_COS); const float* sn = WSP(float, WS_SIN);
    for (int i = gt; i < S_ * 32; i += NGT) { const int m = i >> 5, j = i & 31;
        const unsigned w = *(const unsigned*)(proj + (size_t)m * DINP + PC_KPE + 2 * j);
        const float a = bf2f(w & 0xffffu), b = bf2f(w >> 16), c = cs[i], s = sn[i];
        const unsigned o = pk2(a * c - b * s, b * c + a * s);
#pragma unroll
        for (int h = 0; h < NH; ++h) *(unsigned*)(Kb + (size_t)m * 1536 + h * 192 + 128 + 2 * j) = o; }
}

__device__ __forceinline__ void attn_naive_run(const Params& P, int wg, int nwg, int wv) {
    const int lane = TIDX & 63, gw = wg * 8 + (TIDX >> 6), NGW = nwg * 8;
    const bf16_t* Qb = WSP(bf16_t, WS_QB); const bf16_t* Kb = WSP(bf16_t, WS_KB); const bf16_t* Vb = WSP(bf16_t, WS_VB);
    bf16_t* Op = WSP(bf16_t, WS_OPART); float* ml = WSP(float, WS_ML);
    for (int it = gw; it < S_ * NH; it += NGW) {
        const int h = it & 7, m = S_ - 1 - (it >> 3);
        const bf16_t* q = Qb + (size_t)m * 1536 + h * 192 + 3 * lane;
        const float q0 = bf2f(q[0]), q1 = bf2f(q[1]), q2 = bf2f(q[2]);
        float mx = -1e30f, l = 0.f, o0 = 0.f, o1 = 0.f;
        for (int key = 0; key <= m; ++key) {
            const bf16_t* kr = Kb + (size_t)key * 1536 + h * 192 + 3 * lane;
            float s = q0 * bf2f(kr[0]) + q1 * bf2f(kr[1]) + q2 * bf2f(kr[2]);
            s = wave_sum(s);
            const float mn = fmaxf(mx, s), al = exp2f(mx - mn), p = exp2f(s - mn);
            const unsigned vw = *(const unsigned*)(Vb + (size_t)key * 1024 + h * 128 + 2 * lane);
            l = l * al + p; o0 = o0 * al + p * bf2f(vw & 0xffffu); o1 = o1 * al + p * bf2f(vw >> 16); mx = mn;
        }
        const float rl = 1.f / l;
        *(unsigned*)(Op + (size_t)m * 1024 + h * 128 + 2 * lane) = pk2(o0 * rl, o1 * rl);
        *(unsigned*)(Op + (size_t)S_ * 1024 + (size_t)m * 1024 + h * 128 + 2 * lane) = 0u;
        if (lane == 0) { float* a = ml + ((size_t)m * 8 + h) * 2; a[0] = 0.f; a[1] = 1.f; float* b = ml + (size_t)S_ * 16 + ((size_t)m * 8 + h) * 2; b[0] = -1e30f; b[1] = 0.f; }
    }
}
__device__ __forceinline__ void combine_run(const Params& P, int wg, int nwg, int wv) {
    const int lane = TIDX & 63, gw = wg * 8 + (TIDX >> 6), NGW = nwg * 8;
    const bf16_t* Op = WSP(bf16_t, WS_OPART); const float* ml = WSP(float, WS_ML); bf16_t* ymix = WSP(bf16_t, WS_YMIX);
    for (int m = gw; m < S_; m += NGW) {
        const int h = lane >> 3;
        const float m0 = ml[((size_t)m * 8 + h) * 2], l0 = ml[((size_t)m * 8 + h) * 2 + 1];
        const float m1 = ml[(size_t)S_ * 16 + ((size_t)m * 8 + h) * 2], l1 = ml[(size_t)S_ * 16 + ((size_t)m * 8 + h) * 2 + 1];
        const float mm = fmaxf(m0, m1); float w0 = l0 * exp2f(m0 - mm), w1 = l1 * exp2f(m1 - mm); const float rs = 1.f / (w0 + w1); w0 *= rs; w1 *= rs;
        const u32x4* a = (const u32x4*)(Op + (size_t)m * 1024 + 16 * lane); const u32x4* b = (const u32x4*)(Op + (size_t)S_ * 1024 + (size_t)m * 1024 + 16 * lane);
        float o[16]; float ss = 0.f;
#pragma unroll
        for (int j = 0; j < 2; ++j) { const u32x4 ua = a[j], ub = b[j]; const unsigned wa[4] = {ua.x, ua.y, ua.z, ua.w}, wb[4] = {ub.x, ub.y, ub.z, ub.w};
#pragma unroll
            for (int i = 0; i < 4; ++i) { o[8 * j + 2 * i] = w0 * bf2f(wa[i] & 0xffffu) + w1 * bf2f(wb[i] & 0xffffu); o[8 * j + 2 * i + 1] = w0 * bf2f(wa[i] >> 16) + w1 * bf2f(wb[i] >> 16); } }
#pragma unroll
        for (int i = 0; i < 16; ++i) ss += o[i] * o[i];
        ss = wave_sum(ss); const float r = 1.f / sqrtf(ss * (1.f / 1024.f) + EPS);
        u32x4 w0v, w1v;
        w0v.x = pk2(o[0] * r, o[1] * r); w0v.y = pk2(o[2] * r, o[3] * r); w0v.z = pk2(o[4] * r, o[5] * r); w0v.w = pk2(o[6] * r, o[7] * r);
        w1v.x = pk2(o[8] * r, o[9] * r); w1v.y = pk2(o[10] * r, o[11] * r); w1v.z = pk2(o[12] * r, o[13] * r); w1v.w = pk2(o[14] * r, o[15] * r);
        u32x4* y = (u32x4*)(ymix + (size_t)m * D_ + 16 * lane); y[0] = w0v; y[1] = w1v;
    }
}

__device__ __forceinline__ void hgrn_naive_run(const Params& P, int wg, int wv, LAS unsigned char* lds) {
    if (wg >= NH) return;
    const int h = wg, tid = TIDX; const bool act = tid < 128; const int v = tid & 127;
    const bf16_t* proj = WSP(bf16_t, WS_PROJ); const float* lb = WSP(float, WS_LB); bf16_t* ymix = WSP(bf16_t, WS_YMIX);
    LAS float* sf = (LAS float*)lds; LAS float* sq = sf + 128; LAS float* red = sq + 128;
    float st[128];
#pragma unroll
    for (int k = 0; k < 128; ++k) st[k] = 0.f;
    for (int t = 0; t < S_; ++t) {
        const bf16_t* pr = proj + (size_t)t * DINP;
        if (act) { const float l = lb[h * 128 + v]; sf[v] = l + (1.f - l) * sigmoidf_(bf2f(pr[PC_HF + h * 128 + v])); sq[v] = siluf_(bf2f(pr[PC_HQ + h * 128 + v])); }
        __syncthreads();
        float o = 0.f;
        if (act) { const float iv = bf2f(pr[PC_HI + h * 128 + v]);
#pragma unroll
            for (int k = 0; k < 128; ++k) { const float f = sf[k]; st[k] = f * st[k] + (1.f - f) * iv; o += sq[k] * st[k]; } }
        float ss = act ? o * o : 0.f; ss = wave_sum(ss);
        if (act && (tid & 63) == 0) red[tid >> 6] = ss;
        __syncthreads();
        if (act) { const float r = 1.f / sqrtf((red[0] + red[1]) * (1.f / 128.f) + EPS);
            ymix[(size_t)t * D_ + 1024 + h * 128 + v] = (bf16_t)f2bf(o * r * siluf_(bf2f(pr[PC_HG + h * 128 + v]))); }
    }
}

__device__ __forceinline__ void route_run(const Params& P, int wg, int nwg, int wv, LAS unsigned char* lds) {
    const int lane = TIDX & 63, wave = TIDX >> 6, gw = wg * 8 + wave, NGW = nwg * 8;
    const float* h1 = P.out; const float* Wr = WSP(float, WS_WR); const float* part1 = WSP(float, WS_PART1);
    LAS float* lg = (LAS float*)lds + wave * 96;
    int* cnt = WSP(int, WS_CTL); int* list = WSP(int, WS_LIST); int* eid = WSP(int, WS_EID); float* ew = WSP(float, WS_EW); float* rstd1 = WSP(float, WS_RSTD1);
    for (int t = gw; t < S_; t += NGW) {
        float ss = (lane < 32) ? part1[t * 32 + lane] : 0.f; ss = wave_sum(ss); const float r = 1.f / sqrtf(ss * (1.f / D_) + EPS);
        float a0 = 0.f, a1 = 0.f; const float* hr = h1 + (size_t)t * D_;
        for (int k = 0; k < D_; ++k) { const float hv = hr[k]; a0 = fmaf(hv, Wr[k * 80 + lane], a0); if (lane < 16) a1 = fmaf(hv, Wr[k * 80 + 64 + lane], a1); }
        lg[lane] = a0 * r; if (lane < 16) lg[64 + lane] = a1 * r;
        asm volatile("s_waitcnt lgkmcnt(0)" ::: "memory");
        if (lane == 0) {
            rstd1[t] = r;
            int g = 0; float gm = -INFINITY;
            for (int i = 0; i < 8; ++i) { const float v = lg[i] + P.b_rg[i]; if (v > gm) { gm = v; g = i; } }
            float gs = 0.f; for (int i = 0; i < 8; ++i) gs += expf(lg[i] + P.b_rg[i] - gm);
            const float gw_ = 1.f / gs;
            int i1 = 0, i2 = 0; float l1 = -INFINITY, l2 = -INFINITY;
            for (int i = 0; i < 8; ++i) { const float e = lg[8 + g * 8 + i] + P.b_re[g * 8 + i];
                if (e > l1) { l2 = l1; i2 = i1; l1 = e; i1 = i; } else if (e > l2) { l2 = e; i2 = i; } }
            const float p2 = expf(l2 - l1), w1 = gw_ / (1.f + p2), w2 = gw_ * p2 / (1.f + p2);
            const int e1 = g * 8 + i1, e2 = g * 8 + i2;
            eid[2 * t] = e1; eid[2 * t + 1] = e2; ew[2 * t] = w1; ew[2 * t + 1] = w2;
            const int p1 = atomicAdd(&cnt[e1], 1); list[e1 * LISTCAP + p1] = 2 * t;
            const int q2 = atomicAdd(&cnt[e2], 1); list[e2 * LISTCAP + q2] = 2 * t + 1;
        }
        asm volatile("s_waitcnt lgkmcnt(0)" ::: "memory");
    }
}

__device__ __forceinline__ void moe_up_naive_run(const Params& P, int wg, int nwg, int wv) {
    const int lane = TIDX & 63, gw = wg * 8 + (TIDX >> 6), NGW = nwg * 8;
    const int* cnt = WSP(int, WS_CTL); const int* list = WSP(int, WS_LIST); const float* rstd1 = WSP(float, WS_RSTD1);
    const bf16_t* h1b = WSP(bf16_t, WS_H1B); bf16_t* hmid = WSP(bf16_t, WS_HMID);
    int off = 0, tbase = 0;
    for (int e = 0; e < NE; ++e) {
        const int n = cnt[e], nrg = (n + 63) >> 6, nit = nrg * 16;
        for (int it = gw - off; it < nit; it += NGW) {
            if (it < 0) continue;
            const int rg = it >> 4, cg = it & 15, c0 = cg * 32;
            const int nrows = (n - rg * 64) < 64 ? (n - rg * 64) : 64;
            const int a = list[e * LISTCAP + rg * 64 + (lane < nrows ? lane : 0)]; const int tok = a >> 1;
            const bf16_t* ar = h1b + (size_t)tok * D_;
            const bf16_t* W = WSP(bf16_t, WS_WGU) + (size_t)e * 1024 * 2048;
            const int pn = c0 >> 7, rr = c0 & 127;
            float ag[32], au[32];
#pragma unroll
            for (int c = 0; c < 32; ++c) { ag[c] = 0.f; au[c] = 0.f; }
            for (int k = 0; k < D_; k += 8) {
                const u32x4 av = *(const u32x4*)(ar + k); float af[8];
                af[0] = bf2f(av.x & 0xffffu); af[1] = bf2f(av.x >> 16); af[2] = bf2f(av.y & 0xffffu); af[3] = bf2f(av.y >> 16);
                af[4] = bf2f(av.z & 0xffffu); af[5] = bf2f(av.z >> 16); af[6] = bf2f(av.w & 0xffffu); af[7] = bf2f(av.w >> 16);
#pragma unroll
                for (int c = 0; c < 32; ++c) {
                    const u32x4 bg = *(const u32x4*)(W + (size_t)(pn * 256 + rr + c) * 2048 + k); const u32x4 bu = *(const u32x4*)(W + (size_t)(pn * 256 + 128 + rr + c) * 2048 + k);
                    float s = ag[c], u = au[c];
                    s = fmaf(af[0], bf2f(bg.x & 0xffffu), s); s = fmaf(af[1], bf2f(bg.x >> 16), s); s = fmaf(af[2], bf2f(bg.y & 0xffffu), s); s = fmaf(af[3], bf2f(bg.y >> 16), s);
                    s = fmaf(af[4], bf2f(bg.z & 0xffffu), s); s = fmaf(af[5], bf2f(bg.z >> 16), s); s = fmaf(af[6], bf2f(bg.w & 0xffffu), s); s = fmaf(af[7], bf2f(bg.w >> 16), s);
                    u = fmaf(af[0], bf2f(bu.x & 0xffffu), u); u = fmaf(af[1], bf2f(bu.x >> 16), u); u = fmaf(af[2], bf2f(bu.y & 0xffffu), u); u = fmaf(af[3], bf2f(bu.y >> 16), u);
                    u = fmaf(af[4], bf2f(bu.z & 0xffffu), u); u = fmaf(af[5], bf2f(bu.z >> 16), u); u = fmaf(af[6], bf2f(bu.w & 0xffffu), u); u = fmaf(af[7], bf2f(bu.w >> 16), u);
                    ag[c] = s; au[c] = u;
                }
            }
            if (lane < nrows) { const float r = rstd1[tok]; const int slot = tbase * 256 + rg * 64 + lane;
#pragma unroll
                for (int c = 0; c < 32; c += 2) *(unsigned*)(hmid + (size_t)slot * DE + c0 + c) = pk2(siluf_(ag[c] * r) * (au[c] * r), siluf_(ag[c + 1] * r) * (au[c + 1] * r)); }
        }
        off = (off + nit) % NGW; tbase += (n + 255) >> 8;
    }
}
struct FDown { bf16_t* y; const int* lst; int slot0; const float* ew;
    __device__ __forceinline__ f32x4 operator()(int m, int c, f32x4 v) const { const int a = lst[m - slot0]; v = v * ew[a]; st_bf4(y + (size_t)a * D_ + c, v); return v; }
    __device__ __forceinline__ void partial(int, int, float) const {} };
__device__ __forceinline__ void moe_down_naive_run(const Params& P, int wg, int nwg, int wv) {
    const int lane = TIDX & 63, gw = wg * 8 + (TIDX >> 6), NGW = nwg * 8;
    const int* cnt = WSP(int, WS_CTL); const int* list = WSP(int, WS_LIST); const float* ew = WSP(float, WS_EW);
    const bf16_t* hmid = WSP(bf16_t, WS_HMID); bf16_t* y = WSP(bf16_t, WS_Y);
    int off = 0, tbase = 0;
    for (int e = 0; e < NE; ++e) {
        const int n = cnt[e], nrg = (n + 63) >> 6, nit = nrg * 32;
        for (int it = gw - off; it < nit; it += NGW) {
            if (it < 0) continue;
            const int rg = it >> 5, cg = it & 31; const int nrows = (n - rg * 64) < 64 ? (n - rg * 64) : 64;
            const int slot0 = tbase * 256 + rg * 64;
            FDown f{y, list + e * LISTCAP + rg * 64, slot0, ew};
            naive_gemm_item(hmid, DE, WSP(bf16_t, WS_WD) + (size_t)e * 2048 * DE, DE, DE, slot0, nrows, cg * 64, f, RowId{}, lane);
        }
        off = (off + nit) % NGW; tbase += (n + 255) >> 8;
    }
}
__device__ __forceinline__ void moe_combine_run(const Params& P, int wg, int nwg, int wv) {
    const int lane = TIDX & 63, gw = wg * 8 + (TIDX >> 6), NGW = nwg * 8;
    const bf16_t* y = WSP(bf16_t, WS_Y); bf16_t* h2b = WSP(bf16_t, WS_H2B); float* rstd2 = WSP(float, WS_RSTD2);
    for (int m = gw; m < S_; m += NGW) {
        f32x4* hr = (f32x4*)(P.out + (size_t)m * D_) + lane; const u32x2* y0 = (const u32x2*)(y + (size_t)(2 * m) * D_) + lane; const u32x2* y1 = (const u32x2*)(y + (size_t)(2 * m + 1) * D_) + lane;
        u32x2* ob = (u32x2*)(h2b + (size_t)m * D_) + lane; float ss = 0.f;
#pragma unroll
        for (int j = 0; j < 8; ++j) { f32x4 h = hr[64 * j]; const u32x2 a = y0[64 * j], b = y1[64 * j];
            h.x += bf2f(a.x & 0xffffu) + bf2f(b.x & 0xffffu); h.y += bf2f(a.x >> 16) + bf2f(b.x >> 16); h.z += bf2f(a.y & 0xffffu) + bf2f(b.y & 0xffffu); h.w += bf2f(a.y >> 16) + bf2f(b.y >> 16);
            hr[64 * j] = h; u32x2 w; w.x = pk2(h.x, h.y); w.y = pk2(h.z, h.w); ob[64 * j] = w; ss += (h.x * h.x + h.y * h.y) + (h.z * h.z + h.w * h.w); }
        ss = wave_sum(ss); if (lane == 0) rstd2[m] = 1.f / sqrtf(ss * (1.f / D_) + EPS);
    }
}
__device__ __forceinline__ void final_run(const Params& P, int wg, int nwg, int wv) {
    const int lane = TIDX & 63, gw = wg * 8 + (TIDX >> 6), NGW = nwg * 8; const float* part3 = WSP(float, WS_PART3);
    for (int m = gw; m < S_; m += NGW) {
        float ss = (lane < 32) ? part3[m * 32 + lane] : 0.f; ss = wave_sum(ss); const float r = 1.f / sqrtf(ss * (1.f / D_) + EPS);
        f32x4* hr = (f32x4*)(P.out + (size_t)m * D_) + lane; const f32x4* g = (const f32x4*)P.final_norm + lane;
#pragma unroll
        for (int j = 0; j < 8; ++j) hr[64 * j] = hr[64 * j] * r * g[64 * j];
    }
}

namespace pg8 {
typedef short bf16x8 __attribute__((ext_vector_type(8)));
constexpr int BM = 256, BK = 64, HALF = 128, HTB = HALF * BK * 2, STAGE_BYTES = 8 * HTB, NXCD = 8, WGM = 8;
__device__ __forceinline__ int lds_byte(int r, int c) { const int st = (r >> 4) * 2 + (c >> 5), rr = r & 15, cc = c & 31, ob = rr * 64 + cc * 2; return st * 1024 + (ob ^ (((ob >> 9) & 1) << 5)); }
__device__ __forceinline__ void stage_rc(int b, int& R, int& C) { const int st = b / 1024, sb = b % 1024, swz = sb ^ (((sb >> 9) & 1) << 5); R = (st >> 1) * 16 + swz / 64; C = (st & 1) * 32 + (swz % 64) / 2; }
struct Unit { int pm, pn; const char* a; const char* b; int x0, x1, x2; };
struct DenseOrder {
    const bf16_t* A; const bf16_t* Bt; int K, lda, nM, nN, nwg, G, c;
    __device__ __forceinline__ void init(const bf16_t* A_, int lda_, const bf16_t* Bt_, int M, int N, int K_, int G_, int c_) { A = A_; lda = lda_; Bt = Bt_; K = K_; nM = M / BM; nN = N / BM; nwg = nM * nN; G = G_; c = c_; }
    __device__ __forceinline__ bool next(int i, Unit& u) const {
        const long L = (long)i * G + c; if (L >= nwg) return false;
        int wgid = (int)L; { const int q = nwg / NXCD, r = nwg % NXCD, xcd = wgid % NXCD, off = wgid / NXCD; wgid = (xcd < r ? xcd * (q + 1) : r * (q + 1) + (xcd - r) * q) + off; }
        const int nig = WGM * nN, gid = wgid / nig, fm = gid * WGM, gsz = (nM - fm) < WGM ? (nM - fm) : WGM;
        u.pm = fm + ((wgid % nig) % gsz); u.pn = (wgid % nig) / gsz;
        u.a = (const char*)A + (size_t)u.pm * BM * lda * 2; u.b = (const char*)Bt + (size_t)u.pn * BM * K * 2; u.x0 = 0; u.x1 = 0; u.x2 = 0; return true;
    }
    __device__ __forceinline__ unsigned row_off(const Unit&, int) const { return 0u; }
};
template <class F> struct EpiF { F f;
    __device__ __forceinline__ void operator()(const f32x4 (&acc)[2][2][4][2], const Unit& u, int wr, int wc, int fr, int fq) const {
#pragma unroll
        for (int ai = 0; ai < 2; ++ai)
#pragma unroll
            for (int m = 0; m < 4; ++m) { const int r = ai * HALF + wr * 64 + m * 16 + fr; const auto ctx = f.row(u, r); float ss = 0.f;
#pragma unroll
                for (int bj = 0; bj < 2; ++bj)
#pragma unroll
                    for (int n = 0; n < 2; ++n) { const f32x4 v = f.elem(u, r, bj * HALF + wc * 32 + n * 16 + fq * 4, acc[ai][bj][m][n], ctx);
                        if (F::ROWSUM) ss += (v.x * v.x + v.y * v.y) + (v.z * v.z + v.w * v.w); }
                if (F::ROWSUM) { ss += __shfl_xor(ss, 16); ss += __shfl_xor(ss, 32); if (fq == 0) f.partial(u, r, wc, ss); }
                asm volatile("" ::: "memory"); }
    } };

template <class Epi, class Sched, bool GATHER>
__device__ __forceinline__ void gemm_phase(LAS unsigned char* lds, const int K, const int lda, const Sched& S, const Epi& E, const int wv) {
    const int wid = wv, lane = lane_id_(), tid = wid * 64 + lane, wr = wid >> 2, wc = wid & 3, fr = lane & 15, fq = lane >> 4;
    const int nt = K / BK;
    unsigned voffB[2], vA[2][2], vAn[2][2];
#pragma unroll
    for (int i = 0; i < 2; ++i) { int R, C; stage_rc(tid * 16 + i * 8192, R, C); voffB[i] = (unsigned)(R * K + C) * 2u;
        vA[0][i] = (unsigned)(R * lda + C) * 2u; vA[1][i] = vA[0][i]; vAn[0][i] = vA[0][i]; vAn[1][i] = vA[0][i]; }
    const size_t kstep = (size_t)(BK * 2);
    const size_t hstepB = (size_t)HALF * K * 2;
    const size_t hstepA = GATHER ? (size_t)0 : (size_t)HALF * lda * 2;
    const unsigned ldsw = (unsigned)wid * 1024u;
    const int aoff = lds_byte(wr * 64 + fr, fq * 8), boff = lds_byte(wc * 32 + fr, fq * 8);
#define PG8_SA(b, h) (((b) * 2 + (h)) * HTB)
#define PG8_SB(b, h) ((4 + (b) * 2 + (h)) * HTB)
#define PG8_STAGE(bufoff, gbase, voff) do { _Pragma("unroll") for (int _i = 0; _i < 2; ++_i) \
        __builtin_amdgcn_global_load_lds((const unsigned*)((const char*)(gbase) + (voff)[_i]), (LAS unsigned*)(lds + (bufoff) + ldsw + _i * 8192), 16, 0, 0); } while (0)
#define PG8_LDA(dst, b, h) do { _Pragma("unroll") for (int m = 0; m < 4; ++m) _Pragma("unroll") for (int k = 0; k < 2; ++k) dst[m][k] = *(const LAS bf16x8*)(lds + PG8_SA(b, h) + aoff + m * 2048 + k * 1024); } while (0)
#define PG8_LDB(dst, b, h) do { _Pragma("unroll") for (int n = 0; n < 2; ++n) _Pragma("unroll") for (int k = 0; k < 2; ++k) dst[n][k] = *(const LAS bf16x8*)(lds + PG8_SB(b, h) + boff + n * 2048 + k * 1024); } while (0)
#define PG8_MMA(ai, bj, At, Bt) do { __builtin_amdgcn_s_setprio(1); _Pragma("unroll") for (int m = 0; m < 4; ++m) _Pragma("unroll") for (int n = 0; n < 2; ++n) _Pragma("unroll") for (int k = 0; k < 2; ++k) \
        acc[ai][bj][m][n] = __builtin_amdgcn_mfma_f32_16x16x32_bf16(Bt[n][k], At[m][k], acc[ai][bj][m][n], 0, 0, 0); __builtin_amdgcn_s_setprio(0); } while (0)
#define PG8_WAIT_V(n) asm volatile("s_waitcnt vmcnt(" #n ")" ::: "memory")
#define PG8_WAIT_L(n) asm volatile("s_waitcnt lgkmcnt(" #n ")" ::: "memory")
#define PG8_BAR __builtin_amdgcn_s_barrier()
#define PG8_SCHED __builtin_amdgcn_sched_barrier(0)
#define PG8_GOFF(dst, uu) do { if constexpr (GATHER) { _Pragma("unroll") for (int _i = 0; _i < 2; ++_i) { int _R, _C; stage_rc((wid * 64 + lane_id_()) * 16 + _i * 8192, _R, _C); \
        _Pragma("unroll") for (int _h = 0; _h < 2; ++_h) dst[_h][_i] = S.row_off(uu, _R + _h * HALF) + (unsigned)_C * 2u; } } } while (0)
    Unit cur, nxt; int ui = 0;
    if (!S.next(0, cur)) return;
    PG8_GOFF(vA, cur);
    f32x4 acc[2][2][4][2];
#pragma unroll
    for (int a = 0; a < 2; ++a)
#pragma unroll
        for (int b = 0; b < 2; ++b)
#pragma unroll
            for (int m = 0; m < 4; ++m)
#pragma unroll
                for (int n = 0; n < 2; ++n) acc[a][b][m][n] = (f32x4){0.f, 0.f, 0.f, 0.f};
    bf16x8 At[4][2], B0[2][2], B1[2][2];
    const char* cA = cur.a; const char* cB = cur.b;
    PG8_STAGE(PG8_SB(0, 0), cB, voffB); PG8_STAGE(PG8_SB(0, 1), cB + hstepB, voffB); PG8_STAGE(PG8_SA(0, 0), cA, vA[0]); PG8_STAGE(PG8_SA(0, 1), cA + hstepA, vA[1]);
    if (wr == 1) PG8_BAR;
    PG8_WAIT_V(2); PG8_BAR;
    PG8_STAGE(PG8_SB(1, 0), cB + kstep, voffB); PG8_STAGE(PG8_SA(1, 0), cA + kstep, vA[0]); PG8_STAGE(PG8_SB(1, 1), cB + hstepB + kstep, voffB);
    PG8_WAIT_V(6); PG8_BAR;
    for (;;) {
        const bool has_next = S.next(ui + 1, nxt);
        const char* nA = has_next ? nxt.a : cA; const char* nB = has_next ? nxt.b : cB;
        if constexpr (GATHER) { if (has_next) { PG8_GOFF(vAn, nxt); } else {
#pragma unroll
            for (int h = 0; h < 2; ++h)
#pragma unroll
                for (int i = 0; i < 2; ++i) vAn[h][i] = vA[h][i]; } }
        for (int t = 0; t < nt; t += 2) {
            const bool last = (t == nt - 2);
            const char* a1 = cA + (size_t)(t + 1) * kstep;
            const char* a2 = last ? nA : cA + (size_t)(t + 2) * kstep; const char* b2 = last ? nB : cB + (size_t)(t + 2) * kstep;
            const char* a3 = a2 + kstep; const char* b3 = b2 + kstep;
            unsigned w0[2], w1[2];
#pragma unroll
            for (int i = 0; i < 2; ++i) { w0[i] = (GATHER && last) ? vAn[0][i] : vA[0][i]; w1[i] = (GATHER && last) ? vAn[1][i] : vA[1][i]; }
            PG8_LDB(B0, 0, 0); PG8_LDB(B1, 0, 1); PG8_SCHED; PG8_LDA(At, 0, 0); PG8_STAGE(PG8_SA(1, 1), a1 + hstepA, vA[1]);
            PG8_WAIT_V(8); PG8_WAIT_L(0); PG8_BAR; PG8_MMA(0, 0, At, B0); PG8_MMA(0, 1, At, B1); PG8_BAR; PG8_SCHED;
            PG8_LDA(At, 0, 1); PG8_STAGE(PG8_SB(0, 0), b2, voffB); PG8_STAGE(PG8_SB(0, 1), b2 + hstepB, voffB); PG8_STAGE(PG8_SA(0, 0), a2, w0);
            PG8_WAIT_V(8); PG8_WAIT_L(0); PG8_BAR; PG8_MMA(1, 0, At, B0); PG8_MMA(1, 1, At, B1); PG8_BAR; PG8_SCHED;
            PG8_LDB(B0, 1, 0); PG8_LDB(B1, 1, 1); PG8_SCHED; PG8_LDA(At, 1, 0); PG8_STAGE(PG8_SA(0, 1), a2 + hstepA, w1);
            PG8_WAIT_V(8); PG8_WAIT_L(0); PG8_BAR; PG8_MMA(0, 0, At, B0); PG8_MMA(0, 1, At, B1); PG8_BAR; PG8_SCHED;
            PG8_LDA(At, 1, 1); PG8_STAGE(PG8_SB(1, 0), b3, voffB); PG8_STAGE(PG8_SB(1, 1), b3 + hstepB, voffB); PG8_STAGE(PG8_SA(1, 0), a3, w0);
            PG8_WAIT_V(8); PG8_WAIT_L(0); PG8_BAR; PG8_MMA(1, 0, At, B0); PG8_MMA(1, 1, At, B1); PG8_BAR; PG8_SCHED;
        }
        if (wr == 0) PG8_BAR;
        E(acc, cur, wr, wc, fr, fq);
        if (!has_next) break;
#pragma unroll
        for (int a = 0; a < 2; ++a)
#pragma unroll
            for (int b = 0; b < 2; ++b)
#pragma unroll
                for (int m = 0; m < 4; ++m)
#pragma unroll
                    for (int n = 0; n < 2; ++n) acc[a][b][m][n] = (f32x4){0.f, 0.f, 0.f, 0.f};
        cur = nxt; cA = nA; cB = nB; ++ui;
        if constexpr (GATHER) {
#pragma unroll
            for (int h = 0; h < 2; ++h)
#pragma unroll
                for (int i = 0; i < 2; ++i) vA[h][i] = vAn[h][i]; }
        if (wr == 1) PG8_BAR;
    }
    PG8_WAIT_V(0);
    PG8_BAR;
#undef PG8_SA
#undef PG8_SB
#undef PG8_STAGE
#undef PG8_LDA
#undef PG8_LDB
#undef PG8_MMA
#undef PG8_WAIT_V
#undef PG8_WAIT_L
#undef PG8_BAR
#undef PG8_SCHED
#undef PG8_GOFF
}
}

struct PFProj { static constexpr bool ROWSUM = true; bf16_t* proj; const float* rstd; float* partq;
    __device__ __forceinline__ float row(const pg8::Unit& u, int r) const { return rstd[u.pm * 256 + r]; }
    __device__ __forceinline__ f32x4 elem(const pg8::Unit& u, int r, int c, f32x4 v, float rs) const { v = v * rs; st_bf4(proj + (size_t)(u.pm * 256 + r) * DINP + u.pn * 256 + c, v); return v; }
    __device__ __forceinline__ void partial(const pg8::Unit& u, int r, int wc, float ss) const { const int g = u.pn * 4 + wc; if (g < 12) partq[(u.pm * 256 + r) * 12 + g] = ss; } };
struct PFPP { static constexpr bool ROWSUM = false; bf16_t* pp;
    __device__ __forceinline__ int row(const pg8::Unit&, int) const { return 0; }
    __device__ __forceinline__ f32x4 elem(const pg8::Unit& u, int r, int c, f32x4 v, int) const { st_bf4(pp + (size_t)(u.pm * 256 + r) * D_ + u.pn * 256 + c, v); return v; }
    __device__ __forceinline__ void partial(const pg8::Unit&, int, int, float) const {} };
struct PFQ { static constexpr bool ROWSUM = false; bf16_t* Qb; const float* partq; const float* cs; const float* sn;
    __device__ __forceinline__ float row(const pg8::Unit& u, int r) const { const f32x4* p = (const f32x4*)(partq + (size_t)(u.pm * 256 + r) * 12); const f32x4 a = p[0], b = p[1];
        const float ss = ((a.x + a.y) + (a.z + a.w)) + ((b.x + b.y) + (b.z + b.w)); return QSCALE / sqrtf(ss * (1.f / 512.f) + EPS); }
    __device__ __forceinline__ f32x4 elem(const pg8::Unit& u, int r, int cc, f32x4 v, float sc) const { const int m = u.pm * 256 + r, c = u.pn * 256 + cc; v = v * sc;
        if (u.pn < 4) { st_bf4(Qb + (size_t)m * 1536 + (c >> 7) * 192 + (c & 127), v); }
        else { const int q = c - 1024, h = q >> 6, j = q & 63, i0 = j >> 1;
            const float c0 = cs[m * 32 + i0], s0 = sn[m * 32 + i0], c1 = cs[m * 32 + i0 + 1], s1 = sn[m * 32 + i0 + 1];
            const f32x4 o = {v.x * c0 - v.y * s0, v.y * c0 + v.x * s0, v.z * c1 - v.w * s1, v.w * c1 + v.z * s1};
            st_bf4(Qb + (size_t)m * 1536 + h * 192 + 128 + j, o); }
        return v; }
    __device__ __forceinline__ void partial(const pg8::Unit&, int, int, float) const {} };
struct PFKV { static constexpr bool ROWSUM = false; bf16_t* Kb; bf16_t* Vb; const float* partq;
    __device__ __forceinline__ float row(const pg8::Unit& u, int r) const { const f32x4 a = *(const f32x4*)(partq + (size_t)(u.pm * 256 + r) * 12 + 8);
        return 1.f / sqrtf(((a.x + a.y) + (a.z + a.w)) * (1.f / 256.f) + EPS); }
    __device__ __forceinline__ f32x4 elem(const pg8::Unit& u, int r, int cc, f32x4 v, float sc) const { const int m = u.pm * 256 + r, c = u.pn * 256 + cc; v = v * sc;
        if (u.pn < 4) st_bf4(Kb + (size_t)m * 1536 + (c >> 7) * 192 + (c & 127), v); else st_bf4(Vb + (size_t)m * 1024 + (c - 1024), v);
        return v; }
    __device__ __forceinline__ void partial(const pg8::Unit&, int, int, float) const {} };
struct PFOut { static constexpr bool ROWSUM = true; const float* x; float* out; bf16_t* hb; float* part;
    __device__ __forceinline__ int row(const pg8::Unit&, int) const { return 0; }
    __device__ __forceinline__ f32x4 elem(const pg8::Unit& u, int r, int cc, f32x4 v, int) const { const size_t o = (size_t)(u.pm * 256 + r) * D_ + u.pn * 256 + cc;
        const f32x4 h = *(const f32x4*)(x + o) + v; *(f32x4*)(out + o) = h; st_bf4(hb + o, h); return h; }
    __device__ __forceinline__ void partial(const pg8::Unit& u, int r, int wc, float ss) const { part[(u.pm * 256 + r) * 32 + u.pn * 4 + wc] = ss; } };
struct PFPle { static constexpr bool ROWSUM = true; float* out; const bf16_t* pp; const float* rstd; const float* bias; float* part;
    __device__ __forceinline__ float row(const pg8::Unit& u, int r) const { return rstd[u.pm * 256 + r]; }
    __device__ __forceinline__ f32x4 elem(const pg8::Unit& u, int r, int cc, f32x4 v, float rs) const { const int c = u.pn * 256 + cc; const size_t o = (size_t)(u.pm * 256 + r) * D_ + c;
        const f32x4 b = *(const f32x4*)(bias + c); const u32x2 pw = *(const u32x2*)(pp + o);
        const f32x4 pv = {bf2f(pw.x & 0xffffu), bf2f(pw.x >> 16), bf2f(pw.y & 0xffffu), bf2f(pw.y >> 16)};
        f32x4 h = *(const f32x4*)(out + o);
        h.x += sigmoidf_(v.x * rs + b.x) * pv.x; h.y += sigmoidf_(v.y * rs + b.y) * pv.y; h.z += sigmoidf_(v.z * rs + b.z) * pv.z; h.w += sigmoidf_(v.w * rs + b.w) * pv.w;
        *(f32x4*)(out + o) = h; return h; }
    __device__ __forceinline__ void partial(const pg8::Unit& u, int r, int wc, float ss) const { part[(u.pm * 256 + r) * 32 + u.pn * 4 + wc] = ss; } };
template <class F> __device__ __forceinline__ void dense_gemm(LAS unsigned char* lds, const bf16_t* A, int lda, const bf16_t* Bt, int M, int N, int K, const F& f, int wg, int nwg, int wv) {
    asm volatile("" : "+s"(K), "+s"(lda));
    pg8::DenseOrder S; S.init(A, lda, Bt, M, N, K, nwg, wg);
    pg8::EpiF<F> E{f};
    pg8::gemm_phase<pg8::EpiF<F>, pg8::DenseOrder, false>(lds, K, lda, S, E, wv);
}


namespace att {
typedef short bf16x8 __attribute__((ext_vector_type(8)));
typedef short s16x4 __attribute__((ext_vector_type(4)));
typedef float f32x16 __attribute__((ext_vector_type(16)));
constexpr int KVBLK = 64, QBLK = 32, QB = 256, KROW = 384  , SHM_V = 64 * 128 * 2, SHM_K = 64 * KROW;
constexpr int LDQ = 1536, LDK = 1536, LDV = 1024, LDO = 1024;
constexpr float THR = 8.f;
#define KSWZ(row, colB) ((row) * KROW + ((colB) ^ ((((row) >> 1) & 7) << 4)))
#define SBAR() __builtin_amdgcn_sched_barrier(0)
__device__ __forceinline__ int v_st(int k, int c) { const int kk = (k & ~0xC) | ((k & 4) << 1) | ((k & 8) >> 1); return ((kk >> 3) * 4 + (c >> 5)) * 512 + ((kk & 7) * 32 + (c & 31)) * 2; }
__device__ __forceinline__ int v_rd_base(int lane) { return ((lane & 3) << 3) | (((lane >> 2) & 3) << 6) | (((lane >> 4) & 1) << 5) | (((lane >> 5) & 1) << 8); }
constexpr int v_rd_off(int d0, int ks, int half) { return d0 * 512 + ks * 4096 + half * 2048; }
__device__ __forceinline__ int crow(int r, int hi) { return (r & 3) + 8 * (r >> 2) + 4 * hi; }
__device__ __forceinline__ unsigned cvtpk(float lo, float hi) { unsigned r; asm volatile("v_cvt_pk_bf16_f32 %0, %1, %2" : "=v"(r) : "v"(lo), "v"(hi)); return r; }
__device__ __forceinline__ void mask_tile(f32x16& p0, f32x16& p1, int dq) {
    const float NEG = -__builtin_inff();
#pragma unroll
    for (int r = 0; r < 16; ++r) { const int c = (r & 3) + 8 * (r >> 2); if (dq - c < 0) p0[r] = NEG; if (dq - c - 32 < 0) p1[r] = NEG; }
}
__device__ __forceinline__ void partialSM(f32x16& p0, f32x16& p1, float& m_reg, float& mn, float& alpha) {
    float pmax = p0[0];
#pragma unroll
    for (int r = 1; r < 16; ++r) pmax = fmaxf(pmax, p0[r]);
#pragma unroll
    for (int r = 0; r < 16; ++r) pmax = fmaxf(pmax, p1[r]);
    { auto rr = __builtin_amdgcn_permlane32_swap(__float_as_uint(pmax), __float_as_uint(pmax), false, false);
      pmax = fmaxf(__uint_as_float(rr[0]), __uint_as_float(rr[1])); }
    if (__builtin_expect(__all((pmax - m_reg) <= THR), 1)) { mn = m_reg; alpha = 1.f; }
    else { mn = fmaxf(m_reg, pmax); alpha = __builtin_amdgcn_exp2f(m_reg - mn); m_reg = mn; }
#pragma unroll
    for (int r = 0; r < 16; ++r) p0[r] = p0[r] - mn;
#pragma unroll
    for (int r = 0; r < 16; ++r) p1[r] = p1[r] - mn;
#pragma unroll
    for (int r = 0; r < 16; ++r) p0[r] = __builtin_amdgcn_exp2f(p0[r]);
}
__device__ __forceinline__ void finishSM(f32x16& p0, f32x16& p1, float alpha, float& l_reg, bf16x8& pa0, bf16x8& pa1, bf16x8& pa2, bf16x8& pa3) {
#pragma unroll
    for (int r = 0; r < 16; ++r) p1[r] = __builtin_amdgcn_exp2f(p1[r]);
    float ps = 0;
#pragma unroll
    for (int r = 0; r < 16; ++r) ps += p0[r];
#pragma unroll
    for (int r = 0; r < 16; ++r) ps += p1[r];
    { auto rr = __builtin_amdgcn_permlane32_swap(__float_as_uint(ps), __float_as_uint(ps), false, false);
      ps = __uint_as_float(rr[0]) + __uint_as_float(rr[1]); }
    l_reg = l_reg * alpha + ps;
#define PK4(P, B_, OUT) do { unsigned a0 = cvtpk(P[B_+0], P[B_+1]), a1 = cvtpk(P[B_+2], P[B_+3]);                          \
        unsigned b0 = cvtpk(P[B_+4], P[B_+5]), b1 = cvtpk(P[B_+6], P[B_+7]);                                             \
        auto r0 = __builtin_amdgcn_permlane32_swap(a0, b0, false, false); auto r1 = __builtin_amdgcn_permlane32_swap(a1, b1, false, false); \
        u32x4 w = {r0[0], r1[0], r0[1], r1[1]}; OUT = *reinterpret_cast<bf16x8*>(&w); } while (0)
    PK4(p0, 0, pa0); PK4(p0, 8, pa1); PK4(p1, 0, pa2); PK4(p1, 8, pa3);
#undef PK4
}
template <int KB>
__device__ __forceinline__ void qkt(f32x16& p0, f32x16& p1, const char* K_lds, int r32, int hi, const bf16x8* qr) {
    p0 = f32x16{}; p1 = f32x16{};
    const char* kb[4];
#pragma unroll
    for (int dd = 0; dd < 4; ++dd) kb[dd] = K_lds + KB * SHM_K + KSWZ(r32, (dd * 16 + hi * 8) * 2);
#pragma unroll
    for (int d0 = 0; d0 < 12; ++d0) { const char* a = kb[d0 & 3] + (d0 >> 2) * 128;
        bf16x8 b0 = *reinterpret_cast<const bf16x8*>(a);
        bf16x8 b1 = *reinterpret_cast<const bf16x8*>(a + 32 * KROW);
        p0 = __builtin_amdgcn_mfma_f32_32x32x16_bf16(b0, qr[d0], p0, 0, 0, 0);
        p1 = __builtin_amdgcn_mfma_f32_32x32x16_bf16(b1, qr[d0], p1, 0, 0, 0); }
}
template <int VB>
__device__ __forceinline__ void pv_tile(f32x16* o, int vb0, bf16x8 pa0, bf16x8 pa1, bf16x8 pa2, bf16x8 pa3) {
#define TRRD(dst, off) asm volatile("ds_read_b64_tr_b16 %0, %1 offset:%2" : "=v"(dst) : "v"(vb0), "i"(off) : "memory")
#define PV_RD(S, d0) do { constexpr int b_ = VB * SHM_V + v_rd_off(d0, 0, 0); \
        TRRD(S##l0, b_); TRRD(S##h0, b_ + 2048); TRRD(S##l1, b_ + 4096); TRRD(S##h1, b_ + 6144); TRRD(S##l2, b_ + 8192); TRRD(S##h2, b_ + 10240); TRRD(S##l3, b_ + 12288); TRRD(S##h3, b_ + 14336); } while (0)
#define PV_MM(S, d0) do { \
        o[d0] = __builtin_amdgcn_mfma_f32_32x32x16_bf16(pa0, (bf16x8){S##l0[0], S##l0[1], S##l0[2], S##l0[3], S##h0[0], S##h0[1], S##h0[2], S##h0[3]}, o[d0], 0, 0, 0);   \
        o[d0] = __builtin_amdgcn_mfma_f32_32x32x16_bf16(pa1, (bf16x8){S##l1[0], S##l1[1], S##l1[2], S##l1[3], S##h1[0], S##h1[1], S##h1[2], S##h1[3]}, o[d0], 0, 0, 0);   \
        o[d0] = __builtin_amdgcn_mfma_f32_32x32x16_bf16(pa2, (bf16x8){S##l2[0], S##l2[1], S##l2[2], S##l2[3], S##h2[0], S##h2[1], S##h2[2], S##h2[3]}, o[d0], 0, 0, 0);   \
        o[d0] = __builtin_amdgcn_mfma_f32_32x32x16_bf16(pa3, (bf16x8){S##l3[0], S##l3[1], S##l3[2], S##l3[3], S##h3[0], S##h3[1], S##h3[2], S##h3[3]}, o[d0], 0, 0, 0); } while (0)
#define PV_WAIT(n) do { asm volatile("s_waitcnt lgkmcnt(" #n ")" ::: "memory"); SBAR(); } while (0)
    s16x4 Al0, Al1, Al2, Al3, Ah0, Ah1, Ah2, Ah3, Bl0, Bl1, Bl2, Bl3, Bh0, Bh1, Bh2, Bh3;
    asm volatile("s_waitcnt lgkmcnt(0)" ::: "memory"); SBAR();
    PV_RD(A, 0); PV_RD(B, 1);
    PV_WAIT(8); PV_MM(A, 0); SBAR(); PV_RD(A, 2);
    PV_WAIT(8); PV_MM(B, 1); SBAR(); PV_RD(B, 3);
    PV_WAIT(8); PV_MM(A, 2);
    PV_WAIT(0); PV_MM(B, 3); SBAR();
#undef PV_RD
#undef PV_MM
#undef PV_WAIT
#undef TRRD
}
struct Ref { const bf16_t* Q; const bf16_t* K; const bf16_t* V; bf16_t* O; float* ml; int P0, j_lo, j_hi; };
#define VMW() asm volatile("s_waitcnt vmcnt(0)" ::: "memory")
#define LD8(p) (*reinterpret_cast<const bf16x8*>(p))
#define STG_IDX() int tl_ = tid; asm volatile("" : "+v"(tl_)); const int sr = tl_ >> 4, sc = (tl_ & 15) * 8; \
        const int kr0 = tl_ / 24, kc0 = (tl_ % 24) * 8, kr1 = (tl_ + 512) / 24, kc1 = ((tl_ + 512) % 24) * 8, kr2 = (tl_ + 1024) / 24, kc2 = ((tl_ + 1024) % 24) * 8
#define SLOAD_H(k0) do { STG_IDX(); st_v0 = LD8(Vh + (size_t)((k0) + sr) * LDV + sc); st_v1 = LD8(Vh + (size_t)((k0) + 32 + sr) * LDV + sc); \
        st_k0 = LD8(Kh + (size_t)((k0) + kr0) * LDK + kc0); st_k1 = LD8(Kh + (size_t)((k0) + kr1) * LDK + kc1); st_k2 = LD8(Kh + (size_t)((k0) + kr2) * LDK + kc2); } while (0)
#define SWRITE_H(bf) do { STG_IDX(); *(bf16x8*)(V_lds + (bf) * SHM_V + v_st(sr, sc)) = st_v0; *(bf16x8*)(V_lds + (bf) * SHM_V + v_st(32 + sr, sc)) = st_v1; \
        *(bf16x8*)(K_lds + (bf) * SHM_K + KSWZ(kr0, kc0 * 2)) = st_k0; *(bf16x8*)(K_lds + (bf) * SHM_K + KSWZ(kr1, kc1 * 2)) = st_k1; *(bf16x8*)(K_lds + (bf) * SHM_K + KSWZ(kr2, kc2 * 2)) = st_k2; } while (0)
__device__ __forceinline__ void unit(const Ref& cur, char* lds, int wid, int lane, int xv) {
    const int r32 = lane & 31, hi = lane >> 5;
    const int j_lo = cur.j_lo, NT = cur.j_hi - cur.j_lo;
    const int qlo = cur.P0 + wid * QBLK, qm = qlo + r32 - 4 * hi;
    constexpr int STG = SHM_V + SHM_K;
    float* ws = (float*)(lds + 2 * STG) + wid * 64; float* li_l = ws, * al_l = ws + 32;
    const int vb0 = (int)(uintptr_t)lds + v_rd_base(lane);
    unsigned soff[5];
#pragma unroll
    for (int i = 0; i < 5; ++i) { const int p = wid + 8 * i;
        if (p < 16) { const int st = p * 2 + (lane >> 5), kk = (st >> 2) * 8 + ((lane & 31) >> 2), k = (kk & ~0xC) | ((kk & 4) << 1) | ((kk & 8) >> 1), c = (st & 3) * 32 + (lane & 3) * 8; soff[i] = (unsigned)(k * LDV + c); }
        else { const int o = (p - 16) * 1024 + lane * 16, row = o / KROW, cb = (o % KROW) ^ (((row >> 1) & 7) << 4); soff[i] = (unsigned)(row * LDK + (cb >> 1)); } }
    const bf16_t* Kh = cur.K; const bf16_t* Vh = cur.V;
#define DMA_TILE(kb, stg) do { _Pragma("unroll") for (int i = 0; i < 5; ++i) { const int p = wid + 8 * i; \
        const bf16_t* src = (p < 16 ? Vh + (size_t)(kb) * LDV : Kh + (size_t)(kb) * LDK) + soff[i]; \
        __builtin_amdgcn_global_load_lds((const unsigned*)src, (LAS unsigned*)(lds + (stg) + p * 1024), 16, 0, 0); } } while (0)
    DMA_TILE(j_lo * KVBLK, 0);
    bf16x8 qr[12];
#pragma unroll
    for (int d0 = 0; d0 < 12; ++d0) qr[d0] = LD8(cur.Q + (size_t)(wid * QBLK + r32) * LDQ + d0 * 16 + hi * 8);
    __syncthreads();
    float m_reg = -1e30f, l_reg = 0; f32x16 o[4] = {};
    for (int t = 0; t < NT; ++t) {
        const int kb_ = (j_lo + t) * KVBLK, sc_ = (t & 1) * STG;
        if (t + 1 < NT) DMA_TILE(kb_ + KVBLK, STG - sc_);
        SBAR();
        f32x16 p0 = f32x16{}, p1 = f32x16{};
        if (xv != 7) {
            const int kbase = (int)(uintptr_t)lds + sc_ + SHM_V; int ka[4];
#pragma unroll
            for (int dd = 0; dd < 4; ++dd) ka[dd] = kbase + KSWZ(r32, (dd * 16 + hi * 8) * 2);
            bf16x8 fa0, fa1, fa2, fa3, fb0, fb1, fb2, fb3;
#define KRD(dst, d0, half) asm volatile("ds_read_b128 %0, %1 offset:%2" : "=v"(dst) : "v"(ka[(d0) & 3]), "i"(((d0) >> 2) * 128 + (half) * 32 * KROW) : "memory")
#define KISSUE(f0, f1, f2, f3, j) do { KRD(f0, 2 * (j), 0); KRD(f1, 2 * (j), 1); KRD(f2, 2 * (j) + 1, 0); KRD(f3, 2 * (j) + 1, 1); } while (0)
#define KMMA(f0, f1, f2, f3, j) do { p0 = __builtin_amdgcn_mfma_f32_32x32x16_bf16(f0, qr[2 * (j)], p0, 0, 0, 0); p1 = __builtin_amdgcn_mfma_f32_32x32x16_bf16(f1, qr[2 * (j)], p1, 0, 0, 0); \
            p0 = __builtin_amdgcn_mfma_f32_32x32x16_bf16(f2, qr[2 * (j) + 1], p0, 0, 0, 0); p1 = __builtin_amdgcn_mfma_f32_32x32x16_bf16(f3, qr[2 * (j) + 1], p1, 0, 0, 0); } while (0)
#define KWAIT(n) do { asm volatile("s_waitcnt lgkmcnt(" #n ")" ::: "memory"); SBAR(); } while (0)
            asm volatile("s_waitcnt lgkmcnt(0)" ::: "memory"); SBAR();
            KISSUE(fa0, fa1, fa2, fa3, 0); KISSUE(fb0, fb1, fb2, fb3, 1);
            KWAIT(4); KMMA(fa0, fa1, fa2, fa3, 0); SBAR(); KISSUE(fa0, fa1, fa2, fa3, 2);
            KWAIT(4); KMMA(fb0, fb1, fb2, fb3, 1); SBAR(); KISSUE(fb0, fb1, fb2, fb3, 3);
            KWAIT(4); KMMA(fa0, fa1, fa2, fa3, 2); SBAR(); KISSUE(fa0, fa1, fa2, fa3, 4);
            KWAIT(4); KMMA(fb0, fb1, fb2, fb3, 3); SBAR(); KISSUE(fb0, fb1, fb2, fb3, 5);
            KWAIT(4); KMMA(fa0, fa1, fa2, fa3, 4);
            KWAIT(0); KMMA(fb0, fb1, fb2, fb3, 5); SBAR();
#undef KRD
#undef KISSUE
#undef KMMA
#undef KWAIT
        }
        if (kb_ + KVBLK - 1 > qlo) mask_tile(p0, p1, qm - kb_);
        float mn, alpha; bf16x8 pa0, pa1, pa2, pa3;
        partialSM(p0, p1, m_reg, mn, alpha);
        finishSM(p0, p1, alpha, l_reg, pa0, pa1, pa2, pa3);
        if (__any(alpha < 1.f)) { if (hi == 0) al_l[r32] = alpha; asm volatile("s_waitcnt lgkmcnt(0)" ::: "memory");
#pragma unroll
            for (int d_ = 0; d_ < 4; ++d_)
#pragma unroll
                for (int r = 0; r < 16; ++r) o[d_][r] *= al_l[crow(r, hi)]; }
        SBAR();
        if (xv != 5) pv_tile<0>(o, vb0 + sc_, pa0, pa1, pa2, pa3);
        __syncthreads();
    }
#undef DMA_TILE
    if (hi == 0) li_l[r32] = l_reg; asm volatile("s_waitcnt lgkmcnt(0)" ::: "memory");
    float rli[16];
#pragma unroll
    for (int r = 0; r < 16; ++r) { const float lv = li_l[crow(r, hi)]; rli[r] = lv > 0.f ? __builtin_amdgcn_rcpf(lv) : 0.f; }
    bf16_t* Ow = cur.O + (size_t)(wid * QBLK) * LDO;
#pragma unroll
    for (int r = 0; r < 16; ++r) { const int orow = crow(r, hi);
#pragma unroll
        for (int d0 = 0; d0 < 4; ++d0) { const float v = o[d0][r] * rli[r]; const float vn = __shfl_xor(v, 1);
            if ((r32 & 1) == 0) *(unsigned*)(Ow + (size_t)orow * LDO + d0 * 32 + r32) = cvtpk(v, vn); } }
    if (hi == 0) { float* mp = cur.ml + (size_t)(wid * QBLK + r32) * 16; mp[0] = m_reg; mp[1] = l_reg; }
    __syncthreads();
}
#undef VMW
#undef LD8
#undef SLOAD_H
#undef SWRITE_H
#undef STG_IDX
#undef KSWZ
#undef SBAR
}
__device__ __forceinline__ att::Ref attn_ref(const Params& P, int h, int qb, int sp) {
    att::Ref r; const int q0 = qb * 256;
    r.Q = WSP(bf16_t, WS_QB) + (size_t)q0 * 1536 + h * 192; r.K = WSP(bf16_t, WS_KB) + h * 192; r.V = WSP(bf16_t, WS_VB) + h * 128;
    r.O = WSP(bf16_t, WS_OPART) + (size_t)sp * S_ * 1024 + (size_t)q0 * 1024 + h * 128; r.ml = WSP(float, WS_ML) + (size_t)sp * S_ * 16 + ((size_t)q0 * 8 + h) * 2;
    r.P0 = q0; r.j_lo = sp ? 2 * (qb + 1) : 0; r.j_hi = sp ? 4 * (qb + 1) : 2 * (qb + 1); return r;
}
__device__ __forceinline__ void attn_run(const Params& P, int wg, int nwg, int wv, char* lds) {
    const int lane = lane_id_();
    for (int rp_ = (XPROBE >= 4 ? 0 : 1); rp_ < 2; ++rp_)
    for (int pi = wg; pi < 256; pi += nwg) {
        const int h = pi & 7, j = pi >> 3; const int xv = rp_ == 0 ? XPROBE : 0;
        for (int k = 0; k < 2; ++k) { const att::Ref u = attn_ref(P, h, k ? 31 - j : j, k); att::unit(u, lds, wv, lane, xv); }
    }
}

namespace hg {
typedef short bf16x8 __attribute__((ext_vector_type(8)));
constexpr int RS64 = 144, RS128 = 272;
__device__ __forceinline__ void prep_f(const bf16_t* pr, int col, float lbk, float (&cs)[16], float (&kk)[16]) {
    float run = 0.f;
#pragma unroll
    for (int j = 0; j < 16; ++j) { const float hf = bf2f(pr[(size_t)j * DINP + col]); const float f = lbk + (1.f - lbk) * sigmoidf_(hf); kk[j] = 1.f - f; run += __logf(f); cs[j] = run; }
}
__device__ __forceinline__ void store_iT(const bf16_t* pr, int col, LAS unsigned char* iT, int k, int seg) {
    unsigned w[8];
#pragma unroll
    for (int j = 0; j < 8; ++j) w[j] = (unsigned)pr[(size_t)(2 * j) * DINP + col] | ((unsigned)pr[(size_t)(2 * j + 1) * DINP + col] << 16);
    *(LAS u32x4*)(iT + k * RS64 + seg * 32) = (u32x4){w[0], w[1], w[2], w[3]}; *(LAS u32x4*)(iT + k * RS64 + seg * 32 + 16) = (u32x4){w[4], w[5], w[6], w[7]};
}
__device__ __forceinline__ void h1_unit(const Params& P, int c, int h, LAS unsigned char* lds, int wv, int lane) {
    const int tid = wv * 64 + lane, k = tid & 127, seg = tid >> 7, fr = lane & 15, fq = lane >> 4;
    LAS unsigned char* kbT = lds; LAS unsigned char* iT = lds + 18432; LAS float* segtot = (LAS float*)(lds + 36864);
    const bf16_t* pr = WSP(bf16_t, WS_PROJ) + (size_t)(c * 64 + seg * 16) * DINP;
    float cs[16], kk[16];
    prep_f(pr, PC_HF + h * 128 + k, WSP(float, WS_LB)[h * 128 + k], cs, kk);
    segtot[seg * 128 + k] = cs[15];
    store_iT(pr, PC_HI + h * 128 + k, iT, k, seg);
    __syncthreads();
    float off = 0.f, tot = 0.f;
#pragma unroll
    for (int s2 = 0; s2 < 4; ++s2) { const float v = segtot[s2 * 128 + k]; tot += v; off += (s2 < seg) ? v : 0.f; }
    unsigned w[8];
#pragma unroll
    for (int j = 0; j < 8; ++j) w[j] = pk2(kk[2 * j] * __expf(tot - (off + cs[2 * j])), kk[2 * j + 1] * __expf(tot - (off + cs[2 * j + 1])));
    *(LAS u32x4*)(kbT + k * RS64 + seg * 32) = (u32x4){w[0], w[1], w[2], w[3]}; *(LAS u32x4*)(kbT + k * RS64 + seg * 32 + 16) = (u32x4){w[4], w[5], w[6], w[7]};
    if (seg == 0) WSP(float, WS_DVEC)[(c * 8 + h) * 128 + k] = __expf(tot);
    __syncthreads();
    f32x4 acc[8];
#pragma unroll
    for (int nt = 0; nt < 8; ++nt) acc[nt] = (f32x4){0.f, 0.f, 0.f, 0.f};
#pragma unroll
    for (int ks = 0; ks < 2; ++ks) { const bf16x8 a = *(const LAS bf16x8*)(kbT + (16 * wv + fr) * RS64 + ks * 64 + fq * 16);
#pragma unroll
        for (int nt = 0; nt < 8; ++nt) { const bf16x8 b = *(const LAS bf16x8*)(iT + (16 * nt + fr) * RS64 + ks * 64 + fq * 16);
            acc[nt] = __builtin_amdgcn_mfma_f32_16x16x32_bf16(a, b, acc[nt], 0, 0, 0); } }
    bf16_t* Lst = WSP(bf16_t, WS_LST) + (size_t)(c * 8 + h) * 16384;
#pragma unroll
    for (int nt = 0; nt < 8; ++nt) st_bf4(Lst + (16 * nt + fr) * 128 + 16 * wv + 4 * fq, acc[nt]);
    __syncthreads();
}
__device__ __forceinline__ void scan_run(const Params& P, int wg, int nwg, int wv) {
    const bf16_t* Lst = WSP(bf16_t, WS_LST); bf16_t* Sst = WSP(bf16_t, WS_SST); const float* dvec = WSP(float, WS_DVEC);
    for (int e = wg * 512 + wv * 64 + lane_id_(); e < 8 * 16384; e += nwg * 512) {
        const int h = e >> 14, k = e & 127; float S = 0.f;
#pragma unroll 8
        for (int c = 0; c < 128; ++c) { const float L = bf2f(Lst[(size_t)c * 131072 + e]); const float d = dvec[(c * 8 + h) * 128 + k];
            Sst[(size_t)c * 131072 + e] = (bf16_t)f2bf(S); S = d * S + L; }
    }
}
__device__ __forceinline__ void h3_unit(const Params& P, int c, int h, LAS unsigned char* lds, int wv, int lane) {
    const int tid = wv * 64 + lane, k = tid & 127, seg = tid >> 7, fr = lane & 15, fq = lane >> 4;
    LAS unsigned char* qbL = lds; LAS unsigned char* kiL = lds + 17408; LAS unsigned char* iT = lds + 34816; LAS unsigned char* Am = lds + 53248;
    LAS float* segtot = (LAS float*)(lds + 62464); LAS float* rowss = (LAS float*)(lds + 64512);
    const bf16_t* pr = WSP(bf16_t, WS_PROJ) + (size_t)(c * 64 + seg * 16) * DINP;
    float cs[16], kk[16];
    prep_f(pr, PC_HF + h * 128 + k, WSP(float, WS_LB)[h * 128 + k], cs, kk);
    segtot[seg * 128 + k] = cs[15];
    store_iT(pr, PC_HI + h * 128 + k, iT, k, seg);
    __syncthreads();
    float off = 0.f;
#pragma unroll
    for (int s2 = 0; s2 < 4; ++s2) { const float v = segtot[s2 * 128 + k]; off += (s2 < seg) ? v : 0.f; }
#pragma unroll
    for (int j = 0; j < 16; ++j) { const float b = off + cs[j]; const float q = siluf_(bf2f(pr[(size_t)j * DINP + PC_HQ + h * 128 + k]));
        *(LAS bf16_t*)(qbL + (seg * 16 + j) * RS128 + k * 2) = (bf16_t)f2bf(q * __expf(b));
        *(LAS bf16_t*)(kiL + (seg * 16 + j) * RS128 + k * 2) = (bf16_t)f2bf(kk[j] * __expf(fminf(-b, 80.f))); }
    __syncthreads();
    { const int mt = wv >> 1;
#pragma unroll
      for (int q = 0; q < 2; ++q) { const int nt = (wv & 1) * 2 + q; f32x4 acc = {0.f, 0.f, 0.f, 0.f};
          if (nt <= mt) {
#pragma unroll
              for (int ks = 0; ks < 4; ++ks) { const bf16x8 a = *(const LAS bf16x8*)(qbL + (16 * mt + fr) * RS128 + ks * 64 + fq * 16);
                  const bf16x8 b = *(const LAS bf16x8*)(kiL + (16 * nt + fr) * RS128 + ks * 64 + fq * 16);
                  acc = __builtin_amdgcn_mfma_f32_16x16x32_bf16(a, b, acc, 0, 0, 0); } }
          const int s_ = 16 * nt + fr;
#pragma unroll
          for (int r = 0; r < 4; ++r) { const int t_ = 16 * mt + 4 * fq + r; *(LAS bf16_t*)(Am + t_ * RS64 + s_ * 2) = (bf16_t)f2bf(s_ <= t_ ? acc[r] : 0.f); } } }
    __syncthreads();
    const int mt = wv & 3, ntb = (wv >> 2) * 4;
    f32x4 acc[4];
#pragma unroll
    for (int q = 0; q < 4; ++q) acc[q] = (f32x4){0.f, 0.f, 0.f, 0.f};
#pragma unroll
    for (int ks = 0; ks < 2; ++ks) { const bf16x8 a = *(const LAS bf16x8*)(Am + (16 * mt + fr) * RS64 + ks * 64 + fq * 16);
#pragma unroll
        for (int q = 0; q < 4; ++q) { const bf16x8 b = *(const LAS bf16x8*)(iT + (16 * (ntb + q) + fr) * RS64 + ks * 64 + fq * 16);
            acc[q] = __builtin_amdgcn_mfma_f32_16x16x32_bf16(a, b, acc[q], 0, 0, 0); } }
    const bf16_t* Sst = WSP(bf16_t, WS_SST) + (size_t)(c * 8 + h) * 16384;
#pragma unroll
    for (int ks = 0; ks < 4; ++ks) { const bf16x8 a = *(const LAS bf16x8*)(qbL + (16 * mt + fr) * RS128 + ks * 64 + fq * 16);
#pragma unroll
        for (int q = 0; q < 4; ++q) { const bf16x8 b = *(const bf16x8*)(Sst + (16 * (ntb + q) + fr) * 128 + ks * 32 + fq * 8);
            acc[q] = __builtin_amdgcn_mfma_f32_16x16x32_bf16(a, b, acc[q], 0, 0, 0); } }
    float ss[4];
#pragma unroll
    for (int r = 0; r < 4; ++r) { float v = 0.f;
#pragma unroll
        for (int q = 0; q < 4; ++q) v += acc[q][r] * acc[q][r];
        v += __shfl_xor(v, 1); v += __shfl_xor(v, 2); v += __shfl_xor(v, 4); v += __shfl_xor(v, 8); ss[r] = v; }
    if (fr == 0) {
#pragma unroll
        for (int r = 0; r < 4; ++r) rowss[(wv >> 2) * 64 + 16 * mt + 4 * fq + r] = ss[r]; }
    __syncthreads();
    bf16_t* ymix = WSP(bf16_t, WS_YMIX); const bf16_t* prow = WSP(bf16_t, WS_PROJ);
#pragma unroll
    for (int r = 0; r < 4; ++r) { const int t_ = 16 * mt + 4 * fq + r; const float rs = 1.f / sqrtf((rowss[t_] + rowss[64 + t_]) * (1.f / 128.f) + EPS);
        const size_t row = (size_t)(c * 64 + t_);
#pragma unroll
        for (int q = 0; q < 4; ++q) { const int v_ = 16 * (ntb + q) + fr; const float g = bf2f(prow[row * DINP + PC_HG + h * 128 + v_]);
            ymix[row * D_ + 1024 + h * 128 + v_] = (bf16_t)f2bf(acc[q][r] * rs * siluf_(g)); } }
    __syncthreads();
}
__device__ __forceinline__ void h1_run(const Params& P, int wg, int nwg, int wv, LAS unsigned char* lds) { const int lane = lane_id_(); for (int u = wg; u < 1024; u += nwg) h1_unit(P, u >> 3, u & 7, lds, wv, lane); }
__device__ __forceinline__ void h3_run(const Params& P, int wg, int nwg, int wv, LAS unsigned char* lds) { const int lane = lane_id_(); for (int u = wg; u < 1024; u += nwg) h3_unit(P, u >> 3, u & 7, lds, wv, lane); }
}

__device__ __forceinline__ void route_mfma_run(const Params& P, int wg, int nwg, int wv, LAS unsigned char* lds) {
    const int lane = lane_id_(), r = lane & 15, g = lane >> 4, tt = wv & 1, kq = wv >> 1;
    LAS float* part = (LAS float*)lds;
    const float* h1 = P.out; const f32x4* WrF = WSP(f32x4, WS_WR); const float* part1 = WSP(float, WS_PART1);
    int* cnt = WSP(int, WS_CTL); int* list = WSP(int, WS_LIST); int* eid = WSP(int, WS_EID); float* ew = WSP(float, WS_EW); float* rstd1 = WSP(float, WS_RSTD1);
    for (int tb = wg; tb < S_ / 32; tb += nwg) {
        const float* arow = h1 + (size_t)(tb * 32 + tt * 16 + r) * D_ + kq * 512 + 4 * g;
        const f32x4* wf = WrF + (size_t)(kq * 32) * 5 * 64 + lane;
        f32x4 acc[5];
#pragma unroll
        for (int t5 = 0; t5 < 5; ++t5) acc[t5] = (f32x4){0.f, 0.f, 0.f, 0.f};
#pragma unroll 2
        for (int kb = 0; kb < 32; ++kb) { const f32x4 a = *(const f32x4*)(arow + kb * 16);
#pragma unroll
            for (int t5 = 0; t5 < 5; ++t5) { const f32x4 b = wf[(kb * 5 + t5) * 64];
                acc[t5] = __builtin_amdgcn_mfma_f32_16x16x4f32(a.x, b.x, acc[t5], 0, 0, 0); acc[t5] = __builtin_amdgcn_mfma_f32_16x16x4f32(a.y, b.y, acc[t5], 0, 0, 0);
                acc[t5] = __builtin_amdgcn_mfma_f32_16x16x4f32(a.z, b.z, acc[t5], 0, 0, 0); acc[t5] = __builtin_amdgcn_mfma_f32_16x16x4f32(a.w, b.w, acc[t5], 0, 0, 0); } }
#pragma unroll
        for (int t5 = 0; t5 < 5; ++t5)
#pragma unroll
            for (int q = 0; q < 4; ++q) part[wv * 1280 + (4 * g + q) * 80 + 16 * t5 + r] = acc[t5][q];
        __syncthreads();
        if (wv == 0 && lane < 32) {
            const int t = tb * 32 + lane, t2 = lane >> 4, tr = lane & 15; const LAS float* pp = part + t2 * 1280 + tr * 80;
#define LG(j) ((pp[(j)] + pp[2560 + (j)]) + (pp[5120 + (j)] + pp[7680 + (j)]))
            float ss = 0.f; { const f32x4* p4 = (const f32x4*)(part1 + (size_t)t * 32);
#pragma unroll
                for (int i = 0; i < 8; ++i) { const f32x4 v = p4[i]; ss += (v.x + v.y) + (v.z + v.w); } }
            const float rs = 1.f / sqrtf(ss * (1.f / D_) + EPS);
            rstd1[t] = rs;
            int gi = 0; float gm = -INFINITY;
            for (int i = 0; i < 8; ++i) { const float v = LG(i) * rs + P.b_rg[i]; if (v > gm) { gm = v; gi = i; } }
            float gs = 0.f; for (int i = 0; i < 8; ++i) gs += expf(LG(i) * rs + P.b_rg[i] - gm);
            const float gw_ = 1.f / gs;
            int i1 = 0, i2 = 0; float l1 = -INFINITY, l2 = -INFINITY;
            for (int i = 0; i < 8; ++i) { const float e = LG(8 + gi * 8 + i) * rs + P.b_re[gi * 8 + i];
                if (e > l1) { l2 = l1; i2 = i1; l1 = e; i1 = i; } else if (e > l2) { l2 = e; i2 = i; } }
#undef LG
            const float p2 = expf(l2 - l1), w1 = gw_ / (1.f + p2), w2 = gw_ * p2 / (1.f + p2);
            const int e1 = gi * 8 + i1, e2 = gi * 8 + i2;
            eid[2 * t] = e1; eid[2 * t + 1] = e2; ew[2 * t] = w1; ew[2 * t + 1] = w2;
            const int p1 = atomicAdd(&cnt[e1], 1); list[e1 * LISTCAP + p1] = 2 * t;
            const int q2 = atomicAdd(&cnt[e2], 1); list[e2 * LISTCAP + q2] = 2 * t + 1;
        }
        __syncthreads();
    }
}

constexpr int LDS_TAB = 131072;
__device__ __forceinline__ int moe_build_tab(const int* cnt, LAS unsigned char* lds, int wv) {
    LAS int* tab = (LAS int*)(lds + LDS_TAB);
    if (wv == 0 && lane_id_() == 0) { int nt = 0;
        for (int e = 0; e < NE; ++e) { const int n = cnt[e]; for (int r = 0; r * 256 < n; ++r) { tab[1 + nt] = e; tab[129 + nt] = r; ++nt; } }
        tab[0] = nt; }
    __syncthreads();
    return __builtin_amdgcn_readfirstlane(tab[0]);
}
struct MoeOrder {
    const int* cnt; const int* list; LAS const int* tab; int ntiles, npn, G, c; const char* A; const char* B; size_t bexp, btile, atile; bool gather;
    __device__ __forceinline__ bool next(int i, pg8::Unit& u) const {
        const int L = i * G + c; if (L >= ntiles * npn) return false;
        const int tile = L / npn, pn = L - tile * npn;
        const int e = __builtin_amdgcn_readfirstlane(tab[1 + tile]), rt = __builtin_amdgcn_readfirstlane(tab[129 + tile]);
        u.pm = tile; u.pn = pn; u.x0 = e; u.x1 = rt * 256; u.x2 = __builtin_amdgcn_readfirstlane(cnt[e]);
        u.b = B + (size_t)e * bexp + (size_t)pn * btile; u.a = gather ? A : A + (size_t)tile * atile; return true;
    }
    __device__ __forceinline__ unsigned row_off(const pg8::Unit& u, int R) const { int idx = u.x1 + R; idx = idx < u.x2 ? idx : 0; return (unsigned)(list[u.x0 * LISTCAP + idx] >> 1) * (unsigned)(D_ * 2); }
};
struct MoeUpEpi { const int* list; const float* rstd1; bf16_t* hmid;
    __device__ __forceinline__ void operator()(const f32x4 (&acc)[2][2][4][2], const pg8::Unit& u, int wr, int wc, int fr, int fq) const {
#pragma unroll
        for (int ai = 0; ai < 2; ++ai)
#pragma unroll
            for (int m = 0; m < 4; ++m) { const int r = ai * 128 + wr * 64 + m * 16 + fr; int idx = u.x1 + r; idx = idx < u.x2 ? idx : 0;
                const float rs = rstd1[list[u.x0 * LISTCAP + idx] >> 1];
#pragma unroll
                for (int n = 0; n < 2; ++n) { const f32x4 g = acc[ai][0][m][n] * rs, up = acc[ai][1][m][n] * rs;
                    const f32x4 h = {siluf_(g.x) * up.x, siluf_(g.y) * up.y, siluf_(g.z) * up.z, siluf_(g.w) * up.w};
                    st_bf4(hmid + (size_t)(u.pm * 256 + r) * DE + u.pn * 128 + wc * 32 + n * 16 + fq * 4, h); }
                asm volatile("" ::: "memory"); }
    } };
struct MoeDownEpi { const int* list; const float* ew; bf16_t* y;
    __device__ __forceinline__ void operator()(const f32x4 (&acc)[2][2][4][2], const pg8::Unit& u, int wr, int wc, int fr, int fq) const {
#pragma unroll
        for (int ai = 0; ai < 2; ++ai)
#pragma unroll
            for (int m = 0; m < 4; ++m) { const int r = ai * 128 + wr * 64 + m * 16 + fr; const int idx = u.x1 + r; const bool valid = idx < u.x2;
                const int a = list[u.x0 * LISTCAP + (valid ? idx : 0)]; const float w = ew[a];
                if (valid) {
#pragma unroll
                    for (int bj = 0; bj < 2; ++bj)
#pragma unroll
                        for (int n = 0; n < 2; ++n) st_bf4(y + (size_t)a * D_ + u.pn * 256 + bj * 128 + wc * 32 + n * 16 + fq * 4, acc[ai][bj][m][n] * w); }
                asm volatile("" ::: "memory"); }
    } };
__device__ __forceinline__ void moe_up_run(const Params& P, int wg, int nwg, int wv, LAS unsigned char* lds) {
    const int nt = moe_build_tab(WSP(int, WS_CTL), lds, wv);
    MoeOrder S{WSP(int, WS_CTL), WSP(int, WS_LIST), (LAS const int*)(lds + LDS_TAB), nt, 4, nwg, wg, (const char*)WSP(bf16_t, WS_H1B), (const char*)WSP(bf16_t, WS_WGU), (size_t)1024 * 2048 * 2, (size_t)256 * 2048 * 2, 0, true};
    MoeUpEpi E{WSP(int, WS_LIST), WSP(float, WS_RSTD1), WSP(bf16_t, WS_HMID)};
    int K = D_, lda = D_; asm volatile("" : "+s"(K), "+s"(lda));
    pg8::gemm_phase<MoeUpEpi, MoeOrder, true>(lds, K, lda, S, E, wv);
}
__device__ __forceinline__ void moe_down_run(const Params& P, int wg, int nwg, int wv, LAS unsigned char* lds) {
    const int nt = moe_build_tab(WSP(int, WS_CTL), lds, wv);
    MoeOrder S{WSP(int, WS_CTL), WSP(int, WS_LIST), (LAS const int*)(lds + LDS_TAB), nt, 8, nwg, wg, (const char*)WSP(bf16_t, WS_HMID), (const char*)WSP(bf16_t, WS_WD), (size_t)2048 * DE * 2, (size_t)256 * DE * 2, (size_t)256 * DE * 2, false};
    MoeDownEpi E{WSP(int, WS_LIST), WSP(float, WS_EW), WSP(bf16_t, WS_Y)};
    int K = DE, lda = DE; asm volatile("" : "+s"(K), "+s"(lda));
    pg8::gemm_phase<MoeDownEpi, MoeOrder, false>(lds, K, lda, S, E, wv);
}

namespace rsg {
typedef short bf16x8 __attribute__((ext_vector_type(8)));
constexpr int MR = 320, MF = 5, ABUF = MR * 128, BBUF = 128 * 128, BUF = ABUF + BBUF;
__device__ __forceinline__ int swz(int row, int chunk) { return row * 128 + ((chunk ^ (row & 7)) << 4); }
__device__ __forceinline__ int swzB(int row, int chunk) { return row * 128 + ((chunk ^ ((row ^ (row >> 2)) & 7)) << 4); }
template <bool UP, class Epi>
__device__ __forceinline__ void tile(LAS unsigned char* lds, const char* abase, const unsigned (&aoff)[MF], const float* Bg, const float* Bu, const float* gain, int ldn, int K, int nrows, const Epi& E, int wv, int lane) {
    const int tid = wv * 64 + lane, wr = wv >> 1, wc = wv & 1, fr = lane & 15, fq = lane >> 4;
    const int ach = tid & 7, arow = tid >> 3;
    const int bn4 = tid & 31, bkq = tid >> 5;
    const float* bsrc = ((UP && bn4 >= 16) ? Bu + 4 * (bn4 - 16) : Bg + 4 * bn4) + (size_t)(4 * bkq) * ldn;
    const int nk = K / 64;
    const int mcount = (nrows - 16 * MF * wr + 15) >> 4;
    u32x4 sa[MF]; f32x4 sb0[4], sb1[4];
#define RS_LOADA(kt) do { _Pragma("unroll") for (int i = 0; i < MF; ++i) sa[i] = *(const u32x4*)(abase + aoff[i] + (kt) * 128 + ach * 16); } while (0)
#define RS_LOADB(SB, kt) do { _Pragma("unroll") for (int j = 0; j < 4; ++j) SB[j] = *(const f32x4*)(bsrc + (size_t)((kt) * 64 + j) * ldn); } while (0)
#define RS_WRITE(SB, kt, bf) do { LAS unsigned char* Ab = lds + (bf) * BUF; LAS unsigned char* Bb = Ab + ABUF; \
        _Pragma("unroll") for (int i = 0; i < MF; ++i) *(LAS u32x4*)(Ab + swz(arow + 64 * i, ach)) = sa[i]; \
        f32x4 g_ = {1.f, 1.f, 1.f, 1.f}; if (UP) g_ = *(const LAS f32x4*)(lds + 114688 + ((kt) * 64 + 4 * bkq) * 4);     \
        _Pragma("unroll") for (int c = 0; c < 4; ++c) { u32x2 w; w.x = pk2(SB[0][c] * g_.x, SB[1][c] * g_.y); w.y = pk2(SB[2][c] * g_.z, SB[3][c] * g_.w); \
            *(LAS u32x2*)(Bb + swzB(4 * bn4 + c, bkq >> 1) + (bkq & 1) * 8) = w; } } while (0)
#define RS_COMPUTE(bf) do { const LAS unsigned char* Ab = lds + (bf) * BUF; const LAS unsigned char* Bb = Ab + ABUF; \
        _Pragma("unroll") for (int ks = 0; ks < 2; ++ks) { bf16x8 b[4]; \
            _Pragma("unroll") for (int ni = 0; ni < 4; ++ni) { const int nrow = UP ? ((ni >> 1) * 64 + 32 * wc + 16 * (ni & 1)) : (64 * wc + 16 * ni); b[ni] = *(const LAS bf16x8*)(Bb + swzB(nrow + fr, ks * 4 + fq)); } \
            _Pragma("unroll") for (int mi = 0; mi < MF; ++mi) if (mi < mcount) { const bf16x8 a = *(const LAS bf16x8*)(Ab + swz(16 * MF * wr + 16 * mi + fr, ks * 4 + fq)); \
                _Pragma("unroll") for (int ni = 0; ni < 4; ++ni) acc[mi][ni] = __builtin_amdgcn_mfma_f32_16x16x32_bf16(b[ni], a, acc[mi][ni], 0, 0, 0); } } } while (0)
#define RS_STEP(t, SBfree, SBnext) do { if ((t) < nk) { if ((t) + 2 < nk) RS_LOADB(SBfree, (t) + 2); RS_COMPUTE((t) & 1); \
        if ((t) + 1 < nk) { RS_WRITE(SBnext, (t) + 1, ((t) + 1) & 1); if ((t) + 2 < nk) RS_LOADA((t) + 2); } __syncthreads(); } } while (0)
    f32x4 acc[MF][4];
#pragma unroll
    for (int mi = 0; mi < MF; ++mi)
#pragma unroll
        for (int ni = 0; ni < 4; ++ni) acc[mi][ni] = (f32x4){0.f, 0.f, 0.f, 0.f};
    RS_LOADA(0); RS_LOADB(sb0, 0); RS_LOADB(sb1, 1);
    RS_WRITE(sb0, 0, 0); RS_LOADA(1);
    __syncthreads();
    for (int t = 0; t < nk; t += 2) { RS_STEP(t, sb0, sb1); RS_STEP(t + 1, sb1, sb0); }
    E(acc, wr, wc, fr, fq);
#undef RS_LOADA
#undef RS_LOADB
#undef RS_WRITE
#undef RS_COMPUTE
#undef RS_STEP
}
}
__device__ __forceinline__ void moe_offsets(const int* cnt, LAS unsigned char* lds, int wv) {
    LAS int* off = (LAS int*)(lds + 131072);
    if (wv == 0 && lane_id_() == 0) { int a = 0; for (int e = 0; e < NE; ++e) { off[e] = a; a += cnt[e]; } off[NE] = a; }
    __syncthreads();
}
struct RsUpEpi { bf16_t* hrow0; const int* lst; int n; const float* rstd1; int c0;
    __device__ __forceinline__ void operator()(const f32x4 (&acc)[rsg::MF][4], int wr, int wc, int fr, int fq) const {
#pragma unroll
        for (int mi = 0; mi < rsg::MF; ++mi) { const int r = 16 * rsg::MF * wr + 16 * mi + fr; if (r < n) { const float rs = rstd1[lst[r] >> 1];
#pragma unroll
            for (int q = 0; q < 2; ++q) { const f32x4 g = acc[mi][q] * rs, up = acc[mi][2 + q] * rs;
                const f32x4 h = {siluf_(g.x) * up.x, siluf_(g.y) * up.y, siluf_(g.z) * up.z, siluf_(g.w) * up.w};
                st_bf4(hrow0 + (size_t)r * DE + c0 + 32 * wc + 16 * q + 4 * fq, h); } } }
    } };
struct RsDownEpi { bf16_t* y; const int* lst; int n; const float* ew; int c0;
    __device__ __forceinline__ void operator()(const f32x4 (&acc)[rsg::MF][4], int wr, int wc, int fr, int fq) const {
#pragma unroll
        for (int mi = 0; mi < rsg::MF; ++mi) { const int r = 16 * rsg::MF * wr + 16 * mi + fr; if (r < n) { const int a = lst[r]; const float w = ew[a];
#pragma unroll
            for (int ni = 0; ni < 4; ++ni) st_bf4(y + (size_t)a * D_ + c0 + 64 * wc + 16 * ni + 4 * fq, acc[mi][ni] * w); } }
    } };
__device__ __forceinline__ void moe_up_rs_run(const Params& P, int wg, int nwg, int wv, LAS unsigned char* lds) {
    const int* cnt = WSP(int, WS_CTL); const int* list = WSP(int, WS_LIST); const int lane = lane_id_(), tid = wv * 64 + lane;
    for (int i = tid; i < D_; i += 512) *(LAS float*)(lds + 114688 + i * 4) = P.ffn_norm[i];
    moe_offsets(cnt, lds, wv); LAS const int* off = (LAS const int*)(lds + 131072);
    for (int xp = 0; xp < ((XPROBE >= 1 && XPROBE <= 3) ? 2 : 1); ++xp)
    for (int u = wg; u < NE * 8; u += nwg) {
        int e = u >> 3, hs = u & 7;
        if (nwg == 256) { const int xcd = wg & 7, idx = wg >> 3; e = (u >> 8) * 32 + xcd * 4 + (idx >> 3); hs = idx & 7; } const int n = __builtin_amdgcn_readfirstlane(cnt[e]), o0 = __builtin_amdgcn_readfirstlane(off[e]);
        const int* lst = list + e * LISTCAP;
        for (int r0 = 0; r0 < n; r0 += rsg::MR) { const int nr = (n - r0) < rsg::MR ? (n - r0) : rsg::MR;
            unsigned aoff[rsg::MF];
#pragma unroll
            for (int i = 0; i < rsg::MF; ++i) { int idx = (tid >> 3) + 64 * i; idx = idx < nr ? idx : 0; aoff[i] = (XPROBE == 1 && xp) ? 0u : (unsigned)(lst[r0 + idx] >> 1) * (unsigned)(D_ * 2); }
            const int eb = (XPROBE == 2 && xp) ? 0 : e;
            RsUpEpi E{(xp ? WSP(bf16_t, WS_Y) : WSP(bf16_t, WS_HMID)) + (size_t)(o0 + r0) * DE, lst + r0, nr, WSP(float, WS_RSTD1), hs * 64};
            rsg::tile<true>(lds, (const char*)WSP(bf16_t, WS_H1B), aoff, P.w_eg + (size_t)eb * 2048 * DE + hs * 64, P.w_eu + (size_t)eb * 2048 * DE + hs * 64, P.ffn_norm, DE, D_, nr, E, wv, lane); }
    }
}
__device__ __forceinline__ void moe_down_rs_run(const Params& P, int wg, int nwg, int wv, LAS unsigned char* lds) {
    const int* cnt = WSP(int, WS_CTL); const int* list = WSP(int, WS_LIST); const int lane = lane_id_(), tid = wv * 64 + lane;
    moe_offsets(cnt, lds, wv); LAS const int* off = (LAS const int*)(lds + 131072);
    for (int u = wg; u < NE * 16; u += nwg) {
        int e = u >> 4, cs = u & 15;
        if (nwg == 256) { const int xcd = wg & 7, idx = wg >> 3; e = (u >> 8) * 16 + xcd * 2 + (idx >> 4); cs = idx & 15; } const int n = __builtin_amdgcn_readfirstlane(cnt[e]), o0 = __builtin_amdgcn_readfirstlane(off[e]);
        const int* lst = list + e * LISTCAP;
        for (int r0 = 0; r0 < n; r0 += rsg::MR) { const int nr = (n - r0) < rsg::MR ? (n - r0) : rsg::MR;
            unsigned aoff[rsg::MF];
#pragma unroll
            for (int i = 0; i < rsg::MF; ++i) { int idx = (tid >> 3) + 64 * i; idx = idx < nr ? idx : 0; aoff[i] = (unsigned)(o0 + r0 + idx) * (unsigned)(DE * 2); }
            RsDownEpi E{WSP(bf16_t, WS_Y), lst + r0, nr, WSP(float, WS_EW), cs * 128};
            rsg::tile<false>(lds, (const char*)WSP(bf16_t, WS_HMID), aoff, P.w_ed + (size_t)e * DE * 2048 + cs * 128, nullptr, nullptr, 2048, DE, nr, E, wv, lane); }
    }
}

#define XB_TMO      128
#define XB_XCNT(j)  (256  + 64 * (j))
#define XB_XSUB(j)  (1280 + 64 * (j))
#define XB_XGEN(j)  (2304 + 64 * (j))
#define XB_TOP      3328
#define XB_TOPGEN   3392
#define XCD_BAR_WORDS 3456
#define XB_SPIN_CAP (1u << 18)
__device__ __forceinline__ unsigned xb_ld(unsigned* p)              { return __hip_atomic_load(p, __ATOMIC_RELAXED, __HIP_MEMORY_SCOPE_AGENT); }
__device__ __forceinline__ unsigned xb_add(unsigned* p, unsigned v) { return __hip_atomic_fetch_add(p, v, __ATOMIC_RELAXED, __HIP_MEMORY_SCOPE_AGENT); }
__device__ __forceinline__ unsigned xb_xcc_id() { return (unsigned)__builtin_amdgcn_s_getreg((3 << 11) | 20) & 0xFu; }
#define XB_SPIN(cond, bar) do { unsigned _sp = 0; while (cond) { __builtin_amdgcn_s_sleep(1); \
    if ((++_sp & 255u) == 0u) { if (xb_ld(&(bar)[XB_TMO])) break; if (_sp > XB_SPIN_CAP) { atomicAdd(&(bar)[XB_TMO], 1u); break; } } } } while (0)
struct XcdBarrier { unsigned* bar; unsigned x; volatile LAS unsigned* st; };
__device__ __forceinline__ void xcd_barrier_complete(unsigned* bar, unsigned x, unsigned& nloc, unsigned& nx) {
    const unsigned G = gridDim.x * gridDim.y * gridDim.z;
    unsigned sum, cnt, mine, sp = 0u;
    for (;;) {
        sum = 0u; cnt = 0u; mine = 0u;
#pragma unroll
        for (unsigned j = 0; j < 16; ++j) { const unsigned c = xb_ld(&bar[XB_XCNT(j)]); sum += c; cnt += (c > 0u) ? 1u : 0u; mine = (j == x) ? c : mine; }
        if (sum == G) break;
        __builtin_amdgcn_s_sleep(1);
        if ((++sp & 255u) == 0u) { if (xb_ld(&bar[XB_TMO])) break; if (sp > XB_SPIN_CAP) { atomicAdd(&bar[XB_TMO], 1u); break; } }
    }
    nloc = mine > 0u ? mine : 1u; nx = cnt > 0u ? cnt : 1u;
}
__device__ __forceinline__ void xcd_barrier(const XcdBarrier& b, bool leader_thread) {
    asm volatile("s_waitcnt vmcnt(0)" ::: "memory");
    __syncthreads();
    if (leader_thread) {
        unsigned* bar = b.bar;
        __builtin_amdgcn_s_waitcnt(0);
        unsigned nloc = b.st[0], nx = b.st[1];
        if (nloc == 0u) { xcd_barrier_complete(bar, b.x, nloc, nx); b.st[0] = nloc; b.st[1] = nx; }
        const unsigned old = xb_add(&bar[XB_XSUB(b.x)], 1u);
        const unsigned gen = old / nloc;
        if (old + 1u == (gen + 1u) * nloc) {
            __builtin_amdgcn_fence(__ATOMIC_RELEASE, "agent");
            asm volatile("s_waitcnt vmcnt(0)" ::: "memory");
            const unsigned og = xb_add(&bar[XB_TOP], 1u);
            const unsigned tg = og / nx;
            if (og + 1u == (tg + 1u) * nx) xb_add(&bar[XB_TOPGEN], 1u);
            else XB_SPIN(xb_ld(&bar[XB_TOPGEN]) == tg, bar);
            __builtin_amdgcn_fence(__ATOMIC_ACQUIRE, "agent");
            xb_add(&bar[XB_XGEN(b.x)], 1u);
            asm volatile("s_waitcnt vmcnt(0)" ::: "memory");
        } else {
            XB_SPIN(xb_ld(&bar[XB_XGEN(b.x)]) == gen, bar);
            __builtin_amdgcn_fence(__ATOMIC_ACQUIRE, "agent");
            asm volatile("s_waitcnt vmcnt(0)" ::: "memory");
        }
    }
    __syncthreads();
}

namespace cg = cooperative_groups;
constexpr int LDS_BYTES = 147456;
constexpr int NPHASE = 12;
#ifndef DUP_PHASE
#define DUP_PHASE -1
#endif
#ifndef MK_MULTI
#define MK_MULTI 0
#endif
__global__ void __launch_bounds__(512, 2) mk_fwd(Params P, int ph_lo, int ph_hi) {
    extern __shared__ __attribute__((aligned(16))) unsigned char lds_raw[];
    LAS unsigned char* lds = (LAS unsigned char*)lds_raw;
    const int wg = blockIdx.x, nwg = gridDim.x, wv = __builtin_amdgcn_readfirstlane(threadIdx_x_raw() >> 6);
#define PH(k) if (ph_lo <= (k) && (k) < ph_hi) for (int rep_ = 0; rep_ < ((k) == DUP_PHASE ? 2 : 1); ++rep_)
    const bool leader_thread = (wv == 0 && lane_id_() == 0);
    volatile LAS unsigned* xst = (volatile LAS unsigned*)(lds + 139264);
    if (leader_thread) { xst[0] = 0u; xst[1] = 0u; }
    __syncthreads();
    XcdBarrier xbar; xbar.bar = WSP(unsigned, WS_CTL) + 4096; xbar.x = xb_xcc_id(); xbar.st = xst;
    if (leader_thread && ph_hi - ph_lo > 1) (void)xb_add(&xbar.bar[XB_XCNT(xbar.x)], 1u);
    if (ph_lo < 0) cg::this_grid().sync();
#define SEAM(k) do { if ((k) + 1 < ph_hi) xcd_barrier(xbar, leader_thread); } while (0)
    PH(0) { p0_run(P, wg, nwg, wv, lds); SEAM(0); }
    PH(1) { dense_gemm(lds, WSP(bf16_t, WS_XB), D_, WSP(bf16_t, WS_WIN), S_, DINP, D_, PFProj{WSP(bf16_t, WS_PROJ), WSP(float, WS_RSTDX), WSP(float, WS_PARTQ)}, wg, nwg, wv);
            if (nwg == 256) { if (wg >= 128) { dense_gemm(lds, WSP(bf16_t, WS_PB), PLE, WSP(bf16_t, WS_WPP), S_, D_, PLE, PFPP{WSP(bf16_t, WS_PP)}, wg - 128, 128, wv); __syncthreads(); p1_late_conv(P, (wg - 128) * 8 + wv, 1024, wv, lds); } }
            else dense_gemm(lds, WSP(bf16_t, WS_PB), PLE, WSP(bf16_t, WS_WPP), S_, D_, PLE, PFPP{WSP(bf16_t, WS_PP)}, wg, nwg, wv);
            SEAM(1); }
    PH(2) { dense_gemm(lds, WSP(bf16_t, WS_PROJ) + PC_CQ, DINP, WSP(bf16_t, WS_WUQ), S_, 1536, 512, PFQ{WSP(bf16_t, WS_QB), WSP(float, WS_PARTQ), WSP(float, WS_COS), WSP(float, WS_SIN)}, wg, nwg, wv);
            dense_gemm(lds, WSP(bf16_t, WS_PROJ) + PC_CKV, DINP, WSP(bf16_t, WS_WUKV), S_, 2048, 256, PFKV{WSP(bf16_t, WS_KB), WSP(bf16_t, WS_VB), WSP(float, WS_PARTQ)}, wg, nwg, wv);
            kpe_run(P, wg, nwg, wv); hg::h1_run(P, wg, nwg, wv, lds); SEAM(2); }
    PH(3) { hg::scan_run(P, wg, nwg, wv); attn_run(P, wg, nwg, wv, (char*)lds_raw); SEAM(3); }
    PH(4) { combine_run(P, wg, nwg, wv); hg::h3_run(P, wg, nwg, wv, lds); SEAM(4); }
    PH(5) { dense_gemm(lds, WSP(bf16_t, WS_YMIX), D_, WSP(bf16_t, WS_WOUT), S_, D_, D_, PFOut{P.x, P.out, WSP(bf16_t, WS_H1B), WSP(float, WS_PART1)}, wg, nwg, wv); SEAM(5); }
    PH(6) { route_mfma_run(P, wg, nwg, wv, lds); SEAM(6); }
    PH(7) { moe_up_rs_run(P, wg, nwg, wv, lds); SEAM(7); }
    PH(8) { moe_down_rs_run(P, wg, nwg, wv, lds); SEAM(8); }
    PH(9) { moe_combine_run(P, wg, nwg, wv); SEAM(9); }
    PH(10) { dense_gemm(lds, WSP(bf16_t, WS_H2B), D_, WSP(bf16_t, WS_WPG), S_, D_, D_, PFPle{P.out, WSP(bf16_t, WS_PP), WSP(float, WS_RSTD2), P.b_pg, WSP(float, WS_PART3)}, wg, nwg, wv); SEAM(10); }
    PH(11) { final_run(P, wg, nwg, wv); }
#undef PH
#undef SEAM
}

extern "C" void kernel_launch(void* const* d_in, const int* in_sizes, int n_in, void* d_out, int out_size, void* d_ws, size_t ws_size, hipStream_t stream) {
    if (n_in != 26 || ws_size < WS_END) { fprintf(stderr, "kernel_launch: unexpected n_in %d or ws_size %zu (< %zu)\n", n_in, ws_size, (size_t)WS_END); return; }
    static int grid = 0;
    if (grid == 0) {
        int dev = 0, cus = 0, per_cu = 0;
        (void)hipGetDevice(&dev); (void)hipDeviceGetAttribute(&cus, hipDeviceAttributeMultiprocessorCount, dev);
        (void)hipFuncSetAttribute((const void*)mk_fwd, hipFuncAttributeMaxDynamicSharedMemorySize, LDS_BYTES);
        if (hipOccupancyMaxActiveBlocksPerMultiprocessor(&per_cu, (const void*)mk_fwd, 512, LDS_BYTES) != hipSuccess || per_cu < 1) { fprintf(stderr, "kernel_launch: occupancy query says %d blocks/CU\n", per_cu); per_cu = 1; }
        (void)hipGetLastError();
        grid = cus > 0 ? cus : 256;
    }
    Params P{};
    P.x = (const float*)d_in[0]; P.p = (const float*)d_in[1]; P.pos = (const int*)d_in[2];
    P.attn_norm = (const float*)d_in[3]; P.w_in = (const float*)d_in[4]; P.q_norm = (const float*)d_in[5]; P.w_uq = (const float*)d_in[6];
    P.kv_norm = (const float*)d_in[7]; P.w_ukv = (const float*)d_in[8]; P.mla_norm = (const float*)d_in[9]; P.lb_logits = (const float*)d_in[10];
    P.hg_norm = (const float*)d_in[11]; P.w_out = (const float*)d_in[12]; P.ffn_norm = (const float*)d_in[13];
    P.w_rg = (const float*)d_in[14]; P.b_rg = (const float*)d_in[15]; P.w_re = (const float*)d_in[16]; P.b_re = (const float*)d_in[17];
    P.w_eg = (const float*)d_in[18]; P.w_eu = (const float*)d_in[19]; P.w_ed = (const float*)d_in[20];
    P.ple_norm = (const float*)d_in[21]; P.w_pg = (const float*)d_in[22]; P.b_pg = (const float*)d_in[23]; P.w_pp = (const float*)d_in[24]; P.final_norm = (const float*)d_in[25];
    P.out = (float*)d_out; P.ws = (unsigned char*)d_ws;
    (void)hipMemsetAsync((char*)d_ws + WS_CTL, 0, 1 * MiB, stream);
#if MK_MULTI
    for (int ph = 0; ph < NPHASE; ++ph) hipLaunchKernelGGL(mk_fwd, dim3(grid), dim3(512), LDS_BYTES, stream, P, ph, ph + 1);
#else
    int lo = 0, hi = NPHASE; void* args[] = {&P, &lo, &hi};
    hipError_t e = hipLaunchCooperativeKernel((const void*)mk_fwd, dim3(grid), dim3(512), args, LDS_BYTES, stream);
    if (e != hipSuccess) fprintf(stderr, "kernel_launch: cooperative launch failed: %s (grid %d)\n", hipGetErrorString(e), grid);
#endif
}
```

```cpp
#include <hip/hip_runtime.h>
#include <hip/hip_cooperative_groups.h>
#include <cstdint>
#include <cstdio>

#define LAS __attribute__((address_space(3)))
typedef unsigned short bf16_t;
typedef float f32x4 __attribute__((ext_vector_type(4)));
typedef unsigned u32x4 __attribute__((ext_vector_type(4)));
typedef unsigned u32x2 __attribute__((ext_vector_type(2)));

constexpr int S_ = 8192, D_ = 2048, DIN = 4928, DINP = 5120;
constexpr int NH = 8, QKD = 192, VD = 128;
constexpr int NE = 64, DE = 512, PLE = 256;
constexpr float EPS = 1e-6f;
constexpr float QSCALE = 0.07216878364870323f * 1.4426950408889634f;
constexpr int PC_CQ = 0, PC_CKV = 512, PC_HQ = 768, PC_HF = 1792, PC_HI = 2816, PC_HG = 3840, PC_KPE = 4864;
constexpr int LISTCAP = 8192;

constexpr size_t MiB = 1u << 20;
constexpr size_t WS_CTL = 0;
constexpr size_t WS_RSTDX = 1 * MiB, WS_RSTD1 = WS_RSTDX + 32768, WS_RSTD2 = WS_RSTD1 + 32768, WS_LB = WS_RSTD2 + 32768, WS_TILEB = WS_LB + 4096;
constexpr size_t WS_COS = 2 * MiB, WS_SIN = 3 * MiB, WS_PARTQ = 4 * MiB, WS_PART1 = 5 * MiB, WS_PART3 = 6 * MiB, WS_WR = 7 * MiB;
constexpr size_t WS_ML = 8 * MiB, WS_DVEC = 9 * MiB, WS_EID = 10 * MiB, WS_EW = WS_EID + 65536, WS_LIST = 11 * MiB;
constexpr size_t WS_WUQ = 16 * MiB, WS_WUKV = 18 * MiB, WS_WPP = 19 * MiB, WS_WIN = 20 * MiB, WS_WOUT = 40 * MiB, WS_WPG = 48 * MiB;
constexpr size_t WS_PB = 56 * MiB, WS_XB = 64 * MiB, WS_PROJ = 96 * MiB, WS_PP = 176 * MiB, WS_QB = 208 * MiB, WS_KB = 232 * MiB, WS_VB = 256 * MiB;
constexpr size_t WS_LST = 272 * MiB, WS_SST = 304 * MiB, WS_OPART = 336 * MiB, WS_YMIX = 368 * MiB, WS_H1B = 400 * MiB, WS_H2B = 432 * MiB;
constexpr size_t WS_HMID = 464 * MiB, WS_Y = 496 * MiB, WS_WGU = 560 * MiB, WS_WD = 816 * MiB, WS_END = 944 * MiB;

struct Params {
    const float *x, *p; const int* pos;
    const float *attn_norm, *w_in, *q_norm, *w_uq, *kv_norm, *w_ukv, *mla_norm, *lb_logits, *hg_norm, *w_out, *ffn_norm;
    const float *w_rg, *b_rg, *w_re, *b_re, *w_eg, *w_eu, *w_ed, *ple_norm, *w_pg, *b_pg, *w_pp, *final_norm;
    float* out; unsigned char* ws;
};
#define WSP(T, off) ((T*)(P.ws + (off)))

__device__ __forceinline__ unsigned f2bf(float f) { unsigned u = __builtin_bit_cast(unsigned, f); return (u + 0x7fffu + ((u >> 16) & 1u)) >> 16; }
__device__ __forceinline__ float bf2f(unsigned h) { return __builtin_bit_cast(float, h << 16); }
typedef float f32x2_t __attribute__((ext_vector_type(2))); typedef __bf16 bf16x2_t __attribute__((ext_vector_type(2)));
__device__ __forceinline__ unsigned pk2(float lo, float hi) { f32x2_t v = {lo, hi}; bf16x2_t b = __builtin_convertvector(v, bf16x2_t); return __builtin_bit_cast(unsigned, b); }
__device__ __forceinline__ float wave_sum(float v) {
#pragma unroll
    for (int o = 1; o < 64; o <<= 1) v += __shfl_xor(v, o);
    return v;
}
__device__ __forceinline__ int lane_id_() { return (int)__builtin_amdgcn_mbcnt_hi(~0u, __builtin_amdgcn_mbcnt_lo(~0u, 0u)); }
__device__ __forceinline__ int threadIdx_x_raw() { return (int)__builtin_amdgcn_workitem_id_x(); }
#define TIDX (wv * 64 + lane_id_())
__device__ __forceinline__ float sigmoidf_(float x) { return 1.f / (1.f + __expf(-x)); }
__device__ __forceinline__ float siluf_(float x) { return x / (1.f + __expf(-x)); }

#ifndef P0_EXPERTS
#define P0_EXPERTS 0
#endif
struct SrcWin { const float* W; const float* g;
    __device__ __forceinline__ float operator()(int k, int n) const {
        int src;
        if (n < 768) src = n;
        else if (n < 4864) src = n + 64;
        else if (n < 4928) { const int j = n - 4864; src = 768 + ((j & 1) ? 32 + (j >> 1) : (j >> 1)); }
        else return 0.f;
        return W[(size_t)k * DIN + src] * g[k];
    } };
struct SrcWuq { const float* W; const float* g;
    __device__ __forceinline__ float operator()(int k, int n) const {
        int src;
        if (n < 1024) src = (n >> 7) * 192 + (n & 127);
        else { const int r = n - 1024, h = r >> 6, j = r & 63; src = h * 192 + 128 + ((j & 1) ? 32 + (j >> 1) : (j >> 1)); }
        return W[(size_t)k * 1536 + src] * g[k];
    } };
struct SrcWukv { const float* W; const float* g;
    __device__ __forceinline__ float operator()(int k, int n) const {
        int src;
        if (n < 1024) src = (n >> 7) * 256 + (n & 127);
        else { const int r = n - 1024; src = (r >> 7) * 256 + 128 + (r & 127); }
        return W[(size_t)k * 2048 + src] * g[k];
    } };
struct SrcWout { const float* W; const float* g0; const float* g1;
    __device__ __forceinline__ float operator()(int k, int n) const { return W[(size_t)k * 2048 + n] * (k < 1024 ? g0[k] : g1[k - 1024]); } };
struct SrcPlain { const float* W; const float* g; int N;
    __device__ __forceinline__ float operator()(int k, int n) const { const float w = W[(size_t)k * N + n]; return g ? w * g[k] : w; } };
struct SrcGU { const float* W; const float* g;
    __device__ __forceinline__ float operator()(int k, int n) const { return W[(size_t)k * DE + 128 * (n >> 8) + (n & 127)] * g[k]; } };

template <class Src>
__device__ __forceinline__ void tconv_item(const Src& src, int K, int nblk, bf16_t* WT, LAS unsigned char* scr, int item, int lane) {
    const int kb = item / nblk, nb = item % nblk, k0 = 64 * kb, n0 = 64 * nb;
    float v[64];
#pragma unroll
    for (int i = 0; i < 64; ++i) v[i] = src(k0 + i, n0 + lane);
#pragma unroll
    for (int j = 0; j < 8; ++j) { u32x4 w; w.x = pk2(v[8 * j], v[8 * j + 1]); w.y = pk2(v[8 * j + 2], v[8 * j + 3]); w.z = pk2(v[8 * j + 4], v[8 * j + 5]); w.w = pk2(v[8 * j + 6], v[8 * j + 7]);
        *(LAS u32x4*)(scr + lane * 144 + j * 16) = w; }
    asm volatile("s_waitcnt lgkmcnt(0)" ::: "memory");
#pragma unroll
    for (int i = 0; i < 8; ++i) { const int n = 8 * i + (lane >> 3), c = lane & 7;
        *(u32x4*)(WT + (size_t)(n0 + n) * K + k0 + 8 * c) = *(const LAS u32x4*)(scr + n * 144 + c * 16); }
    asm volatile("s_waitcnt lgkmcnt(0)" ::: "memory");
}

__device__ __forceinline__ void p0_run(const Params& P, int wg, int nwg, int wv, LAS unsigned char* lds) {
    const int tid = TIDX, lane = tid & 63, wave = tid >> 6;
    const int gw = wg * 8 + wave, NGW = nwg * 8;
    LAS unsigned char* scr = lds + wave * 9216;
    constexpr int I_WIN = 32 * 80, I_WUQ = 8 * 24, I_WUKV = 4 * 32, I_WOUT = 32 * 32, I_WPG = 32 * 32, I_WPP = 4 * 32, I_GU = 32 * 16, I_DN = 8 * 32;
    constexpr int NITEMS = I_WIN + I_WUQ + I_WUKV + I_WOUT + I_WPG + I_WPP + (P0_EXPERTS ? NE * I_GU + NE * I_DN : 0);
    for (int it = gw; it < NITEMS; it += NGW) {
        int r = it;
        if (r < I_WIN) { tconv_item(SrcWin{P.w_in, P.attn_norm}, 2048, 80, WSP(bf16_t, WS_WIN), scr, r, lane); continue; } r -= I_WIN;
        if (r < I_WUQ) { tconv_item(SrcWuq{P.w_uq, P.q_norm}, 512, 24, WSP(bf16_t, WS_WUQ), scr, r, lane); continue; } r -= I_WUQ;
        if (r < I_WUKV) { tconv_item(SrcWukv{P.w_ukv, P.kv_norm}, 256, 32, WSP(bf16_t, WS_WUKV), scr, r, lane); continue; } r -= I_WUKV;
        if (r < I_WOUT) { if (nwg != 256) tconv_item(SrcWout{P.w_out, P.mla_norm, P.hg_norm}, 2048, 32, WSP(bf16_t, WS_WOUT), scr, r, lane); continue; } r -= I_WOUT;
        if (r < I_WPG) { if (nwg != 256) tconv_item(SrcPlain{P.w_pg, P.ple_norm, 2048}, 2048, 32, WSP(bf16_t, WS_WPG), scr, r, lane); continue; } r -= I_WPG;
        if (r < I_WPP) { tconv_item(SrcPlain{P.w_pp, nullptr, 2048}, 256, 32, WSP(bf16_t, WS_WPP), scr, r, lane); continue; } r -= I_WPP;
        if (r < NE * I_GU) { const int e = r / I_GU; r -= e * I_GU;
            const bool isup = (((r % 16) * 64) & 255) >= 128;
            const float* Wsel = isup ? P.w_eu : P.w_eg;
            tconv_item(SrcGU{Wsel + (size_t)e * 2048 * DE, P.ffn_norm}, 2048, 16, WSP(bf16_t, WS_WGU) + (size_t)e * 1024 * 2048, scr, r, lane); continue; }
        r -= NE * I_GU;
        { const int e = r / I_DN; r -= e * I_DN;
          tconv_item(SrcPlain{P.w_ed + (size_t)e * DE * 2048, nullptr, 2048}, DE, 32, WSP(bf16_t, WS_WD) + (size_t)e * 2048 * DE, scr, r, lane); }
    }
    for (int m = gw; m < S_; m += NGW) {
        const f32x4* xr = (const f32x4*)(P.x + (size_t)m * D_) + lane; f32x4 v[8]; float s = 0.f;
#pragma unroll
        for (int j = 0; j < 8; ++j) { v[j] = xr[64 * j]; s += (v[j].x * v[j].x + v[j].y * v[j].y) + (v[j].z * v[j].z + v[j].w * v[j].w); }
        s = wave_sum(s);
        if (lane == 0) WSP(float, WS_RSTDX)[m] = 1.f / sqrtf(s * (1.f / D_) + EPS);
        u32x2* o = (u32x2*)(WSP(bf16_t, WS_XB) + (size_t)m * D_) + lane;
#pragma unroll
        for (int j = 0; j < 8; ++j) { u32x2 w; w.x = pk2(v[j].x, v[j].y); w.y = pk2(v[j].z, v[j].w); o[64 * j] = w; }
    }
    const int gt = wg * 512 + tid, NGT = nwg * 512;
    for (int i = gt; i < S_ * PLE / 4; i += NGT) { const f32x4 v = ((const f32x4*)P.p)[i]; u32x2 w; w.x = pk2(v.x, v.y); w.y = pk2(v.z, v.w); WSP(u32x2, WS_PB)[i] = w; }
    for (int i = gt; i < S_ * 32; i += NGT) { const int s = i >> 5, j = i & 31;
        const float invf = exp2f(-(float)j * (13.287712379549449f / 32.0f));
        const double tr = (double)P.pos[s] * (double)invf * 0.15915494309189535;
        const float fr = (float)(tr - floor(tr));
        WSP(float, WS_COS)[i] = __builtin_amdgcn_cosf(fr); WSP(float, WS_SIN)[i] = __builtin_amdgcn_sinf(fr); }
    for (int i = gt; i < 1024; i += NGT) WSP(float, WS_LB)[i] = 1.f / (1.f + expf(P.lb_logits[1024 + i] - P.lb_logits[i]));
    for (int i = gt; i < 2048 * 80; i += NGT) {
        const int s4 = i & 3, ln = (i >> 2) & 63, tl = (i >> 8) % 5, k16 = (i >> 8) / 5; const int k = 16 * k16 + 4 * (ln >> 4) + s4, c = 16 * tl + (ln & 15);
        float w = 0.f; if (c < 8) w = P.w_rg[k * 8 + c]; else if (c < 72) w = P.w_re[k * 64 + (c - 8)];
        WSP(float, WS_WR)[i] = w * P.ffn_norm[k]; }
}

__device__ __forceinline__ void p1_late_conv(const Params& P, int gw, int NGW, int wv, LAS unsigned char* lds) {
    const int lane = lane_id_(); LAS unsigned char* scr = lds + wv * 9216;
    for (int it = gw; it < 2 * 32 * 32; it += NGW) {
        if (it < 1024) tconv_item(SrcWout{P.w_out, P.mla_norm, P.hg_norm}, 2048, 32, WSP(bf16_t, WS_WOUT), scr, it, lane);
        else tconv_item(SrcPlain{P.w_pg, P.ple_norm, 2048}, 2048, 32, WSP(bf16_t, WS_WPG), scr, it - 1024, lane);
    }
}
struct RowId { __device__ __forceinline__ int operator()(int m) const { return m; } };
template <class F, class RowMap>
__device__ __forceinline__ void naive_gemm_item(const bf16_t* A, int lda, const bf16_t* Bt, int ldb, int K, int m0, int nrows, int n0, const F& f, const RowMap& rm, int lane) {
    const int m = m0 + lane; const bool valid = lane < nrows;
    const bf16_t* ar = A + (size_t)rm(valid ? m : m0) * lda;
    float acc[64];
#pragma unroll
    for (int c = 0; c < 64; ++c) acc[c] = 0.f;
    for (int k = 0; k < K; k += 8) {
        const u32x4 a = *(const u32x4*)(ar + k);
        float af[8];
        af[0] = bf2f(a.x & 0xffffu); af[1] = bf2f(a.x >> 16); af[2] = bf2f(a.y & 0xffffu); af[3] = bf2f(a.y >> 16);
        af[4] = bf2f(a.z & 0xffffu); af[5] = bf2f(a.z >> 16); af[6] = bf2f(a.w & 0xffffu); af[7] = bf2f(a.w >> 16);
#pragma unroll
        for (int c = 0; c < 64; ++c) {
            const u32x4 b = *(const u32x4*)(Bt + (size_t)(n0 + c) * ldb + k);
            float s = acc[c];
            s = fmaf(af[0], bf2f(b.x & 0xffffu), s); s = fmaf(af[1], bf2f(b.x >> 16), s); s = fmaf(af[2], bf2f(b.y & 0xffffu), s); s = fmaf(af[3], bf2f(b.y >> 16), s);
            s = fmaf(af[4], bf2f(b.z & 0xffffu), s); s = fmaf(af[5], bf2f(b.z >> 16), s); s = fmaf(af[6], bf2f(b.w & 0xffffu), s); s = fmaf(af[7], bf2f(b.w >> 16), s);
            acc[c] = s;
        }
    }
    if (valid) {
        float ss = 0.f;
#pragma unroll
        for (int q = 0; q < 16; ++q) { const f32x4 v = f(m, n0 + 4 * q, (f32x4){acc[4 * q], acc[4 * q + 1], acc[4 * q + 2], acc[4 * q + 3]});
            ss += (v.x * v.x + v.y * v.y) + (v.z * v.z + v.w * v.w); }
        f.partial(m, n0 >> 6, ss);
    }
}
template <class F>
__device__ __forceinline__ void naive_gemm(const bf16_t* A, int lda, const bf16_t* Bt, int ldb, int M, int N, int K, const F& f, int wg, int nwg, int wv) {
    const int lane = TIDX & 63, gw = wg * 8 + (TIDX >> 6), NGW = nwg * 8;
    const int nmt = M / 64, nnt = N / 64;
    for (int it = gw; it < nmt * nnt; it += NGW) { const int mt = it % nmt, nt = it / nmt;
        naive_gemm_item(A, lda, Bt, ldb, K, mt * 64, 64, nt * 64, f, RowId{}, lane); }
}

__device__ __forceinline__ void st_bf4(bf16_t* p, f32x4 v) { u32x2 w; w.x = pk2(v.x, v.y); w.y = pk2(v.z, v.w); *(u32x2*)p = w; }
struct FProj { bf16_t* proj; const float* rstd; float* partq;
    __device__ __forceinline__ f32x4 operator()(int m, int c, f32x4 v) const { v = v * rstd[m]; st_bf4(proj + (size_t)m * DINP + c, v); return v; }
    __device__ __forceinline__ void partial(int m, int g, float ss) const { if (g < 12) partq[m * 12 + g] = ss; } };
struct FPP { bf16_t* pp;
    __device__ __forceinline__ f32x4 operator()(int m, int c, f32x4 v) const { st_bf4(pp + (size_t)m * D_ + c, v); return v; }
    __device__ __forceinline__ void partial(int, int, float) const {} };
struct FQ { bf16_t* Qb; const float* partq; const float* cs; const float* sn;
    __device__ __forceinline__ f32x4 operator()(int m, int c, f32x4 v) const {
        float ss = 0.f;
#pragma unroll
        for (int i = 0; i < 8; ++i) ss += partq[m * 12 + i];
        v = v * (QSCALE / sqrtf(ss * (1.f / 512.f) + EPS));
        if (c < 1024) { st_bf4(Qb + (size_t)m * 1536 + (c >> 7) * 192 + (c & 127), v); }
        else { const int r = c - 1024, h = r >> 6, j = r & 63, i0 = j >> 1;
            const float c0 = cs[m * 32 + i0], s0 = sn[m * 32 + i0], c1 = cs[m * 32 + i0 + 1], s1 = sn[m * 32 + i0 + 1];
            const f32x4 o = {v.x * c0 - v.y * s0, v.y * c0 + v.x * s0, v.z * c1 - v.w * s1, v.w * c1 + v.z * s1};
            st_bf4(Qb + (size_t)m * 1536 + h * 192 + 128 + j, o); }
        return v; }
    __device__ __forceinline__ void partial(int, int, float) const {} };
struct FKV { bf16_t* Kb; bf16_t* Vb; const float* partq;
    __device__ __forceinline__ f32x4 operator()(int m, int c, f32x4 v) const {
        const float ss = (partq[m * 12 + 8] + partq[m * 12 + 9]) + (partq[m * 12 + 10] + partq[m * 12 + 11]);
        v = v * (1.f / sqrtf(ss * (1.f / 256.f) + EPS));
        if (c < 1024) st_bf4(Kb + (size_t)m * 1536 + (c >> 7) * 192 + (c & 127), v); else st_bf4(Vb + (size_t)m * 1024 + (c - 1024), v);
        return v; }
    __device__ __forceinline__ void partial(int, int, float) const {} };
struct FOut { const float* x; float* out; bf16_t* hb; float* part;
    __device__ __forceinline__ f32x4 operator()(int m, int c, f32x4 v) const { const f32x4 h = *(const f32x4*)(x + (size_t)m * D_ + c) + v;
        *(f32x4*)(out + (size_t)m * D_ + c) = h; st_bf4(hb + (size_t)m * D_ + c, h); return h; }
    __device__ __forceinline__ void partial(int m, int g, float ss) const { part[m * 32 + g] = ss; } };
struct FPle { float* out; const bf16_t* pp; const float* rstd; const float* bias; float* part;
    __device__ __forceinline__ f32x4 operator()(int m, int c, f32x4 v) const {
        const float r = rstd[m]; const f32x4 b = *(const f32x4*)(bias + c); const u32x2 pw = *(const u32x2*)(pp + (size_t)m * D_ + c);
        const f32x4 pv = {bf2f(pw.x & 0xffffu), bf2f(pw.x >> 16), bf2f(pw.y & 0xffffu), bf2f(pw.y >> 16)};
        f32x4 h = *(const f32x4*)(out + (size_t)m * D_ + c);
        h.x += sigmoidf_(v.x * r + b.x) * pv.x; h.y += sigmoidf_(v.y * r + b.y) * pv.y; h.z += sigmoidf_(v.z * r + b.z) * pv.z; h.w += sigmoidf_(v.w * r + b.w) * pv.w;
        *(f32x4*)(out + (size_t)m * D_ + c) = h; return h; }
    __device__ __forceinline__ void partial(int m, int g, float ss) const { part[m * 32 + g] = ss; } };

__device__ __forceinline__ void kpe_run(const Params& P, int wg, int nwg, int wv) {
    const int gt = wg * 512 + TIDX, NGT = nwg * 512;
    const bf16_t* proj = WSP(bf16_t, WS_PROJ); bf16_t* Kb = WSP(bf16_t, WS_KB); const float* cs = WSP(float, WS_COS); const float* sn = WSP(float, WS_SIN);
    for (int i = gt; i < S_ * 32; i += NGT) { const int m = i >> 5, j = i & 31;
        const unsigned w = *(const unsigned*)(proj + (size_t)m * DINP + PC_KPE + 2 * j);
        const float a = bf2f(w & 0xffffu), b = bf2f(w >> 16), c = cs[i], s = sn[i];
        const unsigned o = pk2(a * c - b * s, b * c + a * s);
#pragma unroll
        for (int h = 0; h < NH; ++h) *(unsigned*)(Kb + (size_t)m * 1536 + h * 192 + 128 + 2 * j) = o; }
}

__device__ __forceinline__ void attn_naive_run(const Params& P, int wg, int nwg, int wv) {
    const int lane = TIDX & 63, gw = wg * 8 + (TIDX >> 6), NGW = nwg * 8;
    const bf16_t* Qb = WSP(bf16_t, WS_QB); const bf16_t* Kb = WSP(bf16_t, WS_KB); const bf16_t* Vb = WSP(bf16_t, WS_VB);
    bf16_t* Op = WSP(bf16_t, WS_OPART); float* ml = WSP(float, WS_ML);
    for (int it = gw; it < S_ * NH; it += NGW) {
        const int h = it & 7, m = S_ - 1 - (it >> 3);
        const bf16_t* q = Qb + (size_t)m * 1536 + h * 192 + 3 * lane;
        const float q0 = bf2f(q[0]), q1 = bf2f(q[1]), q2 = bf2f(q[2]);
        float mx = -1e30f, l = 0.f, o0 = 0.f, o1 = 0.f;
        for (int key = 0; key <= m; ++key) {
            const bf16_t* kr = Kb + (size_t)key * 1536 + h * 192 + 3 * lane;
            float s = q0 * bf2f(kr[0]) + q1 * bf2f(kr[1]) + q2 * bf2f(kr[2]);
            s = wave_sum(s);
            const float mn = fmaxf(mx, s), al = exp2f(mx - mn), p = exp2f(s - mn);
            const unsigned vw = *(const unsigned*)(Vb + (size_t)key * 1024 + h * 128 + 2 * lane);
            l = l * al + p; o0 = o0 * al + p * bf2f(vw & 0xffffu); o1 = o1 * al + p * bf2f(vw >> 16); mx = mn;
        }
        const float rl = 1.f / l;
        *(unsigned*)(Op + (size_t)m * 1024 + h * 128 + 2 * lane) = pk2(o0 * rl, o1 * rl);
        *(unsigned*)(Op + (size_t)S_ * 1024 + (size_t)m * 1024 + h * 128 + 2 * lane) = 0u;
        if (lane == 0) { float* a = ml + ((size_t)m * 8 + h) * 2; a[0] = 0.f; a[1] = 1.f; float* b = ml + (size_t)S_ * 16 + ((size_t)m * 8 + h) * 2; b[0] = -1e30f; b[1] = 0.f; }
    }
}
__device__ __forceinline__ void combine_run(const Params& P, int wg, int nwg, int wv) {
    const int lane = TIDX & 63, gw = wg * 8 + (TIDX >> 6), NGW = nwg * 8;
    const bf16_t* Op = WSP(bf16_t, WS_OPART); const float* ml = WSP(float, WS_ML); bf16_t* ymix = WSP(bf16_t, WS_YMIX);
    for (int m = gw; m < S_; m += NGW) {
        const int h = lane >> 3;
        const float m0 = ml[((size_t)m * 8 + h) * 2], l0 = ml[((size_t)m * 8 + h) * 2 + 1];
        const float m1 = ml[(size_t)S_ * 16 + ((size_t)m * 8 + h) * 2], l1 = ml[(size_t)S_ * 16 + ((size_t)m * 8 + h) * 2 + 1];
        const float mm = fmaxf(m0, m1); float w0 = l0 * exp2f(m0 - mm), w1 = l1 * exp2f(m1 - mm); const float rs = 1.f / (w0 + w1); w0 *= rs; w1 *= rs;
        const u32x4* a = (const u32x4*)(Op + (size_t)m * 1024 + 16 * lane); const u32x4* b = (const u32x4*)(Op + (size_t)S_ * 1024 + (size_t)m * 1024 + 16 * lane);
        float o[16]; float ss = 0.f;
#pragma unroll
        for (int j = 0; j < 2; ++j) { const u32x4 ua = a[j], ub = b[j]; const unsigned wa[4] = {ua.x, ua.y, ua.z, ua.w}, wb[4] = {ub.x, ub.y, ub.z, ub.w};
#pragma unroll
            for (int i = 0; i < 4; ++i) { o[8 * j + 2 * i] = w0 * bf2f(wa[i] & 0xffffu) + w1 * bf2f(wb[i] & 0xffffu); o[8 * j + 2 * i + 1] = w0 * bf2f(wa[i] >> 16) + w1 * bf2f(wb[i] >> 16); } }
#pragma unroll
        for (int i = 0; i < 16; ++i) ss += o[i] * o[i];
        ss = wave_sum(ss); const float r = 1.f / sqrtf(ss * (1.f / 1024.f) + EPS);
        u32x4 w0v, w1v;
        w0v.x = pk2(o[0] * r, o[1] * r); w0v.y = pk2(o[2] * r, o[3] * r); w0v.z = pk2(o[4] * r, o[5] * r); w0v.w = pk2(o[6] * r, o[7] * r);
        w1v.x = pk2(o[8] * r, o[9] * r); w1v.y = pk2(o[10] * r, o[11] * r); w1v.z = pk2(o[12] * r, o[13] * r); w1v.w = pk2(o[14] * r, o[15] * r);
        u32x4* y = (u32x4*)(ymix + (size_t)m * D_ + 16 * lane); y[0] = w0v; y[1] = w1v;
    }
}

__device__ __forceinline__ void hgrn_naive_run(const Params& P, int wg, int wv, LAS unsigned char* lds) {
    if (wg >= NH) return;
    const int h = wg, tid = TIDX; const bool act = tid < 128; const int v = tid & 127;
    const bf16_t* proj = WSP(bf16_t, WS_PROJ); const float* lb = WSP(float, WS_LB); bf16_t* ymix = WSP(bf16_t, WS_YMIX);
    LAS float* sf = (LAS float*)lds; LAS float* sq = sf + 128; LAS float* red = sq + 128;
    float st[128];
#pragma unroll
    for (int k = 0; k < 128; ++k) st[k] = 0.f;
    for (int t = 0; t < S_; ++t) {
        const bf16_t* pr = proj + (size_t)t * DINP;
        if (act) { const float l = lb[h * 128 + v]; sf[v] = l + (1.f - l) * sigmoidf_(bf2f(pr[PC_HF + h * 128 + v])); sq[v] = siluf_(bf2f(pr[PC_HQ + h * 128 + v])); }
        __syncthreads();
        float o = 0.f;
        if (act) { const float iv = bf2f(pr[PC_HI + h * 128 + v]);
#pragma unroll
            for (int k = 0; k < 128; ++k) { const float f = sf[k]; st[k] = f * st[k] + (1.f - f) * iv; o += sq[k] * st[k]; } }
        float ss = act ? o * o : 0.f; ss = wave_sum(ss);
        if (act && (tid & 63) == 0) red[tid >> 6] = ss;
        __syncthreads();
        if (act) { const float r = 1.f / sqrtf((red[0] + red[1]) * (1.f / 128.f) + EPS);
            ymix[(size_t)t * D_ + 1024 + h * 128 + v] = (bf16_t)f2bf(o * r * siluf_(bf2f(pr[PC_HG + h * 128 + v]))); }
    }
}

__device__ __forceinline__ void route_run(const Params& P, int wg, int nwg, int wv, LAS unsigned char* lds) {
    const int lane = TIDX & 63, wave = TIDX >> 6, gw = wg * 8 + wave, NGW = nwg * 8;
    const float* h1 = P.out; const float* Wr = WSP(float, WS_WR); const float* part1 = WSP(float, WS_PART1);
    LAS float* lg = (LAS float*)lds + wave * 96;
    int* cnt = WSP(int, WS_CTL); int* list = WSP(int, WS_LIST); int* eid = WSP(int, WS_EID); float* ew = WSP(float, WS_EW); float* rstd1 = WSP(float, WS_RSTD1);
    for (int t = gw; t < S_; t += NGW) {
        float ss = (lane < 32) ? part1[t * 32 + lane] : 0.f; ss = wave_sum(ss); const float r = 1.f / sqrtf(ss * (1.f / D_) + EPS);
        float a0 = 0.f, a1 = 0.f; const float* hr = h1 + (size_t)t * D_;
        for (int k = 0; k < D_; ++k) { const float hv = hr[k]; a0 = fmaf(hv, Wr[k * 80 + lane], a0); if (lane < 16) a1 = fmaf(hv, Wr[k * 80 + 64 + lane], a1); }
        lg[lane] = a0 * r; if (lane < 16) lg[64 + lane] = a1 * r;
        asm volatile("s_waitcnt lgkmcnt(0)" ::: "memory");
        if (lane == 0) {
            rstd1[t] = r;
            int g = 0; float gm = -INFINITY;
            for (int i = 0; i < 8; ++i) { const float v = lg[i] + P.b_rg[i]; if (v > gm) { gm = v; g = i; } }
            float gs = 0.f; for (int i = 0; i < 8; ++i) gs += expf(lg[i] + P.b_rg[i] - gm);
            const float gw_ = 1.f / gs;
            int i1 = 0, i2 = 0; float l1 = -INFINITY, l2 = -INFINITY;
            for (int i = 0; i < 8; ++i) { const float e = lg[8 + g * 8 + i] + P.b_re[g * 8 + i];
                if (e > l1) { l2 = l1; i2 = i1; l1 = e; i1 = i; } else if (e > l2) { l2 = e; i2 = i; } }
            const float p2 = expf(l2 - l1), w1 = gw_ / (1.f + p2), w2 = gw_ * p2 / (1.f + p2);
            const int e1 = g * 8 + i1, e2 = g * 8 + i2;
            eid[2 * t] = e1; eid[2 * t + 1] = e2; ew[2 * t] = w1; ew[2 * t + 1] = w2;
            const int p1 = atomicAdd(&cnt[e1], 1); list[e1 * LISTCAP + p1] = 2 * t;
            const int q2 = atomicAdd(&cnt[e2], 1); list[e2 * LISTCAP + q2] = 2 * t + 1;
        }
        asm volatile("s_waitcnt lgkmcnt(0)" ::: "memory");
    }
}

__device__ __forceinline__ void moe_up_naive_run(const Params& P, int wg, int nwg, int wv) {
    const int lane = TIDX & 63, gw = wg * 8 + (TIDX >> 6), NGW = nwg * 8;
    const int* cnt = WSP(int, WS_CTL); const int* list = WSP(int, WS_LIST); const float* rstd1 = WSP(float, WS_RSTD1);
    const bf16_t* h1b = WSP(bf16_t, WS_H1B); bf16_t* hmid = WSP(bf16_t, WS_HMID);
    int off = 0, tbase = 0;
    for (int e = 0; e < NE; ++e) {
        const int n = cnt[e], nrg = (n + 63) >> 6, nit = nrg * 16;
        for (int it = gw - off; it < nit; it += NGW) {
            if (it < 0) continue;
            const int rg = it >> 4, cg = it & 15, c0 = cg * 32;
            const int nrows = (n - rg * 64) < 64 ? (n - rg * 64) : 64;
            const int a = list[e * LISTCAP + rg * 64 + (lane < nrows ? lane : 0)]; const int tok = a >> 1;
            const bf16_t* ar = h1b + (size_t)tok * D_;
            const bf16_t* W = WSP(bf16_t, WS_WGU) + (size_t)e * 1024 * 2048;
            const int pn = c0 >> 7, rr = c0 & 127;
            float ag[32], au[32];
#pragma unroll
            for (int c = 0; c < 32; ++c) { ag[c] = 0.f; au[c] = 0.f; }
            for (int k = 0; k < D_; k += 8) {
                const u32x4 av = *(const u32x4*)(ar + k); float af[8];
                af[0] = bf2f(av.x & 0xffffu); af[1] = bf2f(av.x >> 16); af[2] = bf2f(av.y & 0xffffu); af[3] = bf2f(av.y >> 16);
                af[4] = bf2f(av.z & 0xffffu); af[5] = bf2f(av.z >> 16); af[6] = bf2f(av.w & 0xffffu); af[7] = bf2f(av.w >> 16);
#pragma unroll
                for (int c = 0; c < 32; ++c) {
                    const u32x4 bg = *(const u32x4*)(W + (size_t)(pn * 256 + rr + c) * 2048 + k); const u32x4 bu = *(const u32x4*)(W + (size_t)(pn * 256 + 128 + rr + c) * 2048 + k);
                    float s = ag[c], u = au[c];
                    s = fmaf(af[0], bf2f(bg.x & 0xffffu), s); s = fmaf(af[1], bf2f(bg.x >> 16), s); s = fmaf(af[2], bf2f(bg.y & 0xffffu), s); s = fmaf(af[3], bf2f(bg.y >> 16), s);
                    s = fmaf(af[4], bf2f(bg.z & 0xffffu), s); s = fmaf(af[5], bf2f(bg.z >> 16), s); s = fmaf(af[6], bf2f(bg.w & 0xffffu), s); s = fmaf(af[7], bf2f(bg.w >> 16), s);
                    u = fmaf(af[0], bf2f(bu.x & 0xffffu), u); u = fmaf(af[1], bf2f(bu.x >> 16), u); u = fmaf(af[2], bf2f(bu.y & 0xffffu), u); u = fmaf(af[3], bf2f(bu.y >> 16), u);
                    u = fmaf(af[4], bf2f(bu.z & 0xffffu), u); u = fmaf(af[5], bf2f(bu.z >> 16), u); u = fmaf(af[6], bf2f(bu.w & 0xffffu), u); u = fmaf(af[7], bf2f(bu.w >> 16), u);
                    ag[c] = s; au[c] = u;
                }
            }
            if (lane < nrows) { const float r = rstd1[tok]; const int slot = tbase * 256 + rg * 64 + lane;
#pragma unroll
                for (int c = 0; c < 32; c += 2) *(unsigned*)(hmid + (size_t)slot * DE + c0 + c) = pk2(siluf_(ag[c] * r) * (au[c] * r), siluf_(ag[c + 1] * r) * (au[c + 1] * r)); }
        }
        off = (off + nit) % NGW; tbase += (n + 255) >> 8;
    }
}
struct FDown { bf16_t* y; const int* lst; int slot0; const float* ew;
    __device__ __forceinline__ f32x4 operator()(int m, int c, f32x4 v) const { const int a = lst[m - slot0]; v = v * ew[a]; st_bf4(y + (size_t)a * D_ + c, v); return v; }
    __device__ __forceinline__ void partial(int, int, float) const {} };
__device__ __forceinline__ void moe_down_naive_run(const Params& P, int wg, int nwg, int wv) {
    const int lane = TIDX & 63, gw = wg * 8 + (TIDX >> 6), NGW = nwg * 8;
    const int* cnt = WSP(int, WS_CTL); const int* list = WSP(int, WS_LIST); const float* ew = WSP(float, WS_EW);
    const bf16_t* hmid = WSP(bf16_t, WS_HMID); bf16_t* y = WSP(bf16_t, WS_Y);
    int off = 0, tbase = 0;
    for (int e = 0; e < NE; ++e) {
        const int n = cnt[e], nrg = (n + 63) >> 6, nit = nrg * 32;
        for (int it = gw - off; it < nit; it += NGW) {
            if (it < 0) continue;
            const int rg = it >> 5, cg = it & 31; const int nrows = (n - rg * 64) < 64 ? (n - rg * 64) : 64;
            const int slot0 = tbase * 256 + rg * 64;
            FDown f{y, list + e * LISTCAP + rg * 64, slot0, ew};
            naive_gemm_item(hmid, DE, WSP(bf16_t, WS_WD) + (size_t)e * 2048 * DE, DE, DE, slot0, nrows, cg * 64, f, RowId{}, lane);
        }
        off = (off + nit) % NGW; tbase += (n + 255) >> 8;
    }
}
__device__ __forceinline__ void moe_combine_run(const Params& P, int wg, int nwg, int wv) {
    const int lane = TIDX & 63, gw = wg * 8 + (TIDX >> 6), NGW = nwg * 8;
    const bf16_t* y = WSP(bf16_t, WS_Y); bf16_t* h2b = WSP(bf16_t, WS_H2B); float* rstd2 = WSP(float, WS_RSTD2);
    for (int m = gw; m < S_; m += NGW) {
        f32x4* hr = (f32x4*)(P.out + (size_t)m * D_) + lane; const u32x2* y0 = (const u32x2*)(y + (size_t)(2 * m) * D_) + lane; const u32x2* y1 = (const u32x2*)(y + (size_t)(2 * m + 1) * D_) + lane;
        u32x2* ob = (u32x2*)(h2b + (size_t)m * D_) + lane; float ss = 0.f;
#pragma unroll
        for (int j = 0; j < 8; ++j) { f32x4 h = hr[64 * j]; const u32x2 a = y0[64 * j], b = y1[64 * j];
            h.x += bf2f(a.x & 0xffffu) + bf2f(b.x & 0xffffu); h.y += bf2f(a.x >> 16) + bf2f(b.x >> 16); h.z += bf2f(a.y & 0xffffu) + bf2f(b.y & 0xffffu); h.w += bf2f(a.y >> 16) + bf2f(b.y >> 16);
            hr[64 * j] = h; u32x2 w; w.x = pk2(h.x, h.y); w.y = pk2(h.z, h.w); ob[64 * j] = w; ss += (h.x * h.x + h.y * h.y) + (h.z * h.z + h.w * h.w); }
        ss = wave_sum(ss); if (lane == 0) rstd2[m] = 1.f / sqrtf(ss * (1.f / D_) + EPS);
    }
}
__device__ __forceinline__ void final_run(const Params& P, int wg, int nwg, int wv) {
    const int lane = TIDX & 63, gw = wg * 8 + (TIDX >> 6), NGW = nwg * 8; const float* part3 = WSP(float, WS_PART3);
    for (int m = gw; m < S_; m += NGW) {
        float ss = (lane < 32) ? part3[m * 32 + lane] : 0.f; ss = wave_sum(ss); const float r = 1.f / sqrtf(ss * (1.f / D_) + EPS);
        f32x4* hr = (f32x4*)(P.out + (size_t)m * D_) + lane; const f32x4* g = (const f32x4*)P.final_norm + lane;
#pragma unroll
        for (int j = 0; j < 8; ++j) hr[64 * j] = hr[64 * j] * r * g[64 * j];
    }
}

namespace pg8 {
typedef short bf16x8 __attribute__((ext_vector_type(8)));
constexpr int BM = 256, BK = 64, HALF = 128, HTB = HALF * BK * 2, STAGE_BYTES = 8 * HTB, NXCD = 8, WGM = 8;
__device__ __forceinline__ int lds_byte(int r, int c) { const int st = (r >> 4) * 2 + (c >> 5), rr = r & 15, cc = c & 31, ob = rr * 64 + cc * 2; return st * 1024 + (ob ^ (((ob >> 9) & 1) << 5)); }
__device__ __forceinline__ void stage_rc(int b, int& R, int& C) { const int st = b / 1024, sb = b % 1024, swz = sb ^ (((sb >> 9) & 1) << 5); R = (st >> 1) * 16 + swz / 64; C = (st & 1) * 32 + (swz % 64) / 2; }
struct Unit { int pm, pn; const char* a; const char* b; int x0, x1, x2; };
struct DenseOrder {
    const bf16_t* A; const bf16_t* Bt; int K, lda, nM, nN, nwg, G, c;
    __device__ __forceinline__ void init(const bf16_t* A_, int lda_, const bf16_t* Bt_, int M, int N, int K_, int G_, int c_) { A = A_; lda = lda_; Bt = Bt_; K = K_; nM = M / BM; nN = N / BM; nwg = nM * nN; G = G_; c = c_; }
    __device__ __forceinline__ bool next(int i, Unit& u) const {
        const long L = (long)i * G + c; if (L >= nwg) return false;
        int wgid = (int)L; { const int q = nwg / NXCD, r = nwg % NXCD, xcd = wgid % NXCD, off = wgid / NXCD; wgid = (xcd < r ? xcd * (q + 1) : r * (q + 1) + (xcd - r) * q) + off; }
        const int nig = WGM * nN, gid = wgid / nig, fm = gid * WGM, gsz = (nM - fm) < WGM ? (nM - fm) : WGM;
        u.pm = fm + ((wgid % nig) % gsz); u.pn = (wgid % nig) / gsz;
        u.a = (const char*)A + (size_t)u.pm * BM * lda * 2; u.b = (const char*)Bt + (size_t)u.pn * BM * K * 2; u.x0 = 0; u.x1 = 0; u.x2 = 0; return true;
    }
    __device__ __forceinline__ unsigned row_off(const Unit&, int) const { return 0u; }
};
template <class F> struct EpiF { F f;
    __device__ __forceinline__ void operator()(const f32x4 (&acc)[2][2][4][2], const Unit& u, int wr, int wc, int fr, int fq) const {
#pragma unroll
        for (int ai = 0; ai < 2; ++ai)
#pragma unroll
            for (int m = 0; m < 4; ++m) { const int r = ai * HALF + wr * 64 + m * 16 + fr; const auto ctx = f.row(u, r); float ss = 0.f;
#pragma unroll
                for (int bj = 0; bj < 2; ++bj)
#pragma unroll
                    for (int n = 0; n < 2; ++n) { const f32x4 v = f.elem(u, r, bj * HALF + wc * 32 + n * 16 + fq * 4, acc[ai][bj][m][n], ctx);
                        if (F::ROWSUM) ss += (v.x * v.x + v.y * v.y) + (v.z * v.z + v.w * v.w); }
                if (F::ROWSUM) { ss += __shfl_xor(ss, 16); ss += __shfl_xor(ss, 32); if (fq == 0) f.partial(u, r, wc, ss); }
                asm volatile("" ::: "memory"); }
    } };

template <class Epi, class Sched, bool GATHER>
__device__ __forceinline__ void gemm_phase(LAS unsigned char* lds, const int K, const int lda, const Sched& S, const Epi& E, const int wv) {
    const int wid = wv, lane = lane_id_(), tid = wid * 64 + lane, wr = wid >> 2, wc = wid & 3, fr = lane & 15, fq = lane >> 4;
    const int nt = K / BK;
    unsigned voffB[2], vA[2][2], vAn[2][2];
#pragma unroll
    for (int i = 0; i < 2; ++i) { int R, C; stage_rc(tid * 16 + i * 8192, R, C); voffB[i] = (unsigned)(R * K + C) * 2u;
        vA[0][i] = (unsigned)(R * lda + C) * 2u; vA[1][i] = vA[0][i]; vAn[0][i] = vA[0][i]; vAn[1][i] = vA[0][i]; }
    const size_t kstep = (size_t)(BK * 2);
    const size_t hstepB = (size_t)HALF * K * 2;
    const size_t hstepA = GATHER ? (size_t)0 : (size_t)HALF * lda * 2;
    const unsigned ldsw = (unsigned)wid * 1024u;
    const int aoff = lds_byte(wr * 64 + fr, fq * 8), boff = lds_byte(wc * 32 + fr, fq * 8);
#define PG8_SA(b, h) (((b) * 2 + (h)) * HTB)
#define PG8_SB(b, h) ((4 + (b) * 2 + (h)) * HTB)
#define PG8_STAGE(bufoff, gbase, voff) do { _Pragma("unroll") for (int _i = 0; _i < 2; ++_i) \
        __builtin_amdgcn_global_load_lds((const unsigned*)((const char*)(gbase) + (voff)[_i]), (LAS unsigned*)(lds + (bufoff) + ldsw + _i * 8192), 16, 0, 0); } while (0)
#define PG8_LDA(dst, b, h) do { _Pragma("unroll") for (int m = 0; m < 4; ++m) _Pragma("unroll") for (int k = 0; k < 2; ++k) dst[m][k] = *(const LAS bf16x8*)(lds + PG8_SA(b, h) + aoff + m * 2048 + k * 1024); } while (0)
#define PG8_LDB(dst, b, h) do { _Pragma("unroll") for (int n = 0; n < 2; ++n) _Pragma("unroll") for (int k = 0; k < 2; ++k) dst[n][k] = *(const LAS bf16x8*)(lds + PG8_SB(b, h) + boff + n * 2048 + k * 1024); } while (0)
#define PG8_MMA(ai, bj, At, Bt) do { __builtin_amdgcn_s_setprio(1); _Pragma("unroll") for (int m = 0; m < 4; ++m) _Pragma("unroll") for (int n = 0; n < 2; ++n) _Pragma("unroll") for (int k = 0; k < 2; ++k) \
        acc[ai][bj][m][n] = __builtin_amdgcn_mfma_f32_16x16x32_bf16(Bt[n][k], At[m][k], acc[ai][bj][m][n], 0, 0, 0); __builtin_amdgcn_s_setprio(0); } while (0)
#define PG8_WAIT_V(n) asm volatile("s_waitcnt vmcnt(" #n ")" ::: "memory")
#define PG8_WAIT_L(n) asm volatile("s_waitcnt lgkmcnt(" #n ")" ::: "memory")
#define PG8_BAR __builtin_amdgcn_s_barrier()
#define PG8_SCHED __builtin_amdgcn_sched_barrier(0)
#define PG8_GOFF(dst, uu) do { if constexpr (GATHER) { _Pragma("unroll") for (int _i = 0; _i < 2; ++_i) { int _R, _C; stage_rc((wid * 64 + lane_id_()) * 16 + _i * 8192, _R, _C); \
        _Pragma("unroll") for (int _h = 0; _h < 2; ++_h) dst[_h][_i] = S.row_off(uu, _R + _h * HALF) + (unsigned)_C * 2u; } } } while (0)
    Unit cur, nxt; int ui = 0;
    if (!S.next(0, cur)) return;
    PG8_GOFF(vA, cur);
    f32x4 acc[2][2][4][2];
#pragma unroll
    for (int a = 0; a < 2; ++a)
#pragma unroll
        for (int b = 0; b < 2; ++b)
#pragma unroll
            for (int m = 0; m < 4; ++m)
#pragma unroll
                for (int n = 0; n < 2; ++n) acc[a][b][m][n] = (f32x4){0.f, 0.f, 0.f, 0.f};
    bf16x8 At[4][2], B0[2][2], B1[2][2];
    const char* cA = cur.a; const char* cB = cur.b;
    PG8_STAGE(PG8_SB(0, 0), cB, voffB); PG8_STAGE(PG8_SB(0, 1), cB + hstepB, voffB); PG8_STAGE(PG8_SA(0, 0), cA, vA[0]); PG8_STAGE(PG8_SA(0, 1), cA + hstepA, vA[1]);
    if (wr == 1) PG8_BAR;
    PG8_WAIT_V(2); PG8_BAR;
    PG8_STAGE(PG8_SB(1, 0), cB + kstep, voffB); PG8_STAGE(PG8_SA(1, 0), cA + kstep, vA[0]); PG8_STAGE(PG8_SB(1, 1), cB + hstepB + kstep, voffB);
    PG8_WAIT_V(6); PG8_BAR;
    for (;;) {
        const bool has_next = S.next(ui + 1, nxt);
        const char* nA = has_next ? nxt.a : cA; const char* nB = has_next ? nxt.b : cB;
        if constexpr (GATHER) { if (has_next) { PG8_GOFF(vAn, nxt); } else {
#pragma unroll
            for (int h = 0; h < 2; ++h)
#pragma unroll
                for (int i = 0; i < 2; ++i) vAn[h][i] = vA[h][i]; } }
        for (int t = 0; t < nt; t += 2) {
            const bool last = (t == nt - 2);
            const char* a1 = cA + (size_t)(t + 1) * kstep;
            const char* a2 = last ? nA : cA + (size_t)(t + 2) * kstep; const char* b2 = last ? nB : cB + (size_t)(t + 2) * kstep;
            const char* a3 = a2 + kstep; const char* b3 = b2 + kstep;
            unsigned w0[2], w1[2];
#pragma unroll
            for (int i = 0; i < 2; ++i) { w0[i] = (GATHER && last) ? vAn[0][i] : vA[0][i]; w1[i] = (GATHER && last) ? vAn[1][i] : vA[1][i]; }
            PG8_LDB(B0, 0, 0); PG8_LDB(B1, 0, 1); PG8_SCHED; PG8_LDA(At, 0, 0); PG8_STAGE(PG8_SA(1, 1), a1 + hstepA, vA[1]);
            PG8_WAIT_V(8); PG8_WAIT_L(0); PG8_BAR; PG8_MMA(0, 0, At, B0); PG8_MMA(0, 1, At, B1); PG8_BAR; PG8_SCHED;
            PG8_LDA(At, 0, 1); PG8_STAGE(PG8_SB(0, 0), b2, voffB); PG8_STAGE(PG8_SB(0, 1), b2 + hstepB, voffB); PG8_STAGE(PG8_SA(0, 0), a2, w0);
            PG8_WAIT_V(8); PG8_WAIT_L(0); PG8_BAR; PG8_MMA(1, 0, At, B0); PG8_MMA(1, 1, At, B1); PG8_BAR; PG8_SCHED;
            PG8_LDB(B0, 1, 0); PG8_LDB(B1, 1, 1); PG8_SCHED; PG8_LDA(At, 1, 0); PG8_STAGE(PG8_SA(0, 1), a2 + hstepA, w1);
            PG8_WAIT_V(8); PG8_WAIT_L(0); PG8_BAR; PG8_MMA(0, 0, At, B0); PG8_MMA(0, 1, At, B1); PG8_BAR; PG8_SCHED;
            PG8_LDA(At, 1, 1); PG8_STAGE(PG8_SB(1, 0), b3, voffB); PG8_STAGE(PG8_SB(1, 1), b3 + hstepB, voffB); PG8_STAGE(PG8_SA(1, 0), a3, w0);
            PG8_WAIT_V(8); PG8_WAIT_L(0); PG8_BAR; PG8_MMA(1, 0, At, B0); PG8_MMA(1, 1, At, B1); PG8_BAR; PG8_SCHED;
        }
        if (wr == 0) PG8_BAR;
        E(acc, cur, wr, wc, fr, fq);
        if (!has_next) break;
#pragma unroll
        for (int a = 0; a < 2; ++a)
#pragma unroll
            for (int b = 0; b < 2; ++b)
#pragma unroll
                for (int m = 0; m < 4; ++m)
#pragma unroll
                    for (int n = 0; n < 2; ++n) acc[a][b][m][n] = (f32x4){0.f, 0.f, 0.f, 0.f};
        cur = nxt; cA = nA; cB = nB; ++ui;
        if constexpr (GATHER) {
#pragma unroll
            for (int h = 0; h < 2; ++h)
#pragma unroll
                for (int i = 0; i < 2; ++i) vA[h][i] = vAn[h][i]; }
        if (wr == 1) PG8_BAR;
    }
    PG8_WAIT_V(0);
    PG8_BAR;
#undef PG8_SA
#undef PG8_SB
#undef PG8_STAGE
#undef PG8_LDA
#undef PG8_LDB
#undef PG8_MMA
#undef PG8_WAIT_V
#undef PG8_WAIT_L
#undef PG8_BAR
#undef PG8_SCHED
#undef PG8_GOFF
}
}

struct PFProj { static constexpr bool ROWSUM = true; bf16_t* proj; const float* rstd; float* partq;
    __device__ __forceinline__ float row(const pg8::Unit& u, int r) const { return rstd[u.pm * 256 + r]; }
    __device__ __forceinline__ f32x4 elem(const pg8::Unit& u, int r, int c, f32x4 v, float rs) const { v = v * rs; st_bf4(proj + (size_t)(u.pm * 256 + r) * DINP + u.pn * 256 + c, v); return v; }
    __device__ __forceinline__ void partial(const pg8::Unit& u, int r, int wc, float ss) const { const int g = u.pn * 4 + wc; if (g < 12) partq[(u.pm * 256 + r) * 12 + g] = ss; } };
struct PFPP { static constexpr bool ROWSUM = false; bf16_t* pp;
    __device__ __forceinline__ int row(const pg8::Unit&, int) const { return 0; }
    __device__ __forceinline__ f32x4 elem(const pg8::Unit& u, int r, int c, f32x4 v, int) const { st_bf4(pp + (size_t)(u.pm * 256 + r) * D_ + u.pn * 256 + c, v); return v; }
    __device__ __forceinline__ void partial(const pg8::Unit&, int, int, float) const {} };
struct PFQ { static constexpr bool ROWSUM = false; bf16_t* Qb; const float* partq; const float* cs; const float* sn;
    __device__ __forceinline__ float row(const pg8::Unit& u, int r) const { const f32x4* p = (const f32x4*)(partq + (size_t)(u.pm * 256 + r) * 12); const f32x4 a = p[0], b = p[1];
        const float ss = ((a.x + a.y) + (a.z + a.w)) + ((b.x + b.y) + (b.z + b.w)); return QSCALE / sqrtf(ss * (1.f / 512.f) + EPS); }
    __device__ __forceinline__ f32x4 elem(const pg8::Unit& u, int r, int cc, f32x4 v, float sc) const { const int m = u.pm * 256 + r, c = u.pn * 256 + cc; v = v * sc;
        if (u.pn < 4) { st_bf4(Qb + (size_t)m * 1536 + (c >> 7) * 192 + (c & 127), v); }
        else { const int q = c - 1024, h = q >> 6, j = q & 63, i0 = j >> 1;
            const float c0 = cs[m * 32 + i0], s0 = sn[m * 32 + i0], c1 = cs[m * 32 + i0 + 1], s1 = sn[m * 32 + i0 + 1];
            const f32x4 o = {v.x * c0 - v.y * s0, v.y * c0 + v.x * s0, v.z * c1 - v.w * s1, v.w * c1 + v.z * s1};
            st_bf4(Qb + (size_t)m * 1536 + h * 192 + 128 + j, o); }
        return v; }
    __device__ __forceinline__ void partial(const pg8::Unit&, int, int, float) const {} };
struct PFKV { static constexpr bool ROWSUM = false; bf16_t* Kb; bf16_t* Vb; const float* partq;
    __device__ __forceinline__ float row(const pg8::Unit& u, int r) const { const f32x4 a = *(const f32x4*)(partq + (size_t)(u.pm * 256 + r) * 12 + 8);
        return 1.f / sqrtf(((a.x + a.y) + (a.z + a.w)) * (1.f / 256.f) + EPS); }
    __device__ __forceinline__ f32x4 elem(const pg8::Unit& u, int r, int cc, f32x4 v, float sc) const { const int m = u.pm * 256 + r, c = u.pn * 256 + cc; v = v * sc;
        if (u.pn < 4) st_bf4(Kb + (size_t)m * 1536 + (c >> 7) * 192 + (c & 127), v); else st_bf4(Vb + (size_t)m * 1024 + (c - 1024), v);
        return v; }
    __device__ __forceinline__ void partial(const pg8::Unit&, int, int, float) const {} };
struct PFOut { static constexpr bool ROWSUM = true; const float* x; float* out; bf16_t* hb; float* part;
    __device__ __forceinline__ int row(const pg8::Unit&, int) const { return 0; }
    __device__ __forceinline__ f32x4 elem(const pg8::Unit& u, int r, int cc, f32x4 v, int) const { const size_t o = (size_t)(u.pm * 256 + r) * D_ + u.pn * 256 + cc;
        const f32x4 h = *(const f32x4*)(x + o) + v; *(f32x4*)(out + o) = h; st_bf4(hb + o, h); return h; }
    __device__ __forceinline__ void partial(const pg8::Unit& u, int r, int wc, float ss) const { part[(u.pm * 256 + r) * 32 + u.pn * 4 + wc] = ss; } };
struct PFPle { static constexpr bool ROWSUM = true; float* out; const bf16_t* pp; const float* rstd; const float* bias; float* part;
    __device__ __forceinline__ float row(const pg8::Unit& u, int r) const { return rstd[u.pm * 256 + r]; }
    __device__ __forceinline__ f32x4 elem(const pg8::Unit& u, int r, int cc, f32x4 v, float rs) const { const int c = u.pn * 256 + cc; const size_t o = (size_t)(u.pm * 256 + r) * D_ + c;
        const f32x4 b = *(const f32x4*)(bias + c); const u32x2 pw = *(const u32x2*)(pp + o);
        const f32x4 pv = {bf2f(pw.x & 0xffffu), bf2f(pw.x >> 16), bf2f(pw.y & 0xffffu), bf2f(pw.y >> 16)};
        f32x4 h = *(const f32x4*)(out + o);
        h.x += sigmoidf_(v.x * rs + b.x) * pv.x; h.y += sigmoidf_(v.y * rs + b.y) * pv.y; h.z += sigmoidf_(v.z * rs + b.z) * pv.z; h.w += sigmoidf_(v.w * rs + b.w) * pv.w;
        *(f32x4*)(out + o) = h; return h; }
    __device__ __forceinline__ void partial(const pg8::Unit& u, int r, int wc, float ss) const { part[(u.pm * 256 + r) * 32 + u.pn * 4 + wc] = ss; } };
template <class F> __device__ __forceinline__ void dense_gemm(LAS unsigned char* lds, const bf16_t* A, int lda, const bf16_t* Bt, int M, int N, int K, const F& f, int wg, int nwg, int wv) {
    asm volatile("" : "+s"(K), "+s"(lda));
    pg8::DenseOrder S; S.init(A, lda, Bt, M, N, K, nwg, wg);
    pg8::EpiF<F> E{f};
    pg8::gemm_phase<pg8::EpiF<F>, pg8::DenseOrder, false>(lds, K, lda, S, E, wv);
}


namespace att {
typedef short bf16x8 __attribute__((ext_vector_type(8)));
typedef short s16x4 __attribute__((ext_vector_type(4)));
typedef float f32x16 __attribute__((ext_vector_type(16)));
constexpr int KVBLK = 64, QBLK = 32, QB = 256, KROW = 384  , SHM_V = 64 * 128 * 2, SHM_K = 64 * KROW;
constexpr int LDQ = 1536, LDK = 1536, LDV = 1024, LDO = 1024;
constexpr float THR = 8.f;
#define KSWZ(row, colB) ((row) * KROW + ((colB) ^ ((((row) >> 1) & 7) << 4)))
#define SBAR() __builtin_amdgcn_sched_barrier(0)
__device__ __forceinline__ int v_st(int k, int c) { const int kk = (k & ~0xC) | ((k & 4) << 1) | ((k & 8) >> 1); return ((kk >> 3) * 4 + (c >> 5)) * 512 + ((kk & 7) * 32 + (c & 31)) * 2; }
__device__ __forceinline__ int v_rd_base(int lane) { return ((lane & 3) << 3) | (((lane >> 2) & 3) << 6) | (((lane >> 4) & 1) << 5) | (((lane >> 5) & 1) << 8); }
constexpr int v_rd_off(int d0, int ks, int half) { return d0 * 512 + ks * 4096 + half * 2048; }
__device__ __forceinline__ int crow(int r, int hi) { return (r & 3) + 8 * (r >> 2) + 4 * hi; }
__device__ __forceinline__ unsigned cvtpk(float lo, float hi) { unsigned r; asm volatile("v_cvt_pk_bf16_f32 %0, %1, %2" : "=v"(r) : "v"(lo), "v"(hi)); return r; }
__device__ __forceinline__ void mask_tile(f32x16& p0, f32x16& p1, int dq) {
    const float NEG = -__builtin_inff();
#pragma unroll
    for (int r = 0; r < 16; ++r) { const int c = (r & 3) + 8 * (r >> 2); if (dq - c < 0) p0[r] = NEG; if (dq - c - 32 < 0) p1[r] = NEG; }
}
__device__ __forceinline__ void partialSM(f32x16& p0, f32x16& p1, float& m_reg, float& mn, float& alpha) {
    float pmax = p0[0];
#pragma unroll
    for (int r = 1; r < 16; ++r) pmax = fmaxf(pmax, p0[r]);
#pragma unroll
    for (int r = 0; r < 16; ++r) pmax = fmaxf(pmax, p1[r]);
    { auto rr = __builtin_amdgcn_permlane32_swap(__float_as_uint(pmax), __float_as_uint(pmax), false, false);
      pmax = fmaxf(__uint_as_float(rr[0]), __uint_as_float(rr[1])); }
    if (__builtin_expect(__all((pmax - m_reg) <= THR), 1)) { mn = m_reg; alpha = 1.f; }
    else { mn = fmaxf(m_reg, pmax); alpha = __builtin_amdgcn_exp2f(m_reg - mn); m_reg = mn; }
#pragma unroll
    for (int r = 0; r < 16; ++r) p0[r] = p0[r] - mn;
#pragma unroll
    for (int r = 0; r < 16; ++r) p1[r] = p1[r] - mn;
#pragma unroll
    for (int r = 0; r < 16; ++r) p0[r] = __builtin_amdgcn_exp2f(p0[r]);
}
__device__ __forceinline__ void finishSM(f32x16& p0, f32x16& p1, float alpha, float& l_reg, bf16x8& pa0, bf16x8& pa1, bf16x8& pa2, bf16x8& pa3) {
#pragma unroll
    for (int r = 0; r < 16; ++r) p1[r] = __builtin_amdgcn_exp2f(p1[r]);
    float ps = 0;
#pragma unroll
    for (int r = 0; r < 16; ++r) ps += p0[r];
#pragma unroll
    for (int r = 0; r < 16; ++r) ps += p1[r];
    { auto rr = __builtin_amdgcn_permlane32_swap(__float_as_uint(ps), __float_as_uint(ps), false, false);
      ps = __uint_as_float(rr[0]) + __uint_as_float(rr[1]); }
    l_reg = l_reg * alpha + ps;
#define PK4(P, B_, OUT) do { unsigned a0 = cvtpk(P[B_+0], P[B_+1]), a1 = cvtpk(P[B_+2], P[B_+3]);                          \
        unsigned b0 = cvtpk(P[B_+4], P[B_+5]), b1 = cvtpk(P[B_+6], P[B_+7]);                                             \
        auto r0 = __builtin_amdgcn_permlane32_swap(a0, b0, false, false); auto r1 = __builtin_amdgcn_permlane32_swap(a1, b1, false, false); \
        u32x4 w = {r0[0], r1[0], r0[1], r1[1]}; OUT = *reinterpret_cast<bf16x8*>(&w); } while (0)
    PK4(p0, 0, pa0); PK4(p0, 8, pa1); PK4(p1, 0, pa2); PK4(p1, 8, pa3);
#undef PK4
}
template <int KB>
__device__ __forceinline__ void qkt(f32x16& p0, f32x16& p1, const char* K_lds, int r32, int hi, const bf16x8* qr) {
    p0 = f32x16{}; p1 = f32x16{};
    const char* kb[4];
#pragma unroll
    for (int dd = 0; dd < 4; ++dd) kb[dd] = K_lds + KB * SHM_K + KSWZ(r32, (dd * 16 + hi * 8) * 2);
#pragma unroll
    for (int d0 = 0; d0 < 12; ++d0) { const char* a = kb[d0 & 3] + (d0 >> 2) * 128;
        bf16x8 b0 = *reinterpret_cast<const bf16x8*>(a);
        bf16x8 b1 = *reinterpret_cast<const bf16x8*>(a + 32 * KROW);
        p0 = __builtin_amdgcn_mfma_f32_32x32x16_bf16(b0, qr[d0], p0, 0, 0, 0);
        p1 = __builtin_amdgcn_mfma_f32_32x32x16_bf16(b1, qr[d0], p1, 0, 0, 0); }
}
template <int VB>
__device__ __forceinline__ void pv_tile(f32x16* o, int vb0, bf16x8 pa0, bf16x8 pa1, bf16x8 pa2, bf16x8 pa3) {
#define TRRD(dst, off) asm volatile("ds_read_b64_tr_b16 %0, %1 offset:%2" : "=v"(dst) : "v"(vb0), "i"(off) : "memory")
#define PV_RD(S, d0) do { constexpr int b_ = VB * SHM_V + v_rd_off(d0, 0, 0); \
        TRRD(S##l0, b_); TRRD(S##h0, b_ + 2048); TRRD(S##l1, b_ + 4096); TRRD(S##h1, b_ + 6144); TRRD(S##l2, b_ + 8192); TRRD(S##h2, b_ + 10240); TRRD(S##l3, b_ + 12288); TRRD(S##h3, b_ + 14336); } while (0)
#define PV_MM(S, d0) do { \
        o[d0] = __builtin_amdgcn_mfma_f32_32x32x16_bf16(pa0, (bf16x8){S##l0[0], S##l0[1], S##l0[2], S##l0[3], S##h0[0], S##h0[1], S##h0[2], S##h0[3]}, o[d0], 0, 0, 0);   \
        o[d0] = __builtin_amdgcn_mfma_f32_32x32x16_bf16(pa1, (bf16x8){S##l1[0], S##l1[1], S##l1[2], S##l1[3], S##h1[0], S##h1[1], S##h1[2], S##h1[3]}, o[d0], 0, 0, 0);   \
        o[d0] = __builtin_amdgcn_mfma_f32_32x32x16_bf16(pa2, (bf16x8){S##l2[0], S##l2[1], S##l2[2], S##l2[3], S##h2[0], S##h2[1], S##h2[2], S##h2[3]}, o[d0], 0, 0, 0);   \
        o[d0] = __builtin_amdgcn_mfma_f32_32x32x16_bf16(pa3, (bf16x8){S##l3[0], S##l3[1], S##l3[2], S##l3[3], S##h3[0], S##h3[1], S##h3[2], S##h3[3]}, o[d0], 0, 0, 0); } while (0)
#define PV_WAIT(n) do { asm volatile("s_waitcnt lgkmcnt(" #n ")" ::: "memory"); SBAR(); } while (0)
    s16x4 Al0, Al1, Al2, Al3, Ah0, Ah1, Ah2, Ah3, Bl0, Bl1, Bl2, Bl3, Bh0, Bh1, Bh2, Bh3;
    asm volatile("s_waitcnt lgkmcnt(0)" ::: "memory"); SBAR();
    PV_RD(A, 0); PV_RD(B, 1);
    PV_WAIT(8); PV_MM(A, 0); SBAR(); PV_RD(A, 2);
    PV_WAIT(8); PV_MM(B, 1); SBAR(); PV_RD(B, 3);
    PV_WAIT(8); PV_MM(A, 2);
    PV_WAIT(0); PV_MM(B, 3); SBAR();
#undef PV_RD
#undef PV_MM
#undef PV_WAIT
#undef TRRD
}
struct Ref { const bf16_t* Q; const bf16_t* K; const bf16_t* V; bf16_t* O; float* ml; int P0, j_lo, j_hi; };
#define VMW() asm volatile("s_waitcnt vmcnt(0)" ::: "memory")
#define LD8(p) (*reinterpret_cast<const bf16x8*>(p))
#define STG_IDX() int tl_ = tid; asm volatile("" : "+v"(tl_)); const int sr = tl_ >> 4, sc = (tl_ & 15) * 8; \
        const int kr0 = tl_ / 24, kc0 = (tl_ % 24) * 8, kr1 = (tl_ + 512) / 24, kc1 = ((tl_ + 512) % 24) * 8, kr2 = (tl_ + 1024) / 24, kc2 = ((tl_ + 1024) % 24) * 8
#define SLOAD_H(k0) do { STG_IDX(); st_v0 = LD8(Vh + (size_t)((k0) + sr) * LDV + sc); st_v1 = LD8(Vh + (size_t)((k0) + 32 + sr) * LDV + sc); \
        st_k0 = LD8(Kh + (size_t)((k0) + kr0) * LDK + kc0); st_k1 = LD8(Kh + (size_t)((k0) + kr1) * LDK + kc1); st_k2 = LD8(Kh + (size_t)((k0) + kr2) * LDK + kc2); } while (0)
#define SWRITE_H(bf) do { STG_IDX(); *(bf16x8*)(V_lds + (bf) * SHM_V + v_st(sr, sc)) = st_v0; *(bf16x8*)(V_lds + (bf) * SHM_V + v_st(32 + sr, sc)) = st_v1; \
        *(bf16x8*)(K_lds + (bf) * SHM_K + KSWZ(kr0, kc0 * 2)) = st_k0; *(bf16x8*)(K_lds + (bf) * SHM_K + KSWZ(kr1, kc1 * 2)) = st_k1; *(bf16x8*)(K_lds + (bf) * SHM_K + KSWZ(kr2, kc2 * 2)) = st_k2; } while (0)
__device__ __forceinline__ void unit(const Ref& cur, char* lds, int wid, int lane) {
    const int r32 = lane & 31, hi = lane >> 5;
    const int j_lo = cur.j_lo, NT = cur.j_hi - cur.j_lo;
    const int qlo = cur.P0 + wid * QBLK, qm = qlo + r32 - 4 * hi;
    constexpr int STG = SHM_V + SHM_K;
    float* ws = (float*)(lds + 2 * STG) + wid * 64; float* li_l = ws, * al_l = ws + 32;
    const int vb0 = (int)(uintptr_t)lds + v_rd_base(lane);
    unsigned soff[5];
#pragma unroll
    for (int i = 0; i < 5; ++i) { const int p = wid + 8 * i;
        if (p < 16) { const int st = p * 2 + (lane >> 5), kk = (st >> 2) * 8 + ((lane & 31) >> 2), k = (kk & ~0xC) | ((kk & 4) << 1) | ((kk & 8) >> 1), c = (st & 3) * 32 + (lane & 3) * 8; soff[i] = (unsigned)(k * LDV + c); }
        else { const int o = (p - 16) * 1024 + lane * 16, row = o / KROW, cb = (o % KROW) ^ (((row >> 1) & 7) << 4); soff[i] = (unsigned)(row * LDK + (cb >> 1)); } }
    const bf16_t* Kh = cur.K; const bf16_t* Vh = cur.V;
#define DMA_TILE(kb, stg) do { _Pragma("unroll") for (int i = 0; i < 5; ++i) { const int p = wid + 8 * i; \
        const bf16_t* src = (p < 16 ? Vh + (size_t)(kb) * LDV : Kh + (size_t)(kb) * LDK) + soff[i]; \
        __builtin_amdgcn_global_load_lds((const unsigned*)src, (LAS unsigned*)(lds + (stg) + p * 1024), 16, 0, 0); } } while (0)
    DMA_TILE(j_lo * KVBLK, 0);
    bf16x8 qr[12];
#pragma unroll
    for (int d0 = 0; d0 < 12; ++d0) qr[d0] = LD8(cur.Q + (size_t)(wid * QBLK + r32) * LDQ + d0 * 16 + hi * 8);
    __syncthreads();
    float m_reg = -1e30f, l_reg = 0; f32x16 o[4] = {};
    for (int t = 0; t < NT; ++t) {
        const int kb_ = (j_lo + t) * KVBLK, sc_ = (t & 1) * STG;
        if (t + 1 < NT) DMA_TILE(kb_ + KVBLK, STG - sc_);
        SBAR();
        f32x16 p0 = f32x16{}, p1 = f32x16{};
        {
            const int kbase = (int)(uintptr_t)lds + sc_ + SHM_V; int ka[4];
#pragma unroll
            for (int dd = 0; dd < 4; ++dd) ka[dd] = kbase + KSWZ(r32, (dd * 16 + hi * 8) * 2);
            bf16x8 fa0, fa1, fa2, fa3, fb0, fb1, fb2, fb3;
#define KRD(dst, d0, half) asm volatile("ds_read_b128 %0, %1 offset:%2" : "=v"(dst) : "v"(ka[(d0) & 3]), "i"(((d0) >> 2) * 128 + (half) * 32 * KROW) : "memory")
#define KISSUE(f0, f1, f2, f3, j) do { KRD(f0, 2 * (j), 0); KRD(f1, 2 * (j), 1); KRD(f2, 2 * (j) + 1, 0); KRD(f3, 2 * (j) + 1, 1); } while (0)
#define KMMA(f0, f1, f2, f3, j) do { p0 = __builtin_amdgcn_mfma_f32_32x32x16_bf16(f0, qr[2 * (j)], p0, 0, 0, 0); p1 = __builtin_amdgcn_mfma_f32_32x32x16_bf16(f1, qr[2 * (j)], p1, 0, 0, 0); \
            p0 = __builtin_amdgcn_mfma_f32_32x32x16_bf16(f2, qr[2 * (j) + 1], p0, 0, 0, 0); p1 = __builtin_amdgcn_mfma_f32_32x32x16_bf16(f3, qr[2 * (j) + 1], p1, 0, 0, 0); } while (0)
#define KWAIT(n) do { asm volatile("s_waitcnt lgkmcnt(" #n ")" ::: "memory"); SBAR(); } while (0)
            asm volatile("s_waitcnt lgkmcnt(0)" ::: "memory"); SBAR();
            KISSUE(fa0, fa1, fa2, fa3, 0); KISSUE(fb0, fb1, fb2, fb3, 1);
            KWAIT(4); KMMA(fa0, fa1, fa2, fa3, 0); SBAR(); KISSUE(fa0, fa1, fa2, fa3, 2);
            KWAIT(4); KMMA(fb0, fb1, fb2, fb3, 1); SBAR(); KISSUE(fb0, fb1, fb2, fb3, 3);
            KWAIT(4); KMMA(fa0, fa1, fa2, fa3, 2); SBAR(); KISSUE(fa0, fa1, fa2, fa3, 4);
            KWAIT(4); KMMA(fb0, fb1, fb2, fb3, 3); SBAR(); KISSUE(fb0, fb1, fb2, fb3, 5);
            KWAIT(4); KMMA(fa0, fa1, fa2, fa3, 4);
            KWAIT(0); KMMA(fb0, fb1, fb2, fb3, 5); SBAR();
#undef KRD
#undef KISSUE
#undef KMMA
#undef KWAIT
        }
        if (kb_ + KVBLK - 1 > qlo) mask_tile(p0, p1, qm - kb_);
        float mn, alpha; bf16x8 pa0, pa1, pa2, pa3;
        partialSM(p0, p1, m_reg, mn, alpha);
        finishSM(p0, p1, alpha, l_reg, pa0, pa1, pa2, pa3);
        if (__any(alpha < 1.f)) { if (hi == 0) al_l[r32] = alpha; asm volatile("s_waitcnt lgkmcnt(0)" ::: "memory");
#pragma unroll
            for (int d_ = 0; d_ < 4; ++d_)
#pragma unroll
                for (int r = 0; r < 16; ++r) o[d_][r] *= al_l[crow(r, hi)]; }
        SBAR();
        pv_tile<0>(o, vb0 + sc_, pa0, pa1, pa2, pa3);
        __syncthreads();
    }
#undef DMA_TILE
    if (hi == 0) li_l[r32] = l_reg; asm volatile("s_waitcnt lgkmcnt(0)" ::: "memory");
    float rli[16];
#pragma unroll
    for (int r = 0; r < 16; ++r) { const float lv = li_l[crow(r, hi)]; rli[r] = lv > 0.f ? __builtin_amdgcn_rcpf(lv) : 0.f; }
    bf16_t* Ow = cur.O + (size_t)(wid * QBLK) * LDO;
#pragma unroll
    for (int r = 0; r < 16; ++r) { const int orow = crow(r, hi);
#pragma unroll
        for (int d0 = 0; d0 < 4; ++d0) { const float v = o[d0][r] * rli[r]; const float vn = __shfl_xor(v, 1);
            if ((r32 & 1) == 0) *(unsigned*)(Ow + (size_t)orow * LDO + d0 * 32 + r32) = cvtpk(v, vn); } }
    if (hi == 0) { float* mp = cur.ml + (size_t)(wid * QBLK + r32) * 16; mp[0] = m_reg; mp[1] = l_reg; }
    __syncthreads();
}
#undef VMW
#undef LD8
#undef SLOAD_H
#undef SWRITE_H
#undef STG_IDX
#undef KSWZ
#undef SBAR
}
__device__ __forceinline__ att::Ref attn_ref(const Params& P, int h, int qb, int sp) {
    att::Ref r; const int q0 = qb * 256;
    r.Q = WSP(bf16_t, WS_QB) + (size_t)q0 * 1536 + h * 192; r.K = WSP(bf16_t, WS_KB) + h * 192; r.V = WSP(bf16_t, WS_VB) + h * 128;
    r.O = WSP(bf16_t, WS_OPART) + (size_t)sp * S_ * 1024 + (size_t)q0 * 1024 + h * 128; r.ml = WSP(float, WS_ML) + (size_t)sp * S_ * 16 + ((size_t)q0 * 8 + h) * 2;
    r.P0 = q0; r.j_lo = sp ? 2 * (qb + 1) : 0; r.j_hi = sp ? 4 * (qb + 1) : 2 * (qb + 1); return r;
}
__device__ __forceinline__ void attn_run(const Params& P, int wg, int nwg, int wv, char* lds) {
    const int lane = lane_id_();
    for (int pi = wg; pi < 256; pi += nwg) {
        const int h = pi & 7, j = pi >> 3;
        for (int k = 0; k < 2; ++k) { const att::Ref u = attn_ref(P, h, k ? 31 - j : j, k); att::unit(u, lds, wv, lane); }
    }
}

namespace hg {
typedef short bf16x8 __attribute__((ext_vector_type(8)));
constexpr int RS64 = 144, RS128 = 272;
__device__ __forceinline__ void prep_f(const bf16_t* pr, int col, float lbk, float (&cs)[16], float (&kk)[16]) {
    float run = 0.f;
#pragma unroll
    for (int j = 0; j < 16; ++j) { const float hf = bf2f(pr[(size_t)j * DINP + col]); const float f = lbk + (1.f - lbk) * sigmoidf_(hf); kk[j] = 1.f - f; run += __logf(f); cs[j] = run; }
}
__device__ __forceinline__ void store_iT(const bf16_t* pr, int col, LAS unsigned char* iT, int k, int seg) {
    unsigned w[8];
#pragma unroll
    for (int j = 0; j < 8; ++j) w[j] = (unsigned)pr[(size_t)(2 * j) * DINP + col] | ((unsigned)pr[(size_t)(2 * j + 1) * DINP + col] << 16);
    *(LAS u32x4*)(iT + k * RS64 + seg * 32) = (u32x4){w[0], w[1], w[2], w[3]}; *(LAS u32x4*)(iT + k * RS64 + seg * 32 + 16) = (u32x4){w[4], w[5], w[6], w[7]};
}
__device__ __forceinline__ void h1_unit(const Params& P, int c, int h, LAS unsigned char* lds, int wv, int lane) {
    const int tid = wv * 64 + lane, k = tid & 127, seg = tid >> 7, fr = lane & 15, fq = lane >> 4;
    LAS unsigned char* kbT = lds; LAS unsigned char* iT = lds + 18432; LAS float* segtot = (LAS float*)(lds + 36864);
    const bf16_t* pr = WSP(bf16_t, WS_PROJ) + (size_t)(c * 64 + seg * 16) * DINP;
    float cs[16], kk[16];
    prep_f(pr, PC_HF + h * 128 + k, WSP(float, WS_LB)[h * 128 + k], cs, kk);
    segtot[seg * 128 + k] = cs[15];
    store_iT(pr, PC_HI + h * 128 + k, iT, k, seg);
    __syncthreads();
    float off = 0.f, tot = 0.f;
#pragma unroll
    for (int s2 = 0; s2 < 4; ++s2) { const float v = segtot[s2 * 128 + k]; tot += v; off += (s2 < seg) ? v : 0.f; }
    unsigned w[8];
#pragma unroll
    for (int j = 0; j < 8; ++j) w[j] = pk2(kk[2 * j] * __expf(tot - (off + cs[2 * j])), kk[2 * j + 1] * __expf(tot - (off + cs[2 * j + 1])));
    *(LAS u32x4*)(kbT + k * RS64 + seg * 32) = (u32x4){w[0], w[1], w[2], w[3]}; *(LAS u32x4*)(kbT + k * RS64 + seg * 32 + 16) = (u32x4){w[4], w[5], w[6], w[7]};
    if (seg == 0) WSP(float, WS_DVEC)[(c * 8 + h) * 128 + k] = __expf(tot);
    __syncthreads();
    f32x4 acc[8];
#pragma unroll
    for (int nt = 0; nt < 8; ++nt) acc[nt] = (f32x4){0.f, 0.f, 0.f, 0.f};
#pragma unroll
    for (int ks = 0; ks < 2; ++ks) { const bf16x8 a = *(const LAS bf16x8*)(kbT + (16 * wv + fr) * RS64 + ks * 64 + fq * 16);
#pragma unroll
        for (int nt = 0; nt < 8; ++nt) { const bf16x8 b = *(const LAS bf16x8*)(iT + (16 * nt + fr) * RS64 + ks * 64 + fq * 16);
            acc[nt] = __builtin_amdgcn_mfma_f32_16x16x32_bf16(a, b, acc[nt], 0, 0, 0); } }
    bf16_t* Lst = WSP(bf16_t, WS_LST) + (size_t)(c * 8 + h) * 16384;
#pragma unroll
    for (int nt = 0; nt < 8; ++nt) st_bf4(Lst + (16 * nt + fr) * 128 + 16 * wv + 4 * fq, acc[nt]);
    __syncthreads();
}
__device__ __forceinline__ void scan_run(const Params& P, int wg, int nwg, int wv) {
    const bf16_t* Lst = WSP(bf16_t, WS_LST); bf16_t* Sst = WSP(bf16_t, WS_SST); const float* dvec = WSP(float, WS_DVEC);
    for (int e = wg * 512 + wv * 64 + lane_id_(); e < 8 * 16384; e += nwg * 512) {
        const int h = e >> 14, k = e & 127; float S = 0.f;
#pragma unroll 8
        for (int c = 0; c < 128; ++c) { const float L = bf2f(Lst[(size_t)c * 131072 + e]); const float d = dvec[(c * 8 + h) * 128 + k];
            Sst[(size_t)c * 131072 + e] = (bf16_t)f2bf(S); S = d * S + L; }
    }
}
__device__ __forceinline__ void h3_unit(const Params& P, int c, int h, LAS unsigned char* lds, int wv, int lane) {
    const int tid = wv * 64 + lane, k = tid & 127, seg = tid >> 7, fr = lane & 15, fq = lane >> 4;
    LAS unsigned char* qbL = lds; LAS unsigned char* kiL = lds + 17408; LAS unsigned char* iT = lds + 34816; LAS unsigned char* Am = lds + 53248;
    LAS float* segtot = (LAS float*)(lds + 62464); LAS float* rowss = (LAS float*)(lds + 64512);
    const bf16_t* pr = WSP(bf16_t, WS_PROJ) + (size_t)(c * 64 + seg * 16) * DINP;
    const int mt = wv & 3, ntb = (wv >> 2) * 4;
    const bf16_t* Sst = WSP(bf16_t, WS_SST) + (size_t)(c * 8 + h) * 16384;
    bf16x8 sfr[4][4]; bf16_t hqv[16], hgv[4][4];
#pragma unroll
    for (int j = 0; j < 16; ++j) hqv[j] = pr[(size_t)j * DINP + PC_HQ + h * 128 + k];
#pragma unroll
    for (int ks = 0; ks < 4; ++ks)
#pragma unroll
        for (int q = 0; q < 4; ++q) sfr[ks][q] = *(const bf16x8*)(Sst + (16 * (ntb + q) + fr) * 128 + ks * 32 + fq * 8);
#pragma unroll
    for (int r = 0; r < 4; ++r)
#pragma unroll
        for (int q = 0; q < 4; ++q) hgv[r][q] = WSP(bf16_t, WS_PROJ)[(size_t)(c * 64 + 16 * mt + 4 * fq + r) * DINP + PC_HG + h * 128 + 16 * (ntb + q) + fr];
    float cs[16], kk[16];
    prep_f(pr, PC_HF + h * 128 + k, WSP(float, WS_LB)[h * 128 + k], cs, kk);
    segtot[seg * 128 + k] = cs[15];
    store_iT(pr, PC_HI + h * 128 + k, iT, k, seg);
    __syncthreads();
    float off = 0.f;
#pragma unroll
    for (int s2 = 0; s2 < 4; ++s2) { const float v = segtot[s2 * 128 + k]; off += (s2 < seg) ? v : 0.f; }
#pragma unroll
    for (int j = 0; j < 16; ++j) { const float b = off + cs[j]; const float q = siluf_(bf2f(hqv[j]));
        *(LAS bf16_t*)(qbL + (seg * 16 + j) * RS128 + k * 2) = (bf16_t)f2bf(q * __expf(b));
        *(LAS bf16_t*)(kiL + (seg * 16 + j) * RS128 + k * 2) = (bf16_t)f2bf(kk[j] * __expf(fminf(-b, 80.f))); }
    __syncthreads();
    { const int mta = wv >> 1;
#pragma unroll
      for (int q = 0; q < 2; ++q) { const int nt = (wv & 1) * 2 + q; f32x4 acc = {0.f, 0.f, 0.f, 0.f};
          if (nt <= mta) {
#pragma unroll
              for (int ks = 0; ks < 4; ++ks) { const bf16x8 a = *(const LAS bf16x8*)(qbL + (16 * mta + fr) * RS128 + ks * 64 + fq * 16);
                  const bf16x8 b = *(const LAS bf16x8*)(kiL + (16 * nt + fr) * RS128 + ks * 64 + fq * 16);
                  acc = __builtin_amdgcn_mfma_f32_16x16x32_bf16(a, b, acc, 0, 0, 0); } }
          const int s_ = 16 * nt + fr;
#pragma unroll
          for (int r = 0; r < 4; ++r) { const int t_ = 16 * mta + 4 * fq + r; *(LAS bf16_t*)(Am + t_ * RS64 + s_ * 2) = (bf16_t)f2bf(s_ <= t_ ? acc[r] : 0.f); } } }
    __syncthreads();
    f32x4 acc[4];
#pragma unroll
    for (int q = 0; q < 4; ++q) acc[q] = (f32x4){0.f, 0.f, 0.f, 0.f};
#pragma unroll
    for (int ks = 0; ks < 2; ++ks) { const bf16x8 a = *(const LAS bf16x8*)(Am + (16 * mt + fr) * RS64 + ks * 64 + fq * 16);
#pragma unroll
        for (int q = 0; q < 4; ++q) { const bf16x8 b = *(const LAS bf16x8*)(iT + (16 * (ntb + q) + fr) * RS64 + ks * 64 + fq * 16);
            acc[q] = __builtin_amdgcn_mfma_f32_16x16x32_bf16(a, b, acc[q], 0, 0, 0); } }
#pragma unroll
    for (int ks = 0; ks < 4; ++ks) { const bf16x8 a = *(const LAS bf16x8*)(qbL + (16 * mt + fr) * RS128 + ks * 64 + fq * 16);
#pragma unroll
        for (int q = 0; q < 4; ++q) acc[q] = __builtin_amdgcn_mfma_f32_16x16x32_bf16(a, sfr[ks][q], acc[q], 0, 0, 0); }
    float ss[4];
#pragma unroll
    for (int r = 0; r < 4; ++r) { float v = 0.f;
#pragma unroll
        for (int q = 0; q < 4; ++q) v += acc[q][r] * acc[q][r];
        v += __shfl_xor(v, 1); v += __shfl_xor(v, 2); v += __shfl_xor(v, 4); v += __shfl_xor(v, 8); ss[r] = v; }
    if (fr == 0) {
#pragma unroll
        for (int r = 0; r < 4; ++r) rowss[(wv >> 2) * 64 + 16 * mt + 4 * fq + r] = ss[r]; }
    __syncthreads();
    bf16_t* ymix = WSP(bf16_t, WS_YMIX);
#pragma unroll
    for (int r = 0; r < 4; ++r) { const int t_ = 16 * mt + 4 * fq + r; const float rs = 1.f / sqrtf((rowss[t_] + rowss[64 + t_]) * (1.f / 128.f) + EPS);
        const size_t row = (size_t)(c * 64 + t_);
#pragma unroll
        for (int q = 0; q < 4; ++q) { const int v_ = 16 * (ntb + q) + fr; const float g = bf2f(hgv[r][q]);
            ymix[row * D_ + 1024 + h * 128 + v_] = (bf16_t)f2bf(acc[q][r] * rs * siluf_(g)); } }
    __syncthreads();
}
__device__ __forceinline__ void h1_run(const Params& P, int wg, int nwg, int wv, LAS unsigned char* lds) { const int lane = lane_id_(); for (int u = wg; u < 1024; u += nwg) h1_unit(P, u >> 3, u & 7, lds, wv, lane); }
__device__ __forceinline__ void h3_run(const Params& P, int wg, int nwg, int wv, LAS unsigned char* lds) { const int lane = lane_id_(); for (int u = wg; u < 1024; u += nwg) h3_unit(P, u >> 3, u & 7, lds, wv, lane); }
}

__device__ __forceinline__ void route_mfma_run(const Params& P, int wg, int nwg, int wv, LAS unsigned char* lds) {
    const int lane = lane_id_(), r = lane & 15, g = lane >> 4, tt = wv & 1, kq = wv >> 1;
    LAS float* part = (LAS float*)lds;
    const float* h1 = P.out; const f32x4* WrF = WSP(f32x4, WS_WR); const float* part1 = WSP(float, WS_PART1);
    int* cnt = WSP(int, WS_CTL); int* list = WSP(int, WS_LIST); int* eid = WSP(int, WS_EID); float* ew = WSP(float, WS_EW); float* rstd1 = WSP(float, WS_RSTD1);
    for (int tb = wg; tb < S_ / 32; tb += nwg) {
        const float* arow = h1 + (size_t)(tb * 32 + tt * 16 + r) * D_ + kq * 512 + 4 * g;
        const f32x4* wf = WrF + (size_t)(kq * 32) * 5 * 64 + lane;
        f32x4 acc[5];
#pragma unroll
        for (int t5 = 0; t5 < 5; ++t5) acc[t5] = (f32x4){0.f, 0.f, 0.f, 0.f};
#pragma unroll 2
        for (int kb = 0; kb < 32; ++kb) { const f32x4 a = *(const f32x4*)(arow + kb * 16);
#pragma unroll
            for (int t5 = 0; t5 < 5; ++t5) { const f32x4 b = wf[(kb * 5 + t5) * 64];
                acc[t5] = __builtin_amdgcn_mfma_f32_16x16x4f32(a.x, b.x, acc[t5], 0, 0, 0); acc[t5] = __builtin_amdgcn_mfma_f32_16x16x4f32(a.y, b.y, acc[t5], 0, 0, 0);
                acc[t5] = __builtin_amdgcn_mfma_f32_16x16x4f32(a.z, b.z, acc[t5], 0, 0, 0); acc[t5] = __builtin_amdgcn_mfma_f32_16x16x4f32(a.w, b.w, acc[t5], 0, 0, 0); } }
#pragma unroll
        for (int t5 = 0; t5 < 5; ++t5)
#pragma unroll
            for (int q = 0; q < 4; ++q) part[wv * 1280 + (4 * g + q) * 80 + 16 * t5 + r] = acc[t5][q];
        __syncthreads();
        if (wv == 0 && lane < 32) {
            const int t = tb * 32 + lane, t2 = lane >> 4, tr = lane & 15; const LAS float* pp = part + t2 * 1280 + tr * 80;
#define LG(j) ((pp[(j)] + pp[2560 + (j)]) + (pp[5120 + (j)] + pp[7680 + (j)]))
            float ss = 0.f; { const f32x4* p4 = (const f32x4*)(part1 + (size_t)t * 32);
#pragma unroll
                for (int i = 0; i < 8; ++i) { const f32x4 v = p4[i]; ss += (v.x + v.y) + (v.z + v.w); } }
            const float rs = 1.f / sqrtf(ss * (1.f / D_) + EPS);
            rstd1[t] = rs;
            int gi = 0; float gm = -INFINITY;
            for (int i = 0; i < 8; ++i) { const float v = LG(i) * rs + P.b_rg[i]; if (v > gm) { gm = v; gi = i; } }
            float gs = 0.f; for (int i = 0; i < 8; ++i) gs += expf(LG(i) * rs + P.b_rg[i] - gm);
            const float gw_ = 1.f / gs;
            int i1 = 0, i2 = 0; float l1 = -INFINITY, l2 = -INFINITY;
            for (int i = 0; i < 8; ++i) { const float e = LG(8 + gi * 8 + i) * rs + P.b_re[gi * 8 + i];
                if (e > l1) { l2 = l1; i2 = i1; l1 = e; i1 = i; } else if (e > l2) { l2 = e; i2 = i; } }
#undef LG
            const float p2 = expf(l2 - l1), w1 = gw_ / (1.f + p2), w2 = gw_ * p2 / (1.f + p2);
            const int e1 = gi * 8 + i1, e2 = gi * 8 + i2;
            eid[2 * t] = e1; eid[2 * t + 1] = e2; ew[2 * t] = w1; ew[2 * t + 1] = w2;
            const int p1 = atomicAdd(&cnt[e1], 1); list[e1 * LISTCAP + p1] = 2 * t;
            const int q2 = atomicAdd(&cnt[e2], 1); list[e2 * LISTCAP + q2] = 2 * t + 1;
        }
        __syncthreads();
    }
}

constexpr int LDS_TAB = 131072;
__device__ __forceinline__ int moe_build_tab(const int* cnt, LAS unsigned char* lds, int wv) {
    LAS int* tab = (LAS int*)(lds + LDS_TAB);
    if (wv == 0 && lane_id_() == 0) { int nt = 0;
        for (int e = 0; e < NE; ++e) { const int n = cnt[e]; for (int r = 0; r * 256 < n; ++r) { tab[1 + nt] = e; tab[129 + nt] = r; ++nt; } }
        tab[0] = nt; }
    __syncthreads();
    return __builtin_amdgcn_readfirstlane(tab[0]);
}
struct MoeOrder {
    const int* cnt; const int* list; LAS const int* tab; int ntiles, npn, G, c; const char* A; const char* B; size_t bexp, btile, atile; bool gather;
    __device__ __forceinline__ bool next(int i, pg8::Unit& u) const {
        const int L = i * G + c; if (L >= ntiles * npn) return false;
        const int tile = L / npn, pn = L - tile * npn;
        const int e = __builtin_amdgcn_readfirstlane(tab[1 + tile]), rt = __builtin_amdgcn_readfirstlane(tab[129 + tile]);
        u.pm = tile; u.pn = pn; u.x0 = e; u.x1 = rt * 256; u.x2 = __builtin_amdgcn_readfirstlane(cnt[e]);
        u.b = B + (size_t)e * bexp + (size_t)pn * btile; u.a = gather ? A : A + (size_t)tile * atile; return true;
    }
    __device__ __forceinline__ unsigned row_off(const pg8::Unit& u, int R) const { int idx = u.x1 + R; idx = idx < u.x2 ? idx : 0; return (unsigned)(list[u.x0 * LISTCAP + idx] >> 1) * (unsigned)(D_ * 2); }
};
struct MoeUpEpi { const int* list; const float* rstd1; bf16_t* hmid;
    __device__ __forceinline__ void operator()(const f32x4 (&acc)[2][2][4][2], const pg8::Unit& u, int wr, int wc, int fr, int fq) const {
#pragma unroll
        for (int ai = 0; ai < 2; ++ai)
#pragma unroll
            for (int m = 0; m < 4; ++m) { const int r = ai * 128 + wr * 64 + m * 16 + fr; int idx = u.x1 + r; idx = idx < u.x2 ? idx : 0;
                const float rs = rstd1[list[u.x0 * LISTCAP + idx] >> 1];
#pragma unroll
                for (int n = 0; n < 2; ++n) { const f32x4 g = acc[ai][0][m][n] * rs, up = acc[ai][1][m][n] * rs;
                    const f32x4 h = {siluf_(g.x) * up.x, siluf_(g.y) * up.y, siluf_(g.z) * up.z, siluf_(g.w) * up.w};
                    st_bf4(hmid + (size_t)(u.pm * 256 + r) * DE + u.pn * 128 + wc * 32 + n * 16 + fq * 4, h); }
                asm volatile("" ::: "memory"); }
    } };
struct MoeDownEpi { const int* list; const float* ew; bf16_t* y;
    __device__ __forceinline__ void operator()(const f32x4 (&acc)[2][2][4][2], const pg8::Unit& u, int wr, int wc, int fr, int fq) const {
#pragma unroll
        for (int ai = 0; ai < 2; ++ai)
#pragma unroll
            for (int m = 0; m < 4; ++m) { const int r = ai * 128 + wr * 64 + m * 16 + fr; const int idx = u.x1 + r; const bool valid = idx < u.x2;
                const int a = list[u.x0 * LISTCAP + (valid ? idx : 0)]; const float w = ew[a];
                if (valid) {
#pragma unroll
                    for (int bj = 0; bj < 2; ++bj)
#pragma unroll
                        for (int n = 0; n < 2; ++n) st_bf4(y + (size_t)a * D_ + u.pn * 256 + bj * 128 + wc * 32 + n * 16 + fq * 4, acc[ai][bj][m][n] * w); }
                asm volatile("" ::: "memory"); }
    } };
__device__ __forceinline__ void moe_up_run(const Params& P, int wg, int nwg, int wv, LAS unsigned char* lds) {
    const int nt = moe_build_tab(WSP(int, WS_CTL), lds, wv);
    MoeOrder S{WSP(int, WS_CTL), WSP(int, WS_LIST), (LAS const int*)(lds + LDS_TAB), nt, 4, nwg, wg, (const char*)WSP(bf16_t, WS_H1B), (const char*)WSP(bf16_t, WS_WGU), (size_t)1024 * 2048 * 2, (size_t)256 * 2048 * 2, 0, true};
    MoeUpEpi E{WSP(int, WS_LIST), WSP(float, WS_RSTD1), WSP(bf16_t, WS_HMID)};
    int K = D_, lda = D_; asm volatile("" : "+s"(K), "+s"(lda));
    pg8::gemm_phase<MoeUpEpi, MoeOrder, true>(lds, K, lda, S, E, wv);
}
__device__ __forceinline__ void moe_down_run(const Params& P, int wg, int nwg, int wv, LAS unsigned char* lds) {
    const int nt = moe_build_tab(WSP(int, WS_CTL), lds, wv);
    MoeOrder S{WSP(int, WS_CTL), WSP(int, WS_LIST), (LAS const int*)(lds + LDS_TAB), nt, 8, nwg, wg, (const char*)WSP(bf16_t, WS_HMID), (const char*)WSP(bf16_t, WS_WD), (size_t)2048 * DE * 2, (size_t)256 * DE * 2, (size_t)256 * DE * 2, false};
    MoeDownEpi E{WSP(int, WS_LIST), WSP(float, WS_EW), WSP(bf16_t, WS_Y)};
    int K = DE, lda = DE; asm volatile("" : "+s"(K), "+s"(lda));
    pg8::gemm_phase<MoeDownEpi, MoeOrder, false>(lds, K, lda, S, E, wv);
}

namespace rsg {
typedef short bf16x8 __attribute__((ext_vector_type(8)));
constexpr int MR = 320, MF = 5, ABUF = MR * 128, BBUF = 128 * 128, BUF = ABUF + BBUF;
__device__ __forceinline__ int swz(int row, int chunk) { return row * 128 + ((chunk ^ (row & 7)) << 4); }
__device__ __forceinline__ int swzB(int row, int chunk) { return row * 128 + ((chunk ^ ((row ^ (row >> 2)) & 7)) << 4); }
template <bool UP, class Epi>
__device__ __forceinline__ void tile(LAS unsigned char* lds, const char* abase, const unsigned (&aoff)[MF], const float* Bg, const float* Bu, const float* gain, int ldn, int K, int nrows, const Epi& E, int wv, int lane) {
    const int tid = wv * 64 + lane, wr = wv >> 1, wc = wv & 1, fr = lane & 15, fq = lane >> 4;
    const int ach = tid & 7, arow = tid >> 3;
    const int bn4 = tid & 31, bkq = tid >> 5;
    const float* bsrc = ((UP && bn4 >= 16) ? Bu + 4 * (bn4 - 16) : Bg + 4 * bn4) + (size_t)(4 * bkq) * ldn;
    const int nk = K / 64;
    const int mcount = (nrows - 16 * MF * wr + 15) >> 4;
    u32x4 sa[MF]; f32x4 sb0[4], sb1[4];
#define RS_LOADA(kt) do { _Pragma("unroll") for (int i = 0; i < MF; ++i) sa[i] = *(const u32x4*)(abase + aoff[i] + (kt) * 128 + ach * 16); } while (0)
#define RS_LOADB(SB, kt) do { _Pragma("unroll") for (int j = 0; j < 4; ++j) SB[j] = *(const f32x4*)(bsrc + (size_t)((kt) * 64 + j) * ldn); } while (0)
#define RS_WRITE(SB, kt, bf) do { LAS unsigned char* Ab = lds + (bf) * BUF; LAS unsigned char* Bb = Ab + ABUF; \
        _Pragma("unroll") for (int i = 0; i < MF; ++i) *(LAS u32x4*)(Ab + swz(arow + 64 * i, ach)) = sa[i]; \
        f32x4 g_ = {1.f, 1.f, 1.f, 1.f}; if (UP) g_ = *(const LAS f32x4*)(lds + 114688 + ((kt) * 64 + 4 * bkq) * 4);     \
        _Pragma("unroll") for (int c = 0; c < 4; ++c) { u32x2 w; w.x = pk2(SB[0][c] * g_.x, SB[1][c] * g_.y); w.y = pk2(SB[2][c] * g_.z, SB[3][c] * g_.w); \
            *(LAS u32x2*)(Bb + swzB(4 * bn4 + c, bkq >> 1) + (bkq & 1) * 8) = w; } } while (0)
#define RS_COMPUTE(bf) do { const LAS unsigned char* Ab = lds + (bf) * BUF; const LAS unsigned char* Bb = Ab + ABUF; \
        _Pragma("unroll") for (int ks = 0; ks < 2; ++ks) { bf16x8 b[4]; \
            _Pragma("unroll") for (int ni = 0; ni < 4; ++ni) { const int nrow = UP ? ((ni >> 1) * 64 + 32 * wc + 16 * (ni & 1)) : (64 * wc + 16 * ni); b[ni] = *(const LAS bf16x8*)(Bb + swzB(nrow + fr, ks * 4 + fq)); } \
            if (!UP) { bf16x8 an = *(const LAS bf16x8*)(Ab + swz(16 * MF * wr + fr, ks * 4 + fq)); \
            _Pragma("unroll") for (int mi = 0; mi < MF; ++mi) { const bf16x8 a = an; if (mi + 1 < MF) an = *(const LAS bf16x8*)(Ab + swz(16 * MF * wr + 16 * (mi + 1) + fr, ks * 4 + fq)); \
                if (mi < mcount) { _Pragma("unroll") for (int ni = 0; ni < 4; ++ni) acc[mi][ni] = __builtin_amdgcn_mfma_f32_16x16x32_bf16(b[ni], a, acc[mi][ni], 0, 0, 0); } } } else { \
            _Pragma("unroll") for (int mi = 0; mi < MF; ++mi) if (mi < mcount) { const bf16x8 a = *(const LAS bf16x8*)(Ab + swz(16 * MF * wr + 16 * mi + fr, ks * 4 + fq)); \
                _Pragma("unroll") for (int ni = 0; ni < 4; ++ni) acc[mi][ni] = __builtin_amdgcn_mfma_f32_16x16x32_bf16(b[ni], a, acc[mi][ni], 0, 0, 0); } } } } while (0)
#define RS_STEP(t, SBfree, SBnext) do { if ((t) < nk) { if ((t) + 2 < nk) RS_LOADB(SBfree, (t) + 2); RS_COMPUTE((t) & 1); \
        if ((t) + 1 < nk) { RS_WRITE(SBnext, (t) + 1, ((t) + 1) & 1); if ((t) + 2 < nk) RS_LOADA((t) + 2); } __syncthreads(); } } while (0)
    f32x4 acc[MF][4];
#pragma unroll
    for (int mi = 0; mi < MF; ++mi)
#pragma unroll
        for (int ni = 0; ni < 4; ++ni) acc[mi][ni] = (f32x4){0.f, 0.f, 0.f, 0.f};
    RS_LOADA(0); RS_LOADB(sb0, 0); RS_LOADB(sb1, 1);
    RS_WRITE(sb0, 0, 0); RS_LOADA(1);
    __syncthreads();
    for (int t = 0; t < nk; t += 2) { RS_STEP(t, sb0, sb1); RS_STEP(t + 1, sb1, sb0); }
    E(acc, wr, wc, fr, fq);
#undef RS_LOADA
#undef RS_LOADB
#undef RS_WRITE
#undef RS_COMPUTE
#undef RS_STEP
}
}
__device__ __forceinline__ void moe_offsets(const int* cnt, LAS unsigned char* lds, int wv) {
    LAS int* off = (LAS int*)(lds + 131072);
    if (wv == 0 && lane_id_() == 0) { int a = 0; for (int e = 0; e < NE; ++e) { off[e] = a; a += cnt[e]; } off[NE] = a; }
    __syncthreads();
}
struct RsUpEpi { bf16_t* hrow0; int n; int c0; float rs[rsg::MF];
    __device__ __forceinline__ void operator()(const f32x4 (&acc)[rsg::MF][4], int wr, int wc, int fr, int fq) const {
#pragma unroll
        for (int mi = 0; mi < rsg::MF; ++mi) { const int r = 16 * rsg::MF * wr + 16 * mi + fr; if (r < n) {
#pragma unroll
            for (int q = 0; q < 2; ++q) { const f32x4 g = acc[mi][q] * rs[mi], up = acc[mi][2 + q] * rs[mi];
                const f32x4 h = {siluf_(g.x) * up.x, siluf_(g.y) * up.y, siluf_(g.z) * up.z, siluf_(g.w) * up.w};
                st_bf4(hrow0 + (size_t)r * DE + c0 + 32 * wc + 16 * q + 4 * fq, h); } } }
    } };
struct RsDownEpi { bf16_t* y; int n; int c0; const float* ew; int a[rsg::MF];
    __device__ __forceinline__ void operator()(const f32x4 (&acc)[rsg::MF][4], int wr, int wc, int fr, int fq) const {
#pragma unroll
        for (int mi = 0; mi < rsg::MF; ++mi) { const int r = 16 * rsg::MF * wr + 16 * mi + fr; if (r < n) {
            { const float w = ew[a[mi]];
#pragma unroll
              for (int ni = 0; ni < 4; ++ni) st_bf4(y + (size_t)a[mi] * D_ + c0 + 64 * wc + 16 * ni + 4 * fq, acc[mi][ni] * w); } } }
    } };
__device__ __forceinline__ void moe_up_rs_run(const Params& P, int wg, int nwg, int wv, LAS unsigned char* lds) {
    const int* cnt = WSP(int, WS_CTL); const int* list = WSP(int, WS_LIST); const int lane = lane_id_(), tid = wv * 64 + lane;
    for (int i = tid; i < D_; i += 512) *(LAS float*)(lds + 114688 + i * 4) = P.ffn_norm[i];
    moe_offsets(cnt, lds, wv); LAS const int* off = (LAS const int*)(lds + 131072);
    for (int u = wg; u < NE * 8; u += nwg) {
        int e = u >> 3, hs = u & 7;
        if (nwg == 256) { const int xcd = wg & 7, idx = wg >> 3; e = (u >> 8) * 32 + xcd * 4 + (idx >> 3); hs = idx & 7; } const int n = __builtin_amdgcn_readfirstlane(cnt[e]), o0 = __builtin_amdgcn_readfirstlane(off[e]);
        const int* lst = list + e * LISTCAP;
        for (int r0 = 0; r0 < n; r0 += rsg::MR) { const int nr = (n - r0) < rsg::MR ? (n - r0) : rsg::MR;
            unsigned aoff[rsg::MF];
#pragma unroll
            for (int i = 0; i < rsg::MF; ++i) { int idx = (tid >> 3) + 64 * i; idx = idx < nr ? idx : 0; aoff[i] = (unsigned)(lst[r0 + idx] >> 1) * (unsigned)(D_ * 2); }
            RsUpEpi E; E.hrow0 = WSP(bf16_t, WS_HMID) + (size_t)(o0 + r0) * DE; E.n = nr; E.c0 = hs * 64;
#pragma unroll
            for (int mi = 0; mi < rsg::MF; ++mi) { int r = 16 * rsg::MF * (wv >> 1) + 16 * mi + (lane & 15); r = r < nr ? r : 0; E.rs[mi] = WSP(float, WS_RSTD1)[lst[r0 + r] >> 1]; }
            rsg::tile<true>(lds, (const char*)WSP(bf16_t, WS_H1B), aoff, P.w_eg + (size_t)e * 2048 * DE + hs * 64, P.w_eu + (size_t)e * 2048 * DE + hs * 64, P.ffn_norm, DE, D_, nr, E, wv, lane); }
    }
}
__device__ __forceinline__ void moe_down_rs_run(const Params& P, int wg, int nwg, int wv, LAS unsigned char* lds) {
    const int* cnt = WSP(int, WS_CTL); const int* list = WSP(int, WS_LIST); const int lane = lane_id_(), tid = wv * 64 + lane;
    moe_offsets(cnt, lds, wv); LAS const int* off = (LAS const int*)(lds + 131072);
    for (int u = wg; u < NE * 16; u += nwg) {
        int e = u >> 4, cs = u & 15;
        if (nwg == 256) { const int xcd = wg & 7, idx = wg >> 3; e = (u >> 8) * 16 + xcd * 2 + (idx >> 4); cs = idx & 15; } const int n = __builtin_amdgcn_readfirstlane(cnt[e]), o0 = __builtin_amdgcn_readfirstlane(off[e]);
        const int* lst = list + e * LISTCAP;
        for (int r0 = 0; r0 < n; r0 += rsg::MR) { const int nr = (n - r0) < rsg::MR ? (n - r0) : rsg::MR;
            unsigned aoff[rsg::MF];
#pragma unroll
            for (int i = 0; i < rsg::MF; ++i) { int idx = (tid >> 3) + 64 * i; idx = idx < nr ? idx : 0; aoff[i] = (unsigned)(o0 + r0 + idx) * (unsigned)(DE * 2); }
            RsDownEpi E; E.y = WSP(bf16_t, WS_Y); E.n = nr; E.c0 = cs * 128; E.ew = WSP(float, WS_EW);
#pragma unroll
            for (int mi = 0; mi < rsg::MF; ++mi) { int r = 16 * rsg::MF * (wv >> 1) + 16 * mi + (lane & 15); r = r < nr ? r : 0; E.a[mi] = lst[r0 + r]; }
            rsg::tile<false>(lds, (const char*)WSP(bf16_t, WS_HMID), aoff, P.w_ed + (size_t)e * DE * 2048 + cs * 128, nullptr, nullptr, 2048, DE, nr, E, wv, lane); }
    }
}

#define XB_TMO      128
#define XB_XCNT(j)  (256  + 64 * (j))
#define XB_XSUB(j)  (1280 + 64 * (j))
#define XB_XGEN(j)  (2304 + 64 * (j))
#define XB_TOP      3328
#define XB_TOPGEN   3392
#define XCD_BAR_WORDS 3456
#define XB_SPIN_CAP (1u << 18)
__device__ __forceinline__ unsigned xb_ld(unsigned* p)              { return __hip_atomic_load(p, __ATOMIC_RELAXED, __HIP_MEMORY_SCOPE_AGENT); }
__device__ __forceinline__ unsigned xb_add(unsigned* p, unsigned v) { return __hip_atomic_fetch_add(p, v, __ATOMIC_RELAXED, __HIP_MEMORY_SCOPE_AGENT); }
__device__ __forceinline__ unsigned xb_xcc_id() { return (unsigned)__builtin_amdgcn_s_getreg((3 << 11) | 20) & 0xFu; }
#define XB_SPIN(cond, bar) do { unsigned _sp = 0; while (cond) { __builtin_amdgcn_s_sleep(1); \
    if ((++_sp & 255u) == 0u) { if (xb_ld(&(bar)[XB_TMO])) break; if (_sp > XB_SPIN_CAP) { atomicAdd(&(bar)[XB_TMO], 1u); break; } } } } while (0)
struct XcdBarrier { unsigned* bar; unsigned x; volatile LAS unsigned* st; };
__device__ __forceinline__ void xcd_barrier_complete(unsigned* bar, unsigned x, unsigned& nloc, unsigned& nx) {
    const unsigned G = gridDim.x * gridDim.y * gridDim.z;
    unsigned sum, cnt, mine, sp = 0u;
    for (;;) {
        sum = 0u; cnt = 0u; mine = 0u;
#pragma unroll
        for (unsigned j = 0; j < 16; ++j) { const unsigned c = xb_ld(&bar[XB_XCNT(j)]); sum += c; cnt += (c > 0u) ? 1u : 0u; mine = (j == x) ? c : mine; }
        if (sum == G) break;
        __builtin_amdgcn_s_sleep(1);
        if ((++sp & 255u) == 0u) { if (xb_ld(&bar[XB_TMO])) break; if (sp > XB_SPIN_CAP) { atomicAdd(&bar[XB_TMO], 1u); break; } }
    }
    nloc = mine > 0u ? mine : 1u; nx = cnt > 0u ? cnt : 1u;
}
__device__ __forceinline__ void xcd_barrier(const XcdBarrier& b, bool leader_thread) {
    asm volatile("s_waitcnt vmcnt(0)" ::: "memory");
    __syncthreads();
    if (leader_thread) {
        unsigned* bar = b.bar;
        __builtin_amdgcn_s_waitcnt(0);
        unsigned nloc = b.st[0], nx = b.st[1];
        if (nloc == 0u) { xcd_barrier_complete(bar, b.x, nloc, nx); b.st[0] = nloc; b.st[1] = nx; }
        const unsigned old = xb_add(&bar[XB_XSUB(b.x)], 1u);
        const unsigned gen = old / nloc;
        if (old + 1u == (gen + 1u) * nloc) {
            __builtin_amdgcn_fence(__ATOMIC_RELEASE, "agent");
            asm volatile("s_waitcnt vmcnt(0)" ::: "memory");
            const unsigned og = xb_add(&bar[XB_TOP], 1u);
            const unsigned tg = og / nx;
            if (og + 1u == (tg + 1u) * nx) xb_add(&bar[XB_TOPGEN], 1u);
            else XB_SPIN(xb_ld(&bar[XB_TOPGEN]) == tg, bar);
            __builtin_amdgcn_fence(__ATOMIC_ACQUIRE, "agent");
            xb_add(&bar[XB_XGEN(b.x)], 1u);
            asm volatile("s_waitcnt vmcnt(0)" ::: "memory");
        } else {
            XB_SPIN(xb_ld(&bar[XB_XGEN(b.x)]) == gen, bar);
            __builtin_amdgcn_fence(__ATOMIC_ACQUIRE, "agent");
            asm volatile("s_waitcnt vmcnt(0)" ::: "memory");
        }
    }
    __syncthreads();
}

namespace cg = cooperative_groups;
constexpr int LDS_BYTES = 147456;
constexpr int NPHASE = 12;
#ifndef MK_MULTI
#define MK_MULTI 0
#endif
__global__ void __launch_bounds__(512, 2) mk_fwd(Params P, int ph_lo, int ph_hi) {
    extern __shared__ __attribute__((aligned(16))) unsigned char lds_raw[];
    LAS unsigned char* lds = (LAS unsigned char*)lds_raw;
    const int wg = blockIdx.x, nwg = gridDim.x, wv = __builtin_amdgcn_readfirstlane(threadIdx_x_raw() >> 6);
#define PH(k) if (ph_lo <= (k) && (k) < ph_hi)
    const bool leader_thread = (wv == 0 && lane_id_() == 0);
    volatile LAS unsigned* xst = (volatile LAS unsigned*)(lds + 139264);
    if (leader_thread) { xst[0] = 0u; xst[1] = 0u; }
    __syncthreads();
    XcdBarrier xbar; xbar.bar = WSP(unsigned, WS_CTL) + 4096; xbar.x = xb_xcc_id(); xbar.st = xst;
    if (leader_thread && ph_hi - ph_lo > 1) (void)xb_add(&xbar.bar[XB_XCNT(xbar.x)], 1u);
    if (ph_lo < 0) cg::this_grid().sync();
#define SEAM(k) do { if ((k) + 1 < ph_hi) xcd_barrier(xbar, leader_thread); } while (0)
    PH(0) { p0_run(P, wg, nwg, wv, lds); SEAM(0); }
    PH(1) { dense_gemm(lds, WSP(bf16_t, WS_XB), D_, WSP(bf16_t, WS_WIN), S_, DINP, D_, PFProj{WSP(bf16_t, WS_PROJ), WSP(float, WS_RSTDX), WSP(float, WS_PARTQ)}, wg, nwg, wv);
            if (nwg == 256) { if (wg >= 128) { dense_gemm(lds, WSP(bf16_t, WS_PB), PLE, WSP(bf16_t, WS_WPP), S_, D_, PLE, PFPP{WSP(bf16_t, WS_PP)}, wg - 128, 128, wv); __syncthreads(); p1_late_conv(P, (wg - 128) * 8 + wv, 1024, wv, lds); } }
            else dense_gemm(lds, WSP(bf16_t, WS_PB), PLE, WSP(bf16_t, WS_WPP), S_, D_, PLE, PFPP{WSP(bf16_t, WS_PP)}, wg, nwg, wv);
            SEAM(1); }
    PH(2) { dense_gemm(lds, WSP(bf16_t, WS_PROJ) + PC_CQ, DINP, WSP(bf16_t, WS_WUQ), S_, 1536, 512, PFQ{WSP(bf16_t, WS_QB), WSP(float, WS_PARTQ), WSP(float, WS_COS), WSP(float, WS_SIN)}, wg, nwg, wv);
            dense_gemm(lds, WSP(bf16_t, WS_PROJ) + PC_CKV, DINP, WSP(bf16_t, WS_WUKV), S_, 2048, 256, PFKV{WSP(bf16_t, WS_KB), WSP(bf16_t, WS_VB), WSP(float, WS_PARTQ)}, wg, nwg, wv);
            kpe_run(P, wg, nwg, wv); hg::h1_run(P, wg, nwg, wv, lds); SEAM(2); }
    PH(3) { hg::scan_run(P, wg, nwg, wv); attn_run(P, wg, nwg, wv, (char*)lds_raw); SEAM(3); }
    PH(4) { combine_run(P, wg, nwg, wv); hg::h3_run(P, wg, nwg, wv, lds); SEAM(4); }
    PH(5) { dense_gemm(lds, WSP(bf16_t, WS_YMIX), D_, WSP(bf16_t, WS_WOUT), S_, D_, D_, PFOut{P.x, P.out, WSP(bf16_t, WS_H1B), WSP(float, WS_PART1)}, wg, nwg, wv); SEAM(5); }
    PH(6) { route_mfma_run(P, wg, nwg, wv, lds); SEAM(6); }
    PH(7) { moe_up_rs_run(P, wg, nwg, wv, lds); SEAM(7); }
    PH(8) { moe_down_rs_run(P, wg, nwg, wv, lds); SEAM(8); }
    PH(9) { moe_combine_run(P, wg, nwg, wv); SEAM(9); }
    PH(10) { dense_gemm(lds, WSP(bf16_t, WS_H2B), D_, WSP(bf16_t, WS_WPG), S_, D_, D_, PFPle{P.out, WSP(bf16_t, WS_PP), WSP(float, WS_RSTD2), P.b_pg, WSP(float, WS_PART3)}, wg, nwg, wv); SEAM(10); }
    PH(11) { final_run(P, wg, nwg, wv); }
#undef PH
#undef SEAM
}

extern "C" void kernel_launch(void* const* d_in, const int* in_sizes, int n_in, void* d_out, int out_size, void* d_ws, size_t ws_size, hipStream_t stream) {
    if (n_in != 26 || ws_size < WS_END) { fprintf(stderr, "kernel_launch: unexpected n_in %d or ws_size %zu (< %zu)\n", n_in, ws_size, (size_t)WS_END); return; }
    static int grid = 0;
    if (grid == 0) {
        int dev = 0, cus = 0, per_cu = 0;
        (void)hipGetDevice(&dev); (void)hipDeviceGetAttribute(&cus, hipDeviceAttributeMultiprocessorCount, dev);
        (void)hipFuncSetAttribute((const void*)mk_fwd, hipFuncAttributeMaxDynamicSharedMemorySize, LDS_BYTES);
        if (hipOccupancyMaxActiveBlocksPerMultiprocessor(&per_cu, (const void*)mk_fwd, 512, LDS_BYTES) != hipSuccess || per_cu < 1) { fprintf(stderr, "kernel_launch: occupancy query says %d blocks/CU\n", per_cu); per_cu = 1; }
        (void)hipGetLastError();
        grid = cus > 0 ? cus : 256;
    }
    Params P{};
    P.x = (const float*)d_in[0]; P.p = (const float*)d_in[1]; P.pos = (const int*)d_in[2];
    P.attn_norm = (const float*)d_in[3]; P.w_in = (const float*)d_in[4]; P.q_norm = (const float*)d_in[5]; P.w_uq = (const float*)d_in[6];
    P.kv_norm = (const float*)d_in[7]; P.w_ukv = (const float*)d_in[8]; P.mla_norm = (const float*)d_in[9]; P.lb_logits = (const float*)d_in[10];
    P.hg_norm = (const float*)d_in[11]; P.w_out = (const float*)d_in[12]; P.ffn_norm = (const float*)d_in[13];
    P.w_rg = (const float*)d_in[14]; P.b_rg = (const float*)d_in[15]; P.w_re = (const float*)d_in[16]; P.b_re = (const float*)d_in[17];
    P.w_eg = (const float*)d_in[18]; P.w_eu = (const float*)d_in[19]; P.w_ed = (const float*)d_in[20];
    P.ple_norm = (const float*)d_in[21]; P.w_pg = (const float*)d_in[22]; P.b_pg = (const float*)d_in[23]; P.w_pp = (const float*)d_in[24]; P.final_norm = (const float*)d_in[25];
    P.out = (float*)d_out; P.ws = (unsigned char*)d_ws;
    (void)hipMemsetAsync((char*)d_ws + WS_CTL, 0, 1 * MiB, stream);
#if MK_MULTI
    for (int ph = 0; ph < NPHASE; ++ph) hipLaunchKernelGGL(mk_fwd, dim3(grid), dim3(512), LDS_BYTES, stream, P, ph, ph + 1);
#else
    int lo = 0, hi = NPHASE; void* args[] = {&P, &lo, &hi};
    hipError_t e = hipLaunchCooperativeKernel((const void*)mk_fwd, dim3(grid), dim3(512), args, LDS_BYTES, stream);
    if (e != hipSuccess) fprintf(stderr, "kernel_launch: cooperative launch failed: %s (grid %d)\n", hipGetErrorString(e), grid);
#endif
}
```
